# Optimizing an MI355X kernel written in HIP

```python
import math
import jax, jax.numpy as jnp
from jax import lax
import numpy as np

D_MODEL = 2048
BATCH = 2
SEQ = 4096
DEPTH = 2

N_META = 16
N_A = DEPTH // 2
N_B = DEPTH - N_A
HG_KDIM = 128
HG_HEADS = D_MODEL // HG_KDIM
HG_FDIM = HG_HEADS * HG_KDIM
HG_VDIM = D_MODEL // HG_HEADS
CHUNK = 64
FOX_HEADS = 16
FOX_HDIM = D_MODEL // FOX_HEADS
Q_BLOCK = 128
EPS = 1e-6
MASK_VALUE = -1e30

kernel_name = "yoco_hgrn2_fox_meta_hybrid"


def rms_norm(x, g):
    xf = x.astype(jnp.float32)
    y = xf * lax.rsqrt(jnp.mean(xf * xf, axis=-1, keepdims=True) + EPS)
    return (y * g.astype(jnp.float32)).astype(x.dtype)


def hgrn2_mix(h, g_norm, w_in, g_out, w_out, lb):
    bsz, L, _ = h.shape
    u = rms_norm(h, g_norm) @ w_in
    q = u[..., :HG_FDIM]
    f = u[..., HG_FDIM:2 * HG_FDIM]
    i = u[..., 2 * HG_FDIM:2 * HG_FDIM + D_MODEL]
    z = u[..., 2 * HG_FDIM + D_MODEL:]
    q = jax.nn.silu(q).astype(jnp.float32)
    fg = lb + (1.0 - lb) * jax.nn.sigmoid(f.astype(jnp.float32))
    logf = jnp.log(fg)
    k = 1.0 - fg
    v = i.astype(jnp.float32)
    n_pad = CHUNK - N_META
    padf = lambda a: jnp.pad(a, ((0, 0), (n_pad, 0), (0, 0)))
    q, logf, k, v = padf(q), padf(logf), padf(k), padf(v)
    Lp = L + n_pad
    nc = Lp // CHUNK
    to_chunks = lambda a, d: a.reshape(bsz, nc, CHUNK, HG_HEADS, d).transpose(0, 3, 1, 2, 4)
    q = to_chunks(q, HG_KDIM)
    logf = to_chunks(logf, HG_KDIM)
    k = to_chunks(k, HG_KDIM)
    v = to_chunks(v, HG_VDIM)
    b = jnp.cumsum(logf, axis=3)
    b_last = b[..., CHUNK - 1:CHUNK, :]
    b_mid = b[..., CHUNK // 2 - 1:CHUNK // 2, :]
    q_intra = q * jnp.exp(b - b_mid)
    k_intra = k * jnp.exp(b_mid - b)
    causal = jnp.tril(jnp.ones((CHUNK, CHUNK), dtype=bool))
    A = jnp.einsum('bhntd,bhnsd->bhnts', q_intra, k_intra)
    A = jnp.where(causal, A, 0.0)
    o_intra = jnp.einsum('bhnts,bhnse->bhnte', A, v)
    dS = jnp.einsum('bhnsd,bhnse->bhnde', k * jnp.exp(b_last - b), v)
    decay = jnp.exp(b_last[..., 0, :])

    def step(S, inp):
        dec, ds = inp
        return dec[..., None] * S + ds, S

    S0 = jnp.zeros((bsz, HG_HEADS, HG_KDIM, HG_VDIM), jnp.float32)
    _, S_prev = lax.scan(step, S0, (jnp.moveaxis(decay, 2, 0), jnp.moveaxis(dS, 2, 0)))
    S_prev = jnp.moveaxis(S_prev, 0, 2)
    o_inter = jnp.einsum('bhntd,bhnde->bhnte', q * jnp.exp(b), S_prev)
    o = (o_intra + o_inter).transpose(0, 2, 3, 1, 4).reshape(bsz, Lp, HG_HEADS, HG_VDIM)
    o = o[:, n_pad:].astype(h.dtype)
    o = rms_norm(o, g_out.reshape(HG_HEADS, HG_VDIM)).reshape(bsz, L, D_MODEL)
    return (o * jax.nn.silu(z)) @ w_out


def fox_shared_kv(h, g_kv, w_kv, b_f, g_k):
    bsz, L, _ = h.shape
    u = rms_norm(h, g_kv) @ w_kv
    k = u[..., :D_MODEL].reshape(bsz, L, FOX_HEADS, FOX_HDIM)
    v = u[..., D_MODEL:2 * D_MODEL].reshape(bsz, L, FOX_HEADS, FOX_HDIM)
    fl = u[..., 2 * D_MODEL:]
    k = rms_norm(k, g_k)
    logf = jax.nn.log_sigmoid(fl.astype(jnp.float32) + b_f.astype(jnp.float32))
    n_pad = Q_BLOCK - N_META
    k = jnp.pad(k, ((0, 0), (n_pad, 0), (0, 0), (0, 0)))
    v = jnp.pad(v, ((0, 0), (n_pad, 0), (0, 0), (0, 0)))
    logf = jnp.pad(logf, ((0, 0), (n_pad, 0), (0, 0)))
    F = jnp.cumsum(logf, axis=1).transpose(0, 2, 1)
    valid = jnp.arange(L + n_pad) >= n_pad
    return k, v, F, valid


def fox_mix(h, g_norm, w_in, g_q, w_out, k, v, F, valid):
    bsz, L, _ = h.shape
    u = rms_norm(h, g_norm) @ w_in
    q = rms_norm(u[..., :D_MODEL].reshape(bsz, L, FOX_HEADS, FOX_HDIM), g_q)
    z = u[..., D_MODEL:]
    n_pad = Q_BLOCK - N_META
    q = jnp.pad(q, ((0, 0), (n_pad, 0), (0, 0), (0, 0)))
    Lp = L + n_pad
    scale = FOX_HDIM ** -0.5
    outs = []
    for blk in range(Lp // Q_BLOCK):
        s0 = blk * Q_BLOCK
        s1 = s0 + Q_BLOCK
        logits = jnp.einsum('bqhd,bkhd->bhqk', q[:, s0:s1], k[:, :s1]).astype(jnp.float32) * scale
        logits = logits + F[:, :, s0:s1, None] - F[:, :, None, :s1]
        qi = jnp.arange(s0, s1)[:, None]
        ki = jnp.arange(s1)[None, :]
        mask = (ki <= qi) & valid[None, :s1]
        logits = jnp.where(mask, logits, MASK_VALUE)
        p = jax.nn.softmax(logits, axis=-1).astype(v.dtype)
        outs.append(jnp.einsum('bhqk,bkhd->bqhd', p, v[:, :s1]))
    o = jnp.concatenate(outs, axis=1)[:, n_pad:].reshape(bsz, L, D_MODEL)
    return (o * jax.nn.silu(z)) @ w_out


def setup_inputs(seed: int = 0) -> dict:
    key = jax.random.key(seed)
    ks = jax.random.split(key, 16)
    f32 = jnp.float32
    nrm = lambda k, shape, s: jax.random.normal(k, shape, f32) * s
    gain = lambda k, shape: 1.0 + 0.02 * jax.random.normal(k, shape, f32)
    sd = D_MODEL ** -0.5
    return {
        "x": nrm(ks[0], (BATCH, SEQ, D_MODEL), 1.0),
        "meta": nrm(ks[1], (N_META, D_MODEL), 1.0),
        "gamma_lb": nrm(ks[2], (N_A + 1, HG_FDIM), 0.1),
        "a_norm": gain(ks[3], (N_A, D_MODEL)),
        "a_w_in": nrm(ks[4], (N_A, D_MODEL, 2 * HG_FDIM + 2 * D_MODEL), sd),
        "a_out_norm": gain(ks[5], (N_A, D_MODEL)),
        "a_w_out": nrm(ks[6], (N_A, D_MODEL, D_MODEL), sd),
        "kv_norm": gain(ks[7], (D_MODEL,)),
        "kv_w": nrm(ks[8], (D_MODEL, 2 * D_MODEL + FOX_HEADS), sd),
        "fox_b_f": 3.0 + 0.1 * jax.random.normal(ks[9], (FOX_HEADS,), f32),
        "fox_k_norm": gain(ks[10], (FOX_HEADS, FOX_HDIM)),
        "b_norm": gain(ks[11], (N_B, D_MODEL)),
        "b_w_in": nrm(ks[12], (N_B, D_MODEL, 2 * D_MODEL), sd),
        "b_q_norm": gain(ks[13], (N_B, FOX_HEADS, FOX_HDIM)),
        "b_w_out": nrm(ks[14], (N_B, D_MODEL, D_MODEL), sd),
    }


def reference(x, meta, gamma_lb, a_norm, a_w_in, a_out_norm, a_w_out, kv_norm, kv_w,
              fox_b_f, fox_k_norm, b_norm, b_w_in, b_q_norm, b_w_out):
    bsz = x.shape[0]
    h = jnp.concatenate(
        [jnp.broadcast_to(meta[None].astype(x.dtype), (bsz, N_META, D_MODEL)), x], axis=1)
    lbs = jnp.cumsum(jax.nn.softmax(gamma_lb.astype(jnp.float32), axis=0), axis=0)
    shared = None
    for layer in range(DEPTH):
        if layer < N_A:
            h = h + hgrn2_mix(h, a_norm[layer], a_w_in[layer], a_out_norm[layer],
                              a_w_out[layer], lbs[layer])
        else:
            if layer == N_A:
                shared = fox_shared_kv(h, kv_norm, kv_w, fox_b_f, fox_k_norm)
            j = layer - N_A
            k_s, v_s, F_s, valid_s = shared
            h = h + fox_mix(h, b_norm[j], b_w_in[j], b_q_norm[j], b_w_out[j],
                            k_s, v_s, F_s, valid_s)
    return h[:, N_META:]
```

```cpp
#include <hip/hip_runtime.h>
#include <hip/hip_cooperative_groups.h>
#include <cstdio>
#include <cstdint>
namespace cg = cooperative_groups;

constexpr int NB = 2, SEQ = 4096, DM = 2048, NH = 16, HD = 128, NMETA = 16;
constexpr int MR = NB * SEQ;
constexpr int MT = MR + NMETA;
constexpr int KPAD = 64;
constexpr int SKV = SEQ + KPAD;
constexpr float EPS = 1e-6f;

constexpr size_t MiB = 1u << 20;
constexpr size_t WS_SMALL = 0;
constexpr size_t WS_WT_AIN = 2 * MiB;
constexpr size_t WS_WT_AOUT = 34 * MiB;
constexpr size_t WS_WT_KVB = 42 * MiB;
constexpr size_t WS_WT_BOUT = 74 * MiB;
constexpr size_t WS_WT_F = 82 * MiB;
constexpr size_t WS_XN0 = 83 * MiB;
constexpr size_t WS_QS = 116 * MiB;
constexpr size_t WS_VV = 149 * MiB;
constexpr size_t WS_GZ = 182 * MiB;
constexpr size_t WS_OG = 215 * MiB;
constexpr size_t WS_END = 248 * MiB;
static_assert(WS_VV - WS_QS == 33 * MiB && WS_GZ - WS_VV == 33 * MiB, "Epi1 selects QS | VV | GZ by stride");
constexpr int SM_ROWSS = 0;
constexpr int SM_LBV = 8448;
constexpr int SM_LOGFM = 10496;
constexpr int SM_LOGF2 = 43264;
constexpr int SM_BIAS = 174592;
constexpr int SM_DSEG = 307712;
constexpr int SM_END = 340480;
static_assert(SM_LBV >= SM_ROWSS + MT && SM_LOGFM >= SM_LBV + 2048 && SM_LOGF2 >= SM_LOGFM + 16 * 2048 && SM_BIAS >= SM_LOGF2 + MT * 16 && SM_DSEG >= SM_BIAS + 32 * SKV && SM_END >= SM_DSEG + 256 * 128 && SM_END * 4 <= 2 * (int)MiB, "small map");

#define LAS __attribute__((address_space(3)))
typedef unsigned short bf16_t;
typedef short bf16x8 __attribute__((ext_vector_type(8)));
typedef short s16x4 __attribute__((ext_vector_type(4)));
typedef float f32x4 __attribute__((ext_vector_type(4)));
typedef float f32x16 __attribute__((ext_vector_type(16)));
typedef unsigned u32x4 __attribute__((ext_vector_type(4)));
typedef unsigned u32x2 __attribute__((ext_vector_type(2)));

__device__ __forceinline__ float bf2f(bf16_t v) { return __uint_as_float(((unsigned)v) << 16); }
typedef __bf16 bf16x2_t __attribute__((ext_vector_type(2)));
typedef float f32x2_t __attribute__((ext_vector_type(2)));
__device__ __forceinline__ unsigned pkbf(float lo, float hi) { f32x2_t v = {lo, hi}; bf16x2_t b = __builtin_convertvector(v, bf16x2_t); return __builtin_bit_cast(unsigned, b); }
typedef _Float16 f16x2_t __attribute__((ext_vector_type(2)));
__device__ __forceinline__ unsigned pkh(float lo, float hi) { f32x2_t v = {lo, hi}; f16x2_t b = __builtin_convertvector(v, f16x2_t); return __builtin_bit_cast(unsigned, b); }
__device__ __forceinline__ float h2f(unsigned v) { return (float)__builtin_bit_cast(_Float16, (unsigned short)v); }
__device__ __forceinline__ float fexp(float x) { return __builtin_amdgcn_exp2f(x * 1.4426950408889634f); }
__device__ __forceinline__ float fsigmoid(float x) { return __builtin_amdgcn_rcpf(1.0f + fexp(-x)); }
__device__ __forceinline__ float fsilu(float x) { return x * fsigmoid(x); }
__device__ __forceinline__ float flog(float x) { return __builtin_amdgcn_logf(x) * 0.6931471805599453f; }
__device__ __forceinline__ float wave_sum(float v) {
#pragma unroll
    for (int o = 1; o < 64; o <<= 1) v += __shfl_xor(v, o);
    return v;
}
namespace pg8 {
#define PG8_LAS __attribute__((address_space(3)))
typedef unsigned short bf16_t;
typedef short bf16x8 __attribute__((ext_vector_type(8)));
typedef float f32x4 __attribute__((ext_vector_type(4)));
typedef unsigned u32x4 __attribute__((ext_vector_type(4)));
constexpr int BM = 256, BK = 64, HALF = 128, HTB = HALF * BK * 2  , STAGE_BYTES = 8 * HTB, NXCD = 8, WGM = 8;

__host__ __device__ __forceinline__ int lds_byte(int r, int c) { const int st = (r >> 4) * 2 + (c >> 5), rr = r & 15, cc = c & 31, ob = rr * 64 + cc * 2; return st * 1024 + (ob ^ (((ob >> 9) & 1) << 5)); }
__host__ __device__ __forceinline__ void stage_rc(int b, int& R, int& C) { const int st = b / 1024, sb = b % 1024, swz = sb ^ (((sb >> 9) & 1) << 5); R = (st >> 1) * 16 + swz / 64; C = (st & 1) * 32 + (swz % 64) / 2; }
__host__ __device__ __forceinline__ int perm32(int rho) { const int n = rho >> 4, i = rho & 15; return 8 * (i >> 2) + 4 * n + (i & 3); }

struct Unit { int pm, pn; };
struct Gemm { const bf16_t* A; const bf16_t* Bt; int M, N, K; };

struct StaticOrder {
    int nM, nN, nwg, G, c;
    __host__ __device__ void init(int M, int N, int G_, int c_) { nM = M / BM; nN = N / BM; nwg = nM * nN; G = G_; c = c_; }
    __host__ __device__ bool next(int i, Unit& u) const {
        const long L = (long)i * G + c; if (L >= nwg) return false;
        int wgid = (int)L; { const int q = nwg / NXCD, r = nwg % NXCD, xcd = wgid % NXCD, off = wgid / NXCD; wgid = (xcd < r ? xcd * (q + 1) : r * (q + 1) + (xcd - r) * q) + off; }
        const int nig = WGM * nN, gid = wgid / nig, fm = gid * WGM, gsz = (nM - fm) < WGM ? (nM - fm) : WGM;
        u.pm = fm + ((wgid % nig) % gsz); u.pn = (wgid % nig) / gsz; return true;
    }
    __device__ __forceinline__ void a_ready(const Unit&) const {}
    __device__ __forceinline__ void done(const Unit&) const {}
};
__device__ __forceinline__ unsigned cvt_pk_bf16(float lo, float hi) { unsigned r; asm volatile("v_cvt_pk_bf16_f32 %0, %1, %2" : "=v"(r) : "v"(lo), "v"(hi)); return r; }
struct Epi1 {
    static constexpr bool PERM = true, AFTER_DRAIN = false;
    bf16_t* QS; unsigned short* LOGF; bf16_t* VV; bf16_t* GZ; const float* lbv;
    __device__ __forceinline__ void operator()(const f32x4 (&acc)[2][2][4][2], const Unit& u, int wr, int wc, int fr, int fq) const {
        const int type = u.pn >> 3, colt = (u.pn & 7) * BM;
        const int row0 = u.pm * BM + wr * 64 + fr, col0 = colt + wc * 32 + 8 * fq;
        if (type == 1) {
#pragma unroll
            for (int bj = 0; bj < 2; ++bj) {
                const f32x4 l0 = *(const f32x4*)(lbv + col0 + bj * HALF), l1 = *(const f32x4*)(lbv + col0 + bj * HALF + 4);
#pragma unroll
                for (int ai = 0; ai < 2; ++ai)
#pragma unroll
                    for (int m = 0; m < 4; ++m) {
                        unsigned short* rowp = LOGF + (size_t)(row0 + ai * HALF + m * 16) * DM + col0 + bj * HALF;
                        f32x4 v0 = acc[ai][bj][m][0], v1 = acc[ai][bj][m][1], o0, o1;
#pragma unroll
                        for (int j = 0; j < 4; ++j) { o0[j] = flog(l0[j] + (1.0f - l0[j]) * fsigmoid(v0[j])); o1[j] = flog(l1[j] + (1.0f - l1[j]) * fsigmoid(v1[j])); }
                        u32x4 w; w.x = pkh(o0[0], o0[1]); w.y = pkh(o0[2], o0[3]); w.z = pkh(o1[0], o1[1]); w.w = pkh(o1[2], o1[3]);
                        *(u32x4*)rowp = w;
                    }
            }
        } else {
            bf16_t* base = QS + (size_t)(type - (type > 0 ? 1 : 0)) * (size_t)(33u << 19);
            const bool act = type != 2;
#pragma unroll
            for (int ai = 0; ai < 2; ++ai)
#pragma unroll
                for (int m = 0; m < 4; ++m) {
                    bf16_t* rowp = base + (size_t)(row0 + ai * HALF + m * 16) * DM + col0;
#pragma unroll
                    for (int bj = 0; bj < 2; ++bj) {
                        f32x4 v0 = acc[ai][bj][m][0], v1 = acc[ai][bj][m][1];
                        if (act) {
#pragma unroll
                            for (int j = 0; j < 4; ++j) { v0[j] = fsilu(v0[j]); v1[j] = fsilu(v1[j]); }
                        }
                        u32x4 w; w.x = pkbf(v0[0], v0[1]); w.y = pkbf(v0[2], v0[3]); w.z = pkbf(v1[0], v1[1]); w.w = pkbf(v1[2], v1[3]);
                        *(u32x4*)(rowp + bj * HALF) = w;
                    }
                }
        }
    }
};
struct Epi2 {
    static constexpr bool PERM = false, AFTER_DRAIN = false;
    const float* X; float* H1; bf16_t* H1BF; float* rowss;
    __device__ __forceinline__ void operator()(const f32x4 (&acc)[2][2][4][2], const Unit& u, int wr, int wc, int fr, int fq) const {
        const int row0 = u.pm * BM + wr * 64 + fr, col0 = u.pn * BM + wc * 32 + 4 * fq;
#pragma unroll
        for (int ai = 0; ai < 2; ++ai)
#pragma unroll
            for (int m = 0; m < 4; ++m) {
                const int row = row0 + ai * HALF + m * 16; const size_t off = (size_t)row * DM + col0; float ss = 0.f;
#pragma unroll
                for (int bj = 0; bj < 2; ++bj)
#pragma unroll
                    for (int n = 0; n < 2; ++n) {
                        const f32x4 h = *(const f32x4*)(X + off + bj * HALF + n * 16) + acc[ai][bj][m][n];
                        u32x2 w; w.x = pkbf(h[0], h[1]); w.y = pkbf(h[2], h[3]);
                        *(u32x2*)(H1BF + off + bj * HALF + n * 16) = w;
                        ss += (h[0] * h[0] + h[1] * h[1]) + (h[2] * h[2] + h[3] * h[3]);
                    }
                ss += __shfl_xor(ss, 16); ss += __shfl_xor(ss, 32);
                if (fq == 0) atomicAdd(rowss + row, ss);
                asm volatile("" ::: "memory");
            }
    }
};
struct Epi3 {
    static constexpr bool PERM = true, AFTER_DRAIN = false;
    bf16_t* KB; bf16_t* VB; bf16_t* QB2; bf16_t* GZ2; const float* rowss; const float* gk; const float* gq; PG8_LAS float* xs;
    __device__ __forceinline__ void operator()(const f32x4 (&acc)[2][2][4][2], const Unit& u, int wr, int wc, int fr, int fq) const {
        const int type = u.pn >> 3, row0 = u.pm * BM + wr * 64 + fr;
        const int b = row0 >> 12;
        float rs[2][4];
#pragma unroll
        for (int ai = 0; ai < 2; ++ai)
#pragma unroll
            for (int m = 0; m < 4; ++m) rs[ai][m] = __builtin_amdgcn_rsqf(rowss[row0 + ai * HALF + m * 16] * (1.0f / DM) + EPS);
        const bool normed = (type == 0 || type == 2);
        if (normed) {
#pragma unroll
            for (int ai = 0; ai < 2; ++ai)
#pragma unroll
                for (int m = 0; m < 4; ++m)
#pragma unroll
                    for (int bj = 0; bj < 2; ++bj) {
                        const f32x4 v0 = acc[ai][bj][m][0] * rs[ai][m], v1 = acc[ai][bj][m][1] * rs[ai][m];
                        float ss = (v0[0] * v0[0] + v0[1] * v0[1]) + (v0[2] * v0[2] + v0[3] * v0[3]) + (v1[0] * v1[0] + v1[1] * v1[1]) + (v1[2] * v1[2] + v1[3] * v1[3]);
                        ss += __shfl_xor(ss, 16); ss += __shfl_xor(ss, 32);
                        if (fq == 0) xs[((ai * HALF + wr * 64 + m * 16 + fr) * 2 + bj) * 4 + wc] = ss;
                    }
            asm volatile("s_waitcnt lgkmcnt(0)" ::: "memory"); __builtin_amdgcn_s_barrier(); asm volatile("" ::: "memory");
        }
#pragma unroll
        for (int bj = 0; bj < 2; ++bj) {
            const int head = (u.pn & 7) * 2 + bj, bh = b * NH + head;
            f32x4 g0 = {1.f, 1.f, 1.f, 1.f}, g1 = g0;
            if (normed) { const float* gp = (type == 0 ? gk : gq) + head * HD + wc * 32 + 8 * fq; g0 = *(const f32x4*)gp; g1 = *(const f32x4*)(gp + 4); }
#pragma unroll
            for (int ai = 0; ai < 2; ++ai)
#pragma unroll
                for (int m = 0; m < 4; ++m) {
                    const int row = row0 + ai * HALF + m * 16, t = row & (SEQ - 1);
                    float sc = rs[ai][m];
                    if (normed) { const f32x4 p4 = *(const PG8_LAS f32x4*)(xs + ((ai * HALF + wr * 64 + m * 16 + fr) * 2 + bj) * 4);
                        sc *= __builtin_amdgcn_rsqf(((p4[0] + p4[1]) + (p4[2] + p4[3])) * (1.0f / HD) + EPS); }
                    f32x4 v0 = acc[ai][bj][m][0] * sc * g0, v1 = acc[ai][bj][m][1] * sc * g1;
                    bf16_t* dst;
                    if (type == 3) {
#pragma unroll
                        for (int j = 0; j < 4; ++j) { v0[j] = fsilu(v0[j]); v1[j] = fsilu(v1[j]); }
                        dst = GZ2 + (size_t)row * DM + (u.pn & 7) * BM + bj * HALF + wc * 32 + 8 * fq;
                    } else if (type == 2) dst = QB2 + ((size_t)bh * SEQ + t) * HD + wc * 32 + 8 * fq;
                    else dst = (type == 0 ? KB : VB) + ((size_t)bh * SKV + KPAD + t) * HD + wc * 32 + 8 * fq;
                    u32x4 w; w.x = pkbf(v0[0], v0[1]); w.y = pkbf(v0[2], v0[3]); w.z = pkbf(v1[0], v1[1]); w.w = pkbf(v1[2], v1[3]);
                    *(u32x4*)dst = w;
                }
        }
    }
};
struct Epi4 {
    static constexpr bool PERM = false, AFTER_DRAIN = false;
    const bf16_t* H1BF; float* OUT;
    __device__ __forceinline__ void operator()(const f32x4 (&acc)[2][2][4][2], const Unit& u, int wr, int wc, int fr, int fq) const {
        const int row0 = u.pm * BM + wr * 64 + fr, col0 = u.pn * BM + wc * 32 + 4 * fq;
#pragma unroll
        for (int ai = 0; ai < 2; ++ai)
#pragma unroll
            for (int m = 0; m < 4; ++m) {
                const size_t off = (size_t)(row0 + ai * HALF + m * 16) * DM + col0;
#pragma unroll
                for (int bj = 0; bj < 2; ++bj)
#pragma unroll
                    for (int n = 0; n < 2; ++n) {
                        const u32x2 w = *(const u32x2*)(H1BF + off + bj * HALF + n * 16);
                        const f32x4 h = {__uint_as_float(w.x << 16), __uint_as_float(w.x & 0xffff0000u), __uint_as_float(w.y << 16), __uint_as_float(w.y & 0xffff0000u)};
                        *(f32x4*)(OUT + off + bj * HALF + n * 16) = h + acc[ai][bj][m][n];
                    }
                asm volatile("" ::: "memory");
            }
    }
};
template <class Epi, class Sched, bool ALIGN_EPI = false, bool SP2 = false>
__device__ __forceinline__ void gemm_phase(PG8_LAS unsigned char* lds, const Gemm g, const Sched& S, const Epi& E) {
    const int tid = threadIdx.x, wid = __builtin_amdgcn_readfirstlane(tid >> 6), lane = tid & 63, wr = wid >> 2, wc = wid & 3, fr = lane & 15, fq = lane >> 4;
    const int K = g.K, nt = K / BK;
    unsigned voffA[2], voffB[2];
#pragma unroll
    for (int i = 0; i < 2; ++i) { int R, C; stage_rc(tid * 16 + i * 8192, R, C); const int Rb = Epi::PERM ? ((R & ~31) + perm32(R & 31)) : R;
        voffA[i] = (unsigned)(R * K + C) * 2u; voffB[i] = (unsigned)(Rb * K + C) * 2u; }
    const size_t kstep = (size_t)(BK * 2);
    const size_t hstep = (size_t)HALF * K * 2;
    const size_t tstep = 2 * hstep;
    const unsigned ldsw = (unsigned)wid * 1024u;
    const int aoff = lds_byte(wr * 64 + fr, fq * 8), boff = lds_byte(wc * 32 + fr, fq * 8);
#define PG8_SA(b, h) (((b) * 2 + (h)) * HTB)
#define PG8_SB(b, h) ((4 + (b) * 2 + (h)) * HTB)
#define PG8_STAGE(bufoff, gbase, voff) do { _Pragma("unroll") for (int _i = 0; _i < 2; ++_i) \
        __builtin_amdgcn_global_load_lds((const unsigned*)((const char*)(gbase) + (voff)[_i]), (PG8_LAS unsigned*)(lds + (bufoff) + ldsw + _i * 8192), 16, 0, 0); } while (0)
#define PG8_LDA(dst, b, h) do { _Pragma("unroll") for (int m = 0; m < 4; ++m) _Pragma("unroll") for (int k = 0; k < 2; ++k) dst[m][k] = *(const PG8_LAS bf16x8*)(lds + PG8_SA(b, h) + aoff + m * 2048 + k * 1024); } while (0)
#define PG8_LDB(dst, b, h) do { _Pragma("unroll") for (int n = 0; n < 2; ++n) _Pragma("unroll") for (int k = 0; k < 2; ++k) dst[n][k] = *(const PG8_LAS bf16x8*)(lds + PG8_SB(b, h) + boff + n * 2048 + k * 1024); } while (0)
#define PG8_MMA(ai, bj, At, Bt) do { __builtin_amdgcn_s_setprio(1); _Pragma("unroll") for (int m = 0; m < 4; ++m) _Pragma("unroll") for (int n = 0; n < 2; ++n) _Pragma("unroll") for (int k = 0; k < 2; ++k) \
        acc[ai][bj][m][n] = __builtin_amdgcn_mfma_f32_16x16x32_bf16(Bt[n][k], At[m][k], acc[ai][bj][m][n], 0, 0, 0); __builtin_amdgcn_s_setprio(0); } while (0)
#define PG8_WAIT_V(n) asm volatile("s_waitcnt vmcnt(" #n ")" ::: "memory")
#define PG8_WAIT_L(n) asm volatile("s_waitcnt lgkmcnt(" #n ")" ::: "memory")
#define PG8_BAR __builtin_amdgcn_s_barrier()
#define PG8_SCHED __builtin_amdgcn_sched_barrier(0)
    Unit cur, nxt; int ui = 0;
    if (!S.next(0, cur)) return;
    f32x4 acc[2][2][4][2];
#pragma unroll
    for (int a = 0; a < 2; ++a)
#pragma unroll
        for (int b = 0; b < 2; ++b)
#pragma unroll
            for (int m = 0; m < 4; ++m)
#pragma unroll
                for (int n = 0; n < 2; ++n) acc[a][b][m][n] = (f32x4){0.f, 0.f, 0.f, 0.f};
    bf16x8 At[4][2], B0[2][2], B1[2][2];
    const char* cA = (const char*)g.A + (size_t)cur.pm * tstep; const char* cB = (const char*)g.Bt + (size_t)cur.pn * tstep;
    S.a_ready(cur);
    if constexpr (SP2) {
        PG8_STAGE(PG8_SB(0, 0), cB, voffB); PG8_STAGE(PG8_SB(0, 1), cB + hstep, voffB); PG8_STAGE(PG8_SA(0, 0), cA, voffA); PG8_STAGE(PG8_SA(0, 1), cA + hstep, voffA);
        if (wr == 1) PG8_BAR;
        PG8_WAIT_V(2); PG8_BAR;
        PG8_STAGE(PG8_SB(1, 0), cB + kstep, voffB); PG8_STAGE(PG8_SA(1, 0), cA + kstep, voffA); PG8_STAGE(PG8_SB(1, 1), cB + hstep + kstep, voffB);
        PG8_WAIT_V(6); PG8_BAR;
    } else {
        PG8_STAGE(PG8_SB(0, 0), cB, voffB); PG8_STAGE(PG8_SA(0, 0), cA, voffA); PG8_STAGE(PG8_SB(0, 1), cB + hstep, voffB); PG8_STAGE(PG8_SA(0, 1), cA + hstep, voffA);
        if (wr == 1) PG8_BAR;
        PG8_WAIT_V(4); PG8_BAR;
        PG8_STAGE(PG8_SB(1, 0), cB + kstep, voffB); PG8_STAGE(PG8_SA(1, 0), cA + kstep, voffA); PG8_STAGE(PG8_SB(1, 1), cB + hstep + kstep, voffB);
        PG8_WAIT_V(6); PG8_BAR;
    }
    for (;;) {
        const bool has_next = S.next(ui + 1, nxt);
        const char* nA = has_next ? (const char*)g.A + (size_t)nxt.pm * tstep : cA; const char* nB = has_next ? (const char*)g.Bt + (size_t)nxt.pn * tstep : cB;
        for (int t = 0; t < nt; t += 2) {
            const bool last = (t == nt - 2);
            const char* a1 = cA + (size_t)(t + 1) * kstep;
            const char* a2 = last ? nA : cA + (size_t)(t + 2) * kstep; const char* b2 = last ? nB : cB + (size_t)(t + 2) * kstep;
            const char* a3 = a2 + kstep; const char* b3 = b2 + kstep;
            if (last && has_next) S.a_ready(nxt);
            if constexpr (SP2) {
            PG8_LDB(B0, 0, 0); PG8_LDB(B1, 0, 1); PG8_SCHED; PG8_LDA(At, 0, 0); PG8_STAGE(PG8_SA(1, 1), a1 + hstep, voffA);
            PG8_WAIT_V(8); PG8_WAIT_L(0); PG8_BAR; PG8_MMA(0, 0, At, B0); PG8_MMA(0, 1, At, B1); PG8_BAR; PG8_SCHED;
            PG8_LDA(At, 0, 1); PG8_STAGE(PG8_SB(0, 0), b2, voffB); PG8_STAGE(PG8_SB(0, 1), b2 + hstep, voffB); PG8_STAGE(PG8_SA(0, 0), a2, voffA);
            PG8_WAIT_V(8); PG8_WAIT_L(0); PG8_BAR; PG8_MMA(1, 0, At, B0); PG8_MMA(1, 1, At, B1); PG8_BAR; PG8_SCHED;
            PG8_LDB(B0, 1, 0); PG8_LDB(B1, 1, 1); PG8_SCHED; PG8_LDA(At, 1, 0); PG8_STAGE(PG8_SA(0, 1), a2 + hstep, voffA);
            PG8_WAIT_V(8); PG8_WAIT_L(0); PG8_BAR; PG8_MMA(0, 0, At, B0); PG8_MMA(0, 1, At, B1); PG8_BAR; PG8_SCHED;
            PG8_LDA(At, 1, 1); PG8_STAGE(PG8_SB(1, 0), b3, voffB); PG8_STAGE(PG8_SB(1, 1), b3 + hstep, voffB); PG8_STAGE(PG8_SA(1, 0), a3, voffA);
            PG8_WAIT_V(8); PG8_WAIT_L(0); PG8_BAR; PG8_MMA(1, 0, At, B0); PG8_MMA(1, 1, At, B1); PG8_BAR; PG8_SCHED;
            } else {
            PG8_LDB(B0, 0, 0); PG8_SCHED; PG8_LDA(At, 0, 0); PG8_STAGE(PG8_SA(1, 1), a1 + hstep, voffA);
            PG8_WAIT_L(8); PG8_BAR; PG8_WAIT_L(0); PG8_MMA(0, 0, At, B0); PG8_BAR; PG8_SCHED;
            PG8_LDB(B1, 0, 1); PG8_STAGE(PG8_SB(0, 0), b2, voffB);
            PG8_BAR; PG8_WAIT_L(0); PG8_MMA(0, 1, At, B1); PG8_BAR;
            PG8_LDA(At, 0, 1); PG8_STAGE(PG8_SA(0, 0), a2, voffA);
            PG8_BAR; PG8_WAIT_L(0); PG8_MMA(1, 0, At, B0); PG8_BAR; PG8_SCHED;
            PG8_STAGE(PG8_SB(0, 1), b2 + hstep, voffB);
            PG8_WAIT_V(6); PG8_BAR; PG8_MMA(1, 1, At, B1); PG8_BAR;
            PG8_LDB(B0, 1, 0); PG8_SCHED; PG8_LDA(At, 1, 0); PG8_STAGE(PG8_SA(0, 1), a2 + hstep, voffA);
            PG8_WAIT_L(8); PG8_BAR; PG8_WAIT_L(0); PG8_MMA(0, 0, At, B0); PG8_BAR; PG8_SCHED;
            PG8_LDB(B1, 1, 1); PG8_STAGE(PG8_SB(1, 0), b3, voffB);
            PG8_BAR; PG8_WAIT_L(0); PG8_MMA(0, 1, At, B1); PG8_BAR;
            PG8_LDA(At, 1, 1); PG8_STAGE(PG8_SA(1, 0), a3, voffA);
            PG8_BAR; PG8_WAIT_L(0); PG8_MMA(1, 0, At, B0); PG8_BAR; PG8_SCHED;
            PG8_STAGE(PG8_SB(1, 1), b3 + hstep, voffB);
            PG8_WAIT_V(6); PG8_BAR; PG8_MMA(1, 1, At, B1); PG8_BAR;
            }
        }
        if constexpr (ALIGN_EPI) { if (wr == 0) PG8_BAR; }
        if constexpr (!Epi::AFTER_DRAIN) { E(acc, cur, wr, wc, fr, fq); S.done(cur); }
        if (!has_next) break;
#pragma unroll
        for (int a = 0; a < 2; ++a)
#pragma unroll
            for (int b = 0; b < 2; ++b)
#pragma unroll
                for (int m = 0; m < 4; ++m)
#pragma unroll
                    for (int n = 0; n < 2; ++n) acc[a][b][m][n] = (f32x4){0.f, 0.f, 0.f, 0.f};
        cur = nxt; cA = nA; cB = nB; ++ui;
        if constexpr (ALIGN_EPI) { if (wr == 1) PG8_BAR; }
    }
    PG8_WAIT_V(0);
    if constexpr (!ALIGN_EPI) { if (wr == 0) PG8_BAR; }
    PG8_BAR;
    if constexpr (Epi::AFTER_DRAIN) { E.fused(acc, cur, wr, wc, fr, fq, lds, wid, lane); S.done(cur); }
#undef PG8_SA
#undef PG8_SB
#undef PG8_STAGE
#undef PG8_LDA
#undef PG8_LDB
#undef PG8_MMA
#undef PG8_WAIT_V
#undef PG8_WAIT_L
#undef PG8_BAR
#undef PG8_SCHED
}
}
#define XB_LAS __attribute__((address_space(3)))
#define XB_TMO      128
#define XB_XCNT(j)  (256  + 64 * (j))
#define XB_XSUB(j)  (1280 + 64 * (j))
#define XB_XGEN(j)  (2304 + 64 * (j))
#define XB_TOP      3328
#define XB_TOPGEN   3392
#define XCD_BAR_WORDS 3456
#define XB_SPIN_CAP (1u << 18)

__device__ __forceinline__ unsigned xb_ld(unsigned* p)              { return __hip_atomic_load(p, __ATOMIC_RELAXED, __HIP_MEMORY_SCOPE_AGENT); }
__device__ __forceinline__ unsigned xb_add(unsigned* p, unsigned v) { return __hip_atomic_fetch_add(p, v, __ATOMIC_RELAXED, __HIP_MEMORY_SCOPE_AGENT); }
__device__ __forceinline__ unsigned xb_xcc_id() { return (unsigned)__builtin_amdgcn_s_getreg((3 << 11) | 20) & 0xFu; }
#define XB_SPIN(cond, bar) do { unsigned _sp = 0; while (cond) { __builtin_amdgcn_s_sleep(1); \
    if ((++_sp & 255u) == 0u) { if (xb_ld(&(bar)[XB_TMO])) break; if (_sp > XB_SPIN_CAP) { atomicAdd(&(bar)[XB_TMO], 1u); break; } } } } while (0)

struct XcdBarrier {
    unsigned* bar; unsigned x;
    volatile XB_LAS unsigned* st;
};

__device__ __forceinline__ XcdBarrier xcd_barrier_post(unsigned* bar, volatile XB_LAS unsigned* st) {
    XcdBarrier b; b.bar = bar; b.x = xb_xcc_id(); b.st = st;
    if (threadIdx.x == 0) (void)xb_add(&bar[XB_XCNT(b.x)], 1u);
    return b;
}
__device__ __forceinline__ void xcd_barrier_complete(unsigned* bar, unsigned x, unsigned& nloc, unsigned& nx) {
    const unsigned G = gridDim.x * gridDim.y * gridDim.z;
    unsigned sum, cnt, mine, sp = 0u;
    for (;;) {
        sum = 0u; cnt = 0u; mine = 0u;
#pragma unroll
        for (unsigned j = 0; j < 16; ++j) { const unsigned c = xb_ld(&bar[XB_XCNT(j)]); sum += c; cnt += (c > 0u) ? 1u : 0u; mine = (j == x) ? c : mine; }
        if (sum == G) break;
        __builtin_amdgcn_s_sleep(1);
        if ((++sp & 255u) == 0u) { if (xb_ld(&bar[XB_TMO])) break; if (sp > XB_SPIN_CAP) { atomicAdd(&bar[XB_TMO], 1u); break; } }
    }
    nloc = mine > 0u ? mine : 1u; nx = cnt > 0u ? cnt : 1u;
}

__device__ __forceinline__ void xcd_barrier(const XcdBarrier& b) {
    asm volatile("s_waitcnt vmcnt(0)" ::: "memory");
    __syncthreads();
    if (threadIdx.x == 0) {
        unsigned* bar = b.bar;
        __builtin_amdgcn_s_waitcnt(0);
        unsigned nloc = b.st[0], nx = b.st[1];
        if (nloc == 0u) { xcd_barrier_complete(bar, b.x, nloc, nx); b.st[0] = nloc; b.st[1] = nx; }
        const unsigned old = xb_add(&bar[XB_XSUB(b.x)], 1u);
        const unsigned gen = old / nloc;
        if (old + 1u == (gen + 1u) * nloc) {
            __builtin_amdgcn_fence(__ATOMIC_RELEASE, "agent");
            asm volatile("s_waitcnt vmcnt(0)" ::: "memory");
            const unsigned og = xb_add(&bar[XB_TOP], 1u);
            const unsigned tg = og / nx;
            if (og + 1u == (tg + 1u) * nx) xb_add(&bar[XB_TOPGEN], 1u);
            else XB_SPIN(xb_ld(&bar[XB_TOPGEN]) == tg, bar);
            __builtin_amdgcn_fence(__ATOMIC_ACQUIRE, "agent");
            xb_add(&bar[XB_XGEN(b.x)], 1u);
            asm volatile("s_waitcnt vmcnt(0)" ::: "memory");
        } else {
            XB_SPIN(xb_ld(&bar[XB_XGEN(b.x)]) == gen, bar);
            __builtin_amdgcn_fence(__ATOMIC_ACQUIRE, "agent");
            asm volatile("s_waitcnt vmcnt(0)" ::: "memory");
        }
    }
    __syncthreads();
}
struct Ptrs {
    const float *x, *meta, *gamma_lb, *a_norm, *a_w_in, *a_out_norm, *a_w_out, *kv_norm, *kv_w, *fox_b_f, *fox_k_norm, *b_norm, *b_w_in, *b_q_norm, *b_w_out;
    float* out; float* sm;
    bf16_t *WT_AIN, *WT_AOUT, *WT_KVB, *WT_BOUT, *WT_F, *XN0, *QS, *VV, *GZ, *OG;
};

struct P0Item { const float* W; const float* g; bf16_t* WT; int ldw, row_off, k0, n0; };
constexpr int P0_I_AIN = 32 * 128, P0_I_AOUT = 32 * 32, P0_I_KV = 32 * 64, P0_I_BIN = 32 * 64, P0_I_BOUT = 32 * 32;
constexpr int P0_NITEMS = P0_I_AIN + P0_I_AOUT + P0_I_KV + P0_I_BIN + P0_I_BOUT;
__device__ __forceinline__ P0Item p0_decode(const Ptrs& P, int it) {
    P0Item I; int r = it, nblk;
    if (r < P0_I_AIN) { I.W = P.a_w_in; I.ldw = 8192; I.g = P.a_norm; I.WT = P.WT_AIN; I.row_off = 0; nblk = 128; }
    else if ((r -= P0_I_AIN) < P0_I_AOUT) { I.W = P.a_w_out; I.ldw = 2048; I.g = P.a_out_norm; I.WT = P.WT_AOUT; I.row_off = 0; nblk = 32; }
    else if ((r -= P0_I_AOUT) < P0_I_KV) { I.W = P.kv_w; I.ldw = 4112; I.g = P.kv_norm; I.WT = P.WT_KVB; I.row_off = 0; nblk = 64; }
    else if ((r -= P0_I_KV) < P0_I_BIN) { I.W = P.b_w_in; I.ldw = 4096; I.g = P.b_norm; I.WT = P.WT_KVB; I.row_off = 4096; nblk = 64; }
    else { r -= P0_I_BIN; I.W = P.b_w_out; I.ldw = 2048; I.g = nullptr; I.WT = P.WT_BOUT; I.row_off = 0; nblk = 32; }
    I.k0 = 64 * (r / nblk); I.n0 = 64 * (r % nblk);
    return I;
}
__device__ __forceinline__ void p0_item_load(const P0Item& I, int lane, f32x4 (&v)[16], float (&gg)[16]) {
    const int c4 = lane & 15, rr = lane >> 4;
#pragma unroll
    for (int i = 0; i < 16; ++i) { const int k = I.k0 + 4 * i + rr; v[i] = *(const f32x4*)(I.W + (size_t)k * I.ldw + I.n0 + 4 * c4); gg[i] = I.g ? I.g[k] : 1.0f; }
}
__device__ __forceinline__ void p0_item_store(const P0Item& I, LAS float* scr, int lane, const f32x4 (&v)[16], const float (&gg)[16]) {
    const int c4 = lane & 15, rr = lane >> 4;
#pragma unroll
    for (int i = 0; i < 16; ++i) { LAS float* p = scr + (4 * i + rr) * 65 + 4 * c4; p[0] = v[i][0] * gg[i]; p[1] = v[i][1] * gg[i]; p[2] = v[i][2] * gg[i]; p[3] = v[i][3] * gg[i]; }
    asm volatile("s_waitcnt lgkmcnt(0)" ::: "memory");
    const int c = lane & 7, nn = lane >> 3;
#pragma unroll
    for (int j = 0; j < 8; ++j) { const int n = nn + 8 * j; const LAS float* q = scr + (8 * c) * 65 + n;
        u32x4 o; o.x = pkbf(q[0 * 65], q[1 * 65]); o.y = pkbf(q[2 * 65], q[3 * 65]); o.z = pkbf(q[4 * 65], q[5 * 65]); o.w = pkbf(q[6 * 65], q[7 * 65]);
        *(u32x4*)(I.WT + (size_t)(I.row_off + I.n0 + n) * DM + I.k0 + 8 * c) = o; }
    asm volatile("s_waitcnt lgkmcnt(0)" ::: "memory");
}
__device__ __forceinline__ void rms_row_to_bf16(const float* xrow, bf16_t* orow, int lane) {
    const f32x4* xr = (const f32x4*)xrow + lane;
    f32x4 v[8]; float s = 0.f;
#pragma unroll
    for (int j = 0; j < 8; ++j) { v[j] = xr[64 * j]; s += (v[j].x * v[j].x + v[j].y * v[j].y) + (v[j].z * v[j].z + v[j].w * v[j].w); }
    const float rstd = __builtin_amdgcn_rsqf(wave_sum(s) * (1.f / DM) + EPS);
    u32x2* o8 = (u32x2*)orow + lane;
#pragma unroll
    for (int j = 0; j < 8; ++j) { u32x2 w; w.x = pkbf(v[j].x * rstd, v[j].y * rstd); w.y = pkbf(v[j].z * rstd, v[j].w * rstd); o8[64 * j] = w; }
}
__device__ __forceinline__ void p0_prologue(const Ptrs& P, LAS unsigned char* lds, int gw, int NGW, int wave, int lane) {
    LAS float* scr = (LAS float*)(lds + wave * 16640);
    {
        int it = gw; f32x4 va[16]; float ga[16];
        if (it < P0_NITEMS) p0_item_load(p0_decode(P, it), lane, va, ga);
        while (it < P0_NITEMS) {
            const int nx = it + NGW; f32x4 vb[16]; float gb[16];
            if (nx < P0_NITEMS) p0_item_load(p0_decode(P, nx), lane, vb, gb);
            p0_item_store(p0_decode(P, it), scr, lane, va, ga);
#pragma unroll
            for (int i = 0; i < 16; ++i) { va[i] = vb[i]; ga[i] = gb[i]; }
            it = nx;
        }
    }
    for (int idx = gw * 64 + lane; idx < 16 * DM; idx += NGW * 64) { const int k = idx >> 4, n = idx & 15;
        P.WT_F[(size_t)n * DM + k] = (bf16_t)(pkbf(P.kv_w[(size_t)k * 4112 + 4096 + n] * P.kv_norm[k], 0.f) & 0xffffu); }
    for (int m = gw; m < MT; m += NGW) rms_row_to_bf16(m < MR ? P.x + (size_t)m * DM : P.meta + (size_t)(m - MR) * DM, P.XN0 + (size_t)m * DM, lane);
    for (int idx = gw * 64 + lane; idx < DM; idx += NGW * 64) P.sm[SM_LBV + idx] = fsigmoid(P.gamma_lb[idx] - P.gamma_lb[DM + idx]);
    for (int idx = gw * 64 + lane; idx < MT; idx += NGW * 64) P.sm[SM_ROWSS + idx] = 0.f;
}

__device__ __forceinline__ f32x4 skinny_tile(const bf16_t* A, const bf16_t* Bt, int lane) {
    const int r = lane & 15, g = lane >> 4;
    const bf16x8* pa = (const bf16x8*)(A + (size_t)r * DM + 8 * g);
    const bf16x8* pb = (const bf16x8*)(Bt + (size_t)r * DM + 8 * g);
    f32x4 acc = {0.f, 0.f, 0.f, 0.f};
#pragma unroll 16
    for (int k = 0; k < DM / 32; ++k) acc = __builtin_amdgcn_mfma_f32_16x16x32_bf16(pa[4 * k], pb[4 * k], acc, 0, 0, 0);
    return acc;
}
__device__ __forceinline__ f32x4 skinny_tile4(const bf16_t* A, const bf16_t* Bt, int lane, int wave, LAS f32x4* xs) {
    const int r = lane & 15, g = lane >> 4, part = wave & 3;
    const bf16x8* pa = (const bf16x8*)(A + (size_t)r * DM + 8 * g + part * (DM / 4));
    const bf16x8* pb = (const bf16x8*)(Bt + (size_t)r * DM + 8 * g + part * (DM / 4));
    f32x4 acc = {0.f, 0.f, 0.f, 0.f};
#pragma unroll
    for (int k = 0; k < DM / 128; ++k) acc = __builtin_amdgcn_mfma_f32_16x16x32_bf16(pa[4 * k], pb[4 * k], acc, 0, 0, 0);
    xs[wave * 64 + lane] = acc;
    __syncthreads();
    const int w0 = wave & ~3;
    const f32x4 t = (xs[w0 * 64 + lane] + xs[(w0 + 1) * 64 + lane]) + (xs[(w0 + 2) * 64 + lane] + xs[(w0 + 3) * 64 + lane]);
    __syncthreads();
    return t;
}
constexpr int HG_LD128 = 136, HG_LD64 = 72, HG_LDO = 132;
constexpr int HG_QI = 0, HG_KI = HG_QI + 64 * HG_LD128 * 2, HG_QD = HG_KI + 64 * HG_LD128 * 2, HG_KDT = HG_QD + 64 * HG_LD128 * 2,
              HG_VT = HG_KDT + 128 * HG_LD64 * 2, HG_AL = HG_VT + 128 * HG_LD64 * 2, HG_ST = HG_AL + 64 * HG_LD64 * 2, HG_RT = HG_ST + 128 * HG_LD128 * 2,
              HG_DEC = HG_RT + 4 * 128 * 4, HG_END = HG_DEC + 128 * 4;
static_assert(HG_END <= 140000 && 64 * HG_LDO * 4 <= HG_QD, "hgrn LDS map (O tile overlays QI + KI)");

template <int MODE>
__device__ __forceinline__ void hgrn_item(LAS unsigned char* lds, const bf16_t* QS, const unsigned short* LOGF, const unsigned short* LOGFM, const bf16_t* VV, const bf16_t* GZ, bf16_t* OG,
                                          float* SEGS, float* DSEG, int b, int h, int seg) {
    const int tid = threadIdx.x, wid = __builtin_amdgcn_readfirstlane(tid >> 6), lane = tid & 63, r = lane & 15, g = lane >> 4;
    const int d = tid & 127, rq = tid >> 7, t0 = 16 * rq;
    LAS bf16_t* QI = (LAS bf16_t*)(lds + HG_QI); LAS bf16_t* KI = (LAS bf16_t*)(lds + HG_KI); LAS bf16_t* QD = (LAS bf16_t*)(lds + HG_QD);
    LAS bf16_t* KDT = (LAS bf16_t*)(lds + HG_KDT); LAS bf16_t* VT = (LAS bf16_t*)(lds + HG_VT); LAS bf16_t* AL = (LAS bf16_t*)(lds + HG_AL);
    LAS bf16_t* ST = (LAS bf16_t*)(lds + HG_ST); LAS float* RT = (LAS float*)(lds + HG_RT); LAS float* DEC = (LAS float*)(lds + HG_DEC);
    LAS float* OL = (LAS float*)(lds + HG_QI);
    const int item = (b * NH + h) * 8 + seg;
    const int c_begin = seg == 0 ? 0 : 8 * seg + 1, c_end = 8 * seg + 9;
    f32x4 Sacc[8];
#pragma unroll
    for (int dt = 0; dt < 8; ++dt) Sacc[dt] = (f32x4){0.f, 0.f, 0.f, 0.f};
    float dsum = 0.f;
    if (MODE == 1) {
#ifdef HG_NOFOLD
        for (int j = 0; j < 0; ++j) {
#else
        for (int j = 0; j < seg; ++j) {
#endif
            const int itj = (b * NH + h) * 8 + j;
            const float* sj = SEGS + (size_t)itj * 16384; const float* dj = DSEG + itj * 128;
#pragma unroll
            for (int dt = 0; dt < 8; ++dt) {
                const f32x4 l4 = *(const f32x4*)(dj + 16 * dt + 4 * g);
#pragma unroll
                for (int q = 0; q < 4; ++q) Sacc[dt][q] = fexp(l4[q]) * Sacc[dt][q] + sj[(16 * dt + 4 * g + q) * 128 + 16 * wid + r];
            }
        }
#pragma unroll
        for (int dt = 0; dt < 8; ++dt) { u32x2 w; w.x = pkbf(Sacc[dt][0], Sacc[dt][1]); w.y = pkbf(Sacc[dt][2], Sacc[dt][3]);
            *(LAS u32x2*)(ST + (16 * wid + r) * HG_LD128 + 16 * dt + 4 * g) = w; }
    }
    float lf[16]; unsigned q16[16], v16[16];
#define HG_LOAD(cc) do { const int c_ = (cc); const bool vld_ = c_ > 0 || rq == 3; const int rb_ = b * SEQ + (c_ - 1) * 64;                                   \
        const unsigned short* lp = c_ == 0 ? LOGFM + h * HD + d : LOGF + (size_t)(rb_ + t0) * DM + h * HD + d;                                                       \
        const size_t o16 = c_ == 0 ? (size_t)MR * DM + h * HD + d : (size_t)(rb_ + t0) * DM + h * HD + d;                                                   \
        _Pragma("unroll") for (int i = 0; i < 16; ++i) { const float x = h2f(lp[(size_t)i * DM]); const unsigned vv = VV[o16 + (size_t)i * DM];                   \
            lf[i] = vld_ ? x : 0.f; v16[i] = vld_ ? vv : 0u;                                                                                                \
            if (MODE == 1) { const unsigned qq = QS[o16 + (size_t)i * DM]; q16[i] = vld_ ? qq : 0u; } } } while (0)
    for (int c = c_begin; c < c_end; ++c) {
        HG_LOAD(c);
        const int rowbase = c == 0 ? (MR - 48) : b * SEQ + (c - 1) * 64;
        float cs[16];
        float run = 0.f;
#pragma unroll
        for (int i = 0; i < 16; ++i) { run += lf[i]; cs[i] = run; }
        RT[rq * 128 + d] = run;
        __syncthreads();
        const float r0 = RT[d], r1 = RT[128 + d], r2 = RT[256 + d], r3 = RT[384 + d];
        const float off = (rq > 0 ? r0 : 0.f) + (rq > 1 ? r1 : 0.f) + (rq > 2 ? r2 : 0.f);
        const float bmid = r0 + r1, blast = (r0 + r1) + (r2 + r3);
        if (rq == 0) { DEC[d] = fexp(blast); dsum += blast; }
        const float emid = fexp(bmid), elast = fexp(blast - bmid);
        {
            float kdv[16];
#pragma unroll
            for (int i = 0; i < 16; ++i) {
                const float bb = off + cs[i];
                const float kk = 1.0f - fexp(lf[i]);
                const float e1 = fexp(bb - bmid), e2 = fexp(bmid - bb);
                const float ki = kk * e2;
                kdv[i] = ki * elast;
                if (MODE == 1) {
                    const float qi = __uint_as_float(q16[i] << 16) * e1;
                    QI[(t0 + i) * HG_LD128 + d] = (bf16_t)(pkbf(qi, 0.f) & 0xffffu);
                    KI[(t0 + i) * HG_LD128 + d] = (bf16_t)(pkbf(ki, 0.f) & 0xffffu);
                    QD[(t0 + i) * HG_LD128 + d] = (bf16_t)(pkbf(qi * emid, 0.f) & 0xffffu);
                }
            }
            u32x4 w0, w1, x0, x1;
            w0.x = pkbf(kdv[0], kdv[1]); w0.y = pkbf(kdv[2], kdv[3]); w0.z = pkbf(kdv[4], kdv[5]); w0.w = pkbf(kdv[6], kdv[7]);
            w1.x = pkbf(kdv[8], kdv[9]); w1.y = pkbf(kdv[10], kdv[11]); w1.z = pkbf(kdv[12], kdv[13]); w1.w = pkbf(kdv[14], kdv[15]);
            x0.x = v16[0] | (v16[1] << 16); x0.y = v16[2] | (v16[3] << 16); x0.z = v16[4] | (v16[5] << 16); x0.w = v16[6] | (v16[7] << 16);
            x1.x = v16[8] | (v16[9] << 16); x1.y = v16[10] | (v16[11] << 16); x1.z = v16[12] | (v16[13] << 16); x1.w = v16[14] | (v16[15] << 16);
            *(LAS u32x4*)(KDT + d * HG_LD64 + t0) = w0; *(LAS u32x4*)(KDT + d * HG_LD64 + t0 + 8) = w1;
            *(LAS u32x4*)(VT + d * HG_LD64 + t0) = x0; *(LAS u32x4*)(VT + d * HG_LD64 + t0 + 8) = x1;
        }
        __syncthreads();
        const int tF = tid >> 3, e0F = 16 * (tid & 7);
        const bool wr_ok = c > 0 ? true : (tF >= 48 && b == 0);
        const size_t off2 = (size_t)(wr_ok ? rowbase + tF : MR) * DM + h * HD + e0F;
        u32x4 z0 = {0u, 0u, 0u, 0u}, z1 = z0;
        if (MODE == 1) { z0 = *(const u32x4*)(GZ + off2); z1 = *(const u32x4*)(GZ + off2 + 8); }
        if (MODE == 1) {
            const int ti = wid & 3, si0 = 2 * (wid >> 2);
#pragma unroll
            for (int sj = 0; sj < 2; ++sj) {
                const int si = si0 + sj;
                f32x4 a4 = {0.f, 0.f, 0.f, 0.f};
                if (si <= ti) {
#pragma unroll
                    for (int k4 = 0; k4 < 4; ++k4) {
                        const bf16x8 fa = *(const LAS bf16x8*)(KI + (16 * si + r) * HG_LD128 + 32 * k4 + 8 * g);
                        const bf16x8 fb = *(const LAS bf16x8*)(QI + (16 * ti + r) * HG_LD128 + 32 * k4 + 8 * g);
                        a4 = __builtin_amdgcn_mfma_f32_16x16x32_bf16(fa, fb, a4, 0, 0, 0);
                    }
                    if (si == ti) {
#pragma unroll
                        for (int q = 0; q < 4; ++q) if (4 * g + q > r) a4[q] = 0.f;
                    }
                }
                u32x2 w; w.x = pkbf(a4[0], a4[1]); w.y = pkbf(a4[2], a4[3]);
                *(LAS u32x2*)(AL + (16 * ti + r) * HG_LD64 + 16 * si + 4 * g) = w;
            }
            __syncthreads();
        }
        bf16x8 bv[2];
        bv[0] = *(const LAS bf16x8*)(VT + (16 * wid + r) * HG_LD64 + 8 * g);
        bv[1] = *(const LAS bf16x8*)(VT + (16 * wid + r) * HG_LD64 + 32 + 8 * g);
        if (MODE == 1) {
            bf16x8 sf[4];
#pragma unroll
            for (int k4 = 0; k4 < 4; ++k4) sf[k4] = *(const LAS bf16x8*)(ST + (16 * wid + r) * HG_LD128 + 32 * k4 + 8 * g);
#pragma unroll
            for (int ti = 0; ti < 4; ++ti) {
                f32x4 o4 = {0.f, 0.f, 0.f, 0.f};
#pragma unroll
                for (int k4 = 0; k4 < 4; ++k4) {
                    const bf16x8 fa = *(const LAS bf16x8*)(QD + (16 * ti + r) * HG_LD128 + 32 * k4 + 8 * g);
                    o4 = __builtin_amdgcn_mfma_f32_16x16x32_bf16(fa, sf[k4], o4, 0, 0, 0);
                }
#pragma unroll
                for (int ks = 0; ks < 2; ++ks) {
                    if (ks == 1 && ti < 2) continue;
                    const bf16x8 fa = *(const LAS bf16x8*)(AL + (16 * ti + r) * HG_LD64 + 32 * ks + 8 * g);
                    o4 = __builtin_amdgcn_mfma_f32_16x16x32_bf16(fa, bv[ks], o4, 0, 0, 0);
                }
#pragma unroll
                for (int q = 0; q < 4; ++q) OL[(16 * ti + 4 * g + q) * HG_LDO + 16 * wid + r] = o4[q];
            }
        }
#pragma unroll
        for (int dt = 0; dt < 8; ++dt) {
            const f32x4 dc = *(const LAS f32x4*)(DEC + 16 * dt + 4 * g);
            Sacc[dt] = Sacc[dt] * dc;
#pragma unroll
            for (int ks = 0; ks < 2; ++ks) {
                const bf16x8 fa = *(const LAS bf16x8*)(KDT + (16 * dt + r) * HG_LD64 + 32 * ks + 8 * g);
                Sacc[dt] = __builtin_amdgcn_mfma_f32_16x16x32_bf16(fa, bv[ks], Sacc[dt], 0, 0, 0);
            }
        }
        if (MODE == 1) {
#pragma unroll
            for (int dt = 0; dt < 8; ++dt) { u32x2 w; w.x = pkbf(Sacc[dt][0], Sacc[dt][1]); w.y = pkbf(Sacc[dt][2], Sacc[dt][3]);
                *(LAS u32x2*)(ST + (16 * wid + r) * HG_LD128 + 16 * dt + 4 * g) = w; }
            __syncthreads();
            const int t = tF, e0 = e0F;
            f32x4 o[4]; float ss = 0.f;
#pragma unroll
            for (int q = 0; q < 4; ++q) { o[q] = *(const LAS f32x4*)(OL + t * HG_LDO + e0 + 4 * q); ss += (o[q][0] * o[q][0] + o[q][1] * o[q][1]) + (o[q][2] * o[q][2] + o[q][3] * o[q][3]); }
            ss += __shfl_xor(ss, 1); ss += __shfl_xor(ss, 2); ss += __shfl_xor(ss, 4);
            const float rstd = __builtin_amdgcn_rsqf(ss * (1.0f / HD) + EPS);
            if (wr_ok) {
                u32x4 w0, w1;
#define HG_G(zw, a, b_) pkbf((a) * rstd * __uint_as_float((zw) << 16), (b_) * rstd * __uint_as_float((zw) & 0xffff0000u))
                w0.x = HG_G(z0.x, o[0][0], o[0][1]); w0.y = HG_G(z0.y, o[0][2], o[0][3]); w0.z = HG_G(z0.z, o[1][0], o[1][1]); w0.w = HG_G(z0.w, o[1][2], o[1][3]);
                w1.x = HG_G(z1.x, o[2][0], o[2][1]); w1.y = HG_G(z1.y, o[2][2], o[2][3]); w1.z = HG_G(z1.z, o[3][0], o[3][1]); w1.w = HG_G(z1.w, o[3][2], o[3][3]);
#undef HG_G
                *(u32x4*)(OG + off2) = w0; *(u32x4*)(OG + off2 + 8) = w1;
            }
        }
        __syncthreads();
    }
#undef HG_LOAD
    if (MODE == 0) {
        float* sj = SEGS + (size_t)item * 16384;
#pragma unroll
        for (int dt = 0; dt < 8; ++dt)
#pragma unroll
            for (int q = 0; q < 4; ++q) sj[(16 * dt + 4 * g + q) * 128 + 16 * wid + r] = Sacc[dt][q];
        if (rq == 0) DSEG[item * 128 + d] = dsum;
    }
}
__device__ __forceinline__ void p1_meta(const Ptrs& P, LAS unsigned char* lds, int gw, int NGW, int wave, int lane) {
    const int r = lane & 15, g = lane >> 4; LAS f32x4* xs = (LAS f32x4*)lds;
    for (int base = 0; base < 512; base += NGW / 4) {
        const int tl = base + (gw >> 2); const bool ok = tl < 512 && (wave & 3) == 0;
        const f32x4 acc = skinny_tile4(P.XN0 + (size_t)MR * DM, P.WT_AIN + (size_t)(tl < 512 ? tl : 0) * 16 * DM, lane, wave, xs);
        if (!ok) continue;
        const int col = tl * 16 + r, type = col >> 11, c = col & 2047;
#pragma unroll
        for (int q = 0; q < 4; ++q) {
            const int mr = 4 * g + q; const float v = acc[q];
            if (type == 0) P.QS[(size_t)(MR + mr) * DM + c] = (bf16_t)(pkbf(fsilu(v), 0.f) & 0xffffu);
            else if (type == 1) { const float lb = P.sm[SM_LBV + c]; ((unsigned short*)(P.sm + SM_LOGFM))[mr * DM + c] = (unsigned short)(pkh(flog(lb + (1.0f - lb) * fsigmoid(v)), 0.f) & 0xffffu); }
            else if (type == 2) P.VV[(size_t)(MR + mr) * DM + c] = (bf16_t)(pkbf(v, 0.f) & 0xffffu);
            else P.GZ[(size_t)(MR + mr) * DM + c] = (bf16_t)(pkbf(fsilu(v), 0.f) & 0xffffu);
        }
    }
}
__device__ __forceinline__ void p4_meta(const Ptrs& P, bf16_t* H1BF, LAS unsigned char* lds, int gw, int NGW, int wave, int lane) {
    const int r = lane & 15, g = lane >> 4; LAS f32x4* xs = (LAS f32x4*)lds;
    for (int base = 0; base < 128; base += NGW / 4) {
        const int tl = base + (gw >> 2); const bool ok = tl < 128 && (wave & 3) == 0;
        const f32x4 acc = skinny_tile4(P.OG + (size_t)MR * DM, P.WT_AOUT + (size_t)(tl < 128 ? tl : 0) * 16 * DM, lane, wave, xs);
        if (!ok) continue;
        const int col = tl * 16 + r;
#pragma unroll
        for (int q = 0; q < 4; ++q) {
            const int mr = 4 * g + q; const float hv = P.meta[mr * DM + col] + acc[q];
            H1BF[(size_t)(MR + mr) * DM + col] = (bf16_t)(pkbf(hv, 0.f) & 0xffffu);
            float ss = hv * hv; ss += __shfl_xor(ss, 1); ss += __shfl_xor(ss, 2); ss += __shfl_xor(ss, 4); ss += __shfl_xor(ss, 8);
            if (r == 0) atomicAdd(P.sm + SM_ROWSS + MR + mr, ss);
        }
    }
}
__device__ __forceinline__ void p5_side(const Ptrs& P, const bf16_t* H1BF, bf16_t* KB, bf16_t* VB, LAS unsigned char* lds, int gw, int NGW, int wave, int lane) {
    const int r = lane & 15, g = lane >> 4; LAS f32x4* xs = (LAS f32x4*)lds;
    for (int base = 0; base < 256 + 513; base += NGW / 4) {
        const int tl = base + (gw >> 2); const bool inr = tl < 256 + 513, ok = inr && (wave & 3) == 0;
        const bool meta = !inr || tl < 256; const int rt = meta ? 0 : tl - 256;
        const bf16_t* A = meta ? H1BF + (size_t)MR * DM : H1BF + (size_t)rt * 16 * DM;
        const bf16_t* Bt = meta ? P.WT_KVB + (size_t)(inr ? tl : 0) * 16 * DM : P.WT_F;
        const f32x4 acc = skinny_tile4(A, Bt, lane, wave, xs);
        if (!ok) continue;
        if (tl < 256) {
            const int col = tl * 16 + r, isv = col >> 11, c = col & 2047, head = c >> 7, dd = c & 127;
#pragma unroll
            for (int q = 0; q < 4; ++q) {
                const int mr = 4 * g + q;
                const float rs = __builtin_amdgcn_rsqf(P.sm[SM_ROWSS + MR + mr] * (1.0f / DM) + EPS);
                const bf16_t v = (bf16_t)(pkbf(acc[q] * rs, 0.f) & 0xffffu);
                bf16_t* bs = isv ? VB : KB;
                bs[((size_t)(0 * NH + head) * SKV + 48 + mr) * HD + dd] = v;
                bs[((size_t)(1 * NH + head) * SKV + 48 + mr) * HD + dd] = v;
            }
        } else {
            const float bf = P.fox_b_f[r];
#pragma unroll
            for (int q = 0; q < 4; ++q) {
                const int row = rt * 16 + 4 * g + q;
                const float rs = __builtin_amdgcn_rsqf(P.sm[SM_ROWSS + row] * (1.0f / DM) + EPS);
                const float xl = acc[q] * rs + bf;
                P.sm[SM_LOGF2 + row * 16 + r] = fminf(xl, 0.f) - flog(1.0f + fexp(-fabsf(xl)));
            }
        }
    }
    for (int idx = gw * 64 + lane; idx < 32 * 48 * 16; idx += NGW * 64) {
        const int bh = idx / (48 * 16), rem = idx % (48 * 16);
        const u32x4 z = {0u, 0u, 0u, 0u};
        *(u32x4*)(KB + (size_t)bh * SKV * HD + rem * 8) = z; *(u32x4*)(VB + (size_t)bh * SKV * HD + rem * 8) = z;
    }
}
__device__ __forceinline__ void p6_norm_scan(const Ptrs& P, bf16_t* KB, bf16_t* QB2, int gw, int NGW, int lane) {
    const int sub = lane >> 4, l16 = lane & 15;
    constexpr int NKR = 32 * SKV, NQR = 32 * SEQ;
    (void)NKR; (void)NQR; (void)QB2;
    for (int r4 = gw; r4 < 32 * 16 / 4; r4 += NGW) {
        const int rr = r4 * 4 + sub, bh = rr >> 4, mr = rr & 15;
        bf16_t* p = KB + ((size_t)bh * SKV + 48 + mr) * HD; const float* gn = P.fox_k_norm + (bh & 15) * HD;
        const u32x4 w = *(const u32x4*)(p + 8 * l16);
        float v[8];
        v[0] = __uint_as_float(w.x << 16); v[1] = __uint_as_float(w.x & 0xffff0000u); v[2] = __uint_as_float(w.y << 16); v[3] = __uint_as_float(w.y & 0xffff0000u);
        v[4] = __uint_as_float(w.z << 16); v[5] = __uint_as_float(w.z & 0xffff0000u); v[6] = __uint_as_float(w.w << 16); v[7] = __uint_as_float(w.w & 0xffff0000u);
        float ss = 0.f;
#pragma unroll
        for (int j = 0; j < 8; ++j) ss += v[j] * v[j];
        ss += __shfl_xor(ss, 1); ss += __shfl_xor(ss, 2); ss += __shfl_xor(ss, 4); ss += __shfl_xor(ss, 8);
        const float rs = __builtin_amdgcn_rsqf(ss * (1.0f / HD) + EPS);
        const f32x4 g0 = *(const f32x4*)(gn + 8 * l16), g1 = *(const f32x4*)(gn + 8 * l16 + 4);
        u32x4 o; o.x = pkbf(v[0] * rs * g0[0], v[1] * rs * g0[1]); o.y = pkbf(v[2] * rs * g0[2], v[3] * rs * g0[3]);
        o.z = pkbf(v[4] * rs * g1[0], v[5] * rs * g1[1]); o.w = pkbf(v[6] * rs * g1[2], v[7] * rs * g1[3]);
        *(u32x4*)(p + 8 * l16) = o;
    }
    if (gw < 32) {
        const int b = gw >> 4, h = gw & 15; float* bias = P.sm + SM_BIAS + gw * SKV;
        if (lane < 48) bias[lane] = -1e30f;
        constexpr int NPOS = NMETA + SEQ, PER = 65;
        float v[PER];
#pragma unroll
        for (int k = 0; k < PER; ++k) {
            const int pos = lane * PER + k, pc = pos < NPOS ? pos : NPOS - 1;
            const int row = pc < NMETA ? MR + pc : b * SEQ + pc - NMETA;
            const float x = P.sm[SM_LOGF2 + row * 16 + h];
            v[k] = pos < NPOS ? x : 0.f;
        }
        float run = 0.f;
#pragma unroll
        for (int k = 0; k < PER; ++k) { run += v[k]; v[k] = run; }
        float tot = run;
#pragma unroll
        for (int o = 1; o < 64; o <<= 1) { const float n = __shfl_up(tot, o); if (lane >= o) tot += n; }
        const float base = tot - run;
#pragma unroll
        for (int k = 0; k < PER; ++k) { const int pos = lane * PER + k; if (pos < NPOS) bias[48 + pos] = -(base + v[k]) * 11.313708498984761f; }
    }
}
namespace attn {
constexpr float SCALE = 0.08838834764831845f;
constexpr float THR = 14.f;
constexpr int NW = 8, QBLK = 32, KVBLK = 64, QB = NW * QBLK, D = 128, OST = 2048;
constexpr int SHM_V = KVBLK * D * 2, SHM_K = KVBLK * D * 2;
constexpr int OFF_WS = 2 * SHM_V + 2 * SHM_K, OFF_BIAS = OFF_WS + NW * 64 * 4, LDS_BYTES = OFF_BIAS + SKV * 4;
constexpr unsigned WBIG = 1u << 30;

#define KSWZ(row, colB) ((row) * 256 + ((colB) ^ (((row) & 7) << 4)))
#define SBAR() __builtin_amdgcn_sched_barrier(0)
__device__ __forceinline__ int v_st(int k, int c) { const int kk = (k & ~0xC) | ((k & 4) << 1) | ((k & 8) >> 1); return ((kk >> 3) * 4 + (c >> 5)) * 512 + ((kk & 7) * 32 + (c & 31)) * 2; }
__device__ __forceinline__ int v_rd_base(int lane) { return ((lane & 3) << 3) | (((lane >> 2) & 3) << 6) | (((lane >> 4) & 1) << 5) | (((lane >> 5) & 1) << 8); }
constexpr int v_rd_off(int d0, int ks, int half) { return d0 * 512 + ks * 4096 + half * 2048; }
__device__ __forceinline__ int crow(int r, int hi) { return (r & 3) + 8 * (r >> 2) + 4 * hi; }
__device__ __forceinline__ void mask_tile(f32x16& p0, f32x16& p1, int dq, unsigned W) {
    const float NEG = -__builtin_inff();
#pragma unroll
    for (int r = 0; r < 16; ++r) {
        const int c = (r & 3) + 8 * (r >> 2);
        if ((unsigned)(dq - c) >= W) p0[r] = NEG;
        if ((unsigned)(dq - c - 32) >= W) p1[r] = NEG;
    }
}
__device__ __forceinline__ void partialSM(f32x16& p0, f32x16& p1, float& m_reg, float& mn, float& alpha) {
    float pmax = p0[0]; for (int r = 1; r < 16; ++r) pmax = fmaxf(pmax, p0[r]); for (int r = 0; r < 16; ++r) pmax = fmaxf(pmax, p1[r]);
    { auto rr = __builtin_amdgcn_permlane32_swap(__float_as_uint(pmax), __float_as_uint(pmax), false, false);
      pmax = fmaxf(__uint_as_float(rr[0]), __uint_as_float(rr[1])); }
    constexpr float C2 = 1.4426950408889634f * SCALE;
    if (__builtin_expect(__all((pmax - m_reg) * SCALE <= THR), 1)) { mn = m_reg; alpha = 1.f; }
    else { mn = fmaxf(m_reg, pmax); alpha = __builtin_amdgcn_exp2f((m_reg - mn) * C2); m_reg = mn; }
    const float mnL = -mn * C2;
    for (int r = 0; r < 16; ++r) p0[r] = fmaf(p0[r], C2, mnL); for (int r = 0; r < 16; ++r) p1[r] = fmaf(p1[r], C2, mnL);
    for (int r = 0; r < 16; ++r) p0[r] = __builtin_amdgcn_exp2f(p0[r]);
}
__device__ __forceinline__ void finishSM(f32x16& p0, f32x16& p1, float alpha, float& l_reg, bf16x8& pa0, bf16x8& pa1, bf16x8& pa2, bf16x8& pa3) {
    for (int r = 0; r < 16; ++r) p1[r] = __builtin_amdgcn_exp2f(p1[r]);
    float ps = 0; for (int r = 0; r < 16; ++r) ps += p0[r]; for (int r = 0; r < 16; ++r) ps += p1[r];
    { auto rr = __builtin_amdgcn_permlane32_swap(__float_as_uint(ps), __float_as_uint(ps), false, false);
      ps = __uint_as_float(rr[0]) + __uint_as_float(rr[1]); }
    l_reg = l_reg * alpha + ps;
#define PK4(P, B_, OUT) do { unsigned a0 = pkbf(P[B_+0], P[B_+1]), a1 = pkbf(P[B_+2], P[B_+3]);                          \
        unsigned b0 = pkbf(P[B_+4], P[B_+5]), b1 = pkbf(P[B_+6], P[B_+7]);                                             \
        auto r0 = __builtin_amdgcn_permlane32_swap(a0, b0, false, false); auto r1 = __builtin_amdgcn_permlane32_swap(a1, b1, false, false); \
        u32x4 w = {r0[0], r1[0], r0[1], r1[1]}; OUT = *reinterpret_cast<bf16x8*>(&w); } while (0)
    PK4(p0, 0, pa0); PK4(p0, 8, pa1); PK4(p1, 0, pa2); PK4(p1, 8, pa3);
#undef PK4
}
template <int KB>
__device__ __forceinline__ void qkt(f32x16& p0, f32x16& p1, const char* K_lds, const float* bl, int r32, int hi, const bf16x8* qr) {
    {
        const f32x4 a0 = *(const f32x4*)(bl), a1 = *(const f32x4*)(bl + 8), a2 = *(const f32x4*)(bl + 16), a3 = *(const f32x4*)(bl + 24);
        const f32x4 c0 = *(const f32x4*)(bl + 32), c1 = *(const f32x4*)(bl + 40), c2 = *(const f32x4*)(bl + 48), c3 = *(const f32x4*)(bl + 56);
        p0 = (f32x16){a0[0], a0[1], a0[2], a0[3], a1[0], a1[1], a1[2], a1[3], a2[0], a2[1], a2[2], a2[3], a3[0], a3[1], a3[2], a3[3]};
        p1 = (f32x16){c0[0], c0[1], c0[2], c0[3], c1[0], c1[1], c1[2], c1[3], c2[0], c2[1], c2[2], c2[3], c3[0], c3[1], c3[2], c3[3]};
    }
    const char* kb[4];
#pragma unroll
    for (int dd = 0; dd < 4; ++dd) kb[dd] = K_lds + KB * SHM_K + KSWZ(r32, (dd * 16 + hi * 8) * 2);
#pragma unroll
    for (int d0 = 0; d0 < 8; ++d0) { const char* a = kb[d0 & 3] + (d0 >> 2) * 128;
        bf16x8 b0 = *reinterpret_cast<const bf16x8*>(a);
        bf16x8 b1 = *reinterpret_cast<const bf16x8*>(a + 32 * 256);
        p0 = __builtin_amdgcn_mfma_f32_32x32x16_bf16(b0, qr[d0], p0, 0, 0, 0);
        p1 = __builtin_amdgcn_mfma_f32_32x32x16_bf16(b1, qr[d0], p1, 0, 0, 0); }
}
template <int VB>
__device__ __forceinline__ void pv_tile(f32x16* o, int vb0, bf16x8 pa0, bf16x8 pa1, bf16x8 pa2, bf16x8 pa3) {
#define TRRD(dst, off) asm volatile("ds_read_b64_tr_b16 %0, %1 offset:%2" : "=&v"(dst) : "v"(vb0), "i"(off) : "memory")
#define PV_D0(d0) do { s16x4 l0, l1, l2, l3, h0, h1, h2, h3; constexpr int b_ = VB * SHM_V + v_rd_off(d0, 0, 0); \
        TRRD(l0, b_); TRRD(h0, b_ + 2048); TRRD(l1, b_ + 4096); TRRD(h1, b_ + 6144); TRRD(l2, b_ + 8192); TRRD(h2, b_ + 10240); TRRD(l3, b_ + 12288); TRRD(h3, b_ + 14336); \
        asm volatile("s_waitcnt lgkmcnt(0)" ::: "memory"); SBAR();   \
        o[d0] = __builtin_amdgcn_mfma_f32_32x32x16_bf16(pa0, (bf16x8){l0[0], l0[1], l0[2], l0[3], h0[0], h0[1], h0[2], h0[3]}, o[d0], 0, 0, 0);   \
        o[d0] = __builtin_amdgcn_mfma_f32_32x32x16_bf16(pa1, (bf16x8){l1[0], l1[1], l1[2], l1[3], h1[0], h1[1], h1[2], h1[3]}, o[d0], 0, 0, 0);   \
        o[d0] = __builtin_amdgcn_mfma_f32_32x32x16_bf16(pa2, (bf16x8){l2[0], l2[1], l2[2], l2[3], h2[0], h2[1], h2[2], h2[3]}, o[d0], 0, 0, 0);   \
        o[d0] = __builtin_amdgcn_mfma_f32_32x32x16_bf16(pa3, (bf16x8){l3[0], l3[1], l3[2], l3[3], h3[0], h3[1], h3[2], h3[3]}, o[d0], 0, 0, 0); } while (0)
    PV_D0(0); PV_D0(1); PV_D0(2); PV_D0(3);
#undef PV_D0
#undef TRRD
}

struct BlockRef { const bf16_t* Q; const bf16_t* K; const bf16_t* V; bf16_t* O; const bf16_t* GZ; const float* BIAS; int P0; };
struct Seam { bf16x8 qr[8]; bf16x8 st_v0, st_v1, st_k0, st_k1; };
#define ROW(p, k0, rr) ((p) + (size_t)((k0) + (rr)) * D + sc)
#define VMW() asm volatile("s_waitcnt vmcnt(0)" ::: "memory")
#define VMWN(n) asm volatile("s_waitcnt vmcnt(%0)" :: "i"(n) : "memory")
#define LD8(p) (*reinterpret_cast<const bf16x8*>(p))
#define SLOAD_H(Kp, Vp, k0) do { S.st_v0 = LD8(ROW(Vp, k0, sr)); S.st_v1 = LD8(ROW(Vp, k0, 32 + sr));              \
                         S.st_k0 = LD8(ROW(Kp, k0, sr)); S.st_k1 = LD8(ROW(Kp, k0, 32 + sr)); } while (0)
#define SWRITE_HK(bf) do { *(bf16x8*)(K_lds + (bf) * SHM_K + kws) = S.st_k0; *(bf16x8*)(K_lds + (bf) * SHM_K + kws + 32 * 256) = S.st_k1; } while (0)
#define SWRITE_HV(bf) do { *(bf16x8*)(V_lds + (bf) * SHM_V + vst0) = S.st_v0; *(bf16x8*)(V_lds + (bf) * SHM_V + vst1) = S.st_v1; } while (0)
#define SWRITE_H(bf) do { SWRITE_HV(bf); SWRITE_HK(bf); } while (0)
__device__ __forceinline__ void causal_prime(const BlockRef& cur, char* lds, Seam& S) {
    const int tid = threadIdx.x, wid = __builtin_amdgcn_readfirstlane(tid >> 6), lane = tid & 63, r32 = lane & 31, hi = lane >> 5;
    const int sr = tid >> 4, sc = (tid & 15) * 8, kws = KSWZ(sr, sc * 2); char* K_lds = lds + 2 * SHM_V;
    for (int d0 = 0; d0 < 8; ++d0) S.qr[d0] = LD8(cur.Q + (size_t)(wid * QBLK + r32) * D + d0 * 16 + hi * 8);
    SLOAD_H(cur.K, cur.V, 0); VMW(); SWRITE_HK(0);
    __syncthreads();
}
__device__ __forceinline__ void causal_block(const BlockRef& cur, char* lds, Seam& S) {
    const int tid = threadIdx.x, wid = __builtin_amdgcn_readfirstlane(tid >> 6), lane = tid & 63, r32 = lane & 31, hi = lane >> 5;
    const int NT = (cur.P0 + QB - 1) / KVBLK + 1;
    const int qlo = cur.P0 + wid * QBLK, qm = qlo + r32 - 4 * hi;
    char* V_lds = lds; char* K_lds = lds + 2 * SHM_V;
    float* ws = (float*)(lds + OFF_WS) + wid * 64; float* li_l = ws, * al_l = ws + 32;
    float* bias_l = (float*)(lds + OFF_BIAS);
    for (int i = tid * 4; i < cur.P0 + QB; i += NW * 64 * 4) *(f32x4*)(bias_l + i) = *(const f32x4*)(cur.BIAS + i);
    __syncthreads();
    float m_reg = -1e30f, l_reg = 0; f32x16 o[4] = {};
    const int sr = tid >> 4, sc = (tid & 15) * 8, vst0 = v_st(sr, sc), vst1 = v_st(32 + sr, sc), kws = KSWZ(sr, sc * 2);
    const int vb0 = (int)(uintptr_t)V_lds + v_rd_base(lane);
    const bf16_t* Kh = cur.K; const bf16_t* Vh = cur.V;
#define RESC(a) do { if (__any((a) < 1.f)) { if (hi == 0) al_l[r32] = (a); asm volatile("s_waitcnt lgkmcnt(0)" ::: "memory");              \
                     for (int d_ = 0; d_ < 4; ++d_) for (int r = 0; r < 16; ++r) o[d_][r] *= al_l[crow(r, hi)]; } } while (0)
#define KBASE(t) ((t) * KVBLK)
#define MASKT(P0_, P1_, t) do { const int kb_ = KBASE(t); if (kb_ + KVBLK - 1 > qlo) mask_tile(P0_, P1_, qm - kb_, WBIG); } while (0)
    constexpr int NQL = 8;
#define SEAM_K0() do { VMWN(NQL); SWRITE_HK(0); SBAR(); } while (0)
    f32x16 pA0, pA1, pB0, pB1; float mnA, mnB, alA, alB; bf16x8 pa0, pa1, pa2, pa3;
    SWRITE_HV(0); SBAR();
    if (NT > 1) { SLOAD_H(Kh, Vh, KBASE(1)); }
    SBAR(); qkt<0>(pA0, pA1, K_lds, bias_l + 4 * hi + KBASE(0), r32, hi, S.qr);
    MASKT(pA0, pA1, 0); partialSM(pA0, pA1, m_reg, mnA, alA);
    if (NT > 1) { VMW(); SWRITE_H(1); }
    __syncthreads();
#define HALF_STEP(PX0, PX1, mnX, alX, PY0, PY1, alY, t, KB, VB, SB) do {                                                      \
        SBAR(); qkt<KB>(PX0, PX1, K_lds, bias_l + 4 * hi + KBASE(t), r32, hi, S.qr);                                             \
        finishSM(PY0, PY1, alY, l_reg, pa0, pa1, pa2, pa3); SBAR();                                                           \
        if ((t) + 1 < NT) { SLOAD_H(Kh, Vh, KBASE((t) + 1)); SBAR(); }                                               \
        pv_tile<VB>(o, vb0, pa0, pa1, pa2, pa3); MASKT(PX0, PX1, (t)); partialSM(PX0, PX1, m_reg, mnX, alX);                                        \
        __syncthreads();                                                                                                      \
        if ((t) + 1 < NT) { VMW(); SWRITE_H(SB); }                                                                          \
        RESC(alX); __syncthreads(); } while (0)
    for (int t = 1; t + 1 < NT; t += 2) {
        HALF_STEP(pB0, pB1, mnB, alB, pA0, pA1, alA, t, 1, 0, 0);
        HALF_STEP(pA0, pA1, mnA, alA, pB0, pB1, alB, t + 1, 0, 1, 1);
    }
    const bool even = (NT & 1) == 0;
    if (even) { SBAR(); qkt<1>(pB0, pB1, K_lds, bias_l + 4 * hi + KBASE(NT - 1), r32, hi, S.qr); SBAR(); }
    SBAR();
    finishSM(pA0, pA1, alA, l_reg, pa0, pa1, pa2, pa3); SBAR();
    pv_tile<0>(o, vb0, pa0, pa1, pa2, pa3);
    if (even) { MASKT(pB0, pB1, NT - 1); partialSM(pB0, pB1, m_reg, mnB, alB); __syncthreads(); RESC(alB);
        finishSM(pB0, pB1, alB, l_reg, pa0, pa1, pa2, pa3); SBAR(); pv_tile<1>(o, vb0, pa0, pa1, pa2, pa3); }
    SBAR();
    if (hi == 0) li_l[r32] = l_reg; asm volatile("s_waitcnt lgkmcnt(0)" ::: "memory");
    float rli[16];
#pragma unroll
    for (int r = 0; r < 16; ++r) rli[r] = __builtin_amdgcn_rcpf(li_l[crow(r, hi)]);
    int eoff = 4 * hi * OST + r32;
    asm volatile("" : "+v"(eoff));
    bf16_t* Ow = cur.O + (size_t)(wid * QBLK) * OST + eoff; const bf16_t* Gw = cur.GZ + (size_t)(wid * QBLK) * OST + eoff;
#pragma unroll
    for (int r = 0; r < 16; ++r) { const int ro = ((r & 3) + 8 * (r >> 2)) * OST;
#pragma unroll
        for (int d0 = 0; d0 < 4; ++d0) { const float v = o[d0][r] * rli[r] * bf2f(Gw[ro + d0 * 32]);
            const float vn = __shfl_xor(v, 1);
            if ((r32 & 1) == 0) *(unsigned*)(Ow + ro + d0 * 32) = pkbf(v, vn); }
        asm volatile("" ::: "memory"); }
    __syncthreads();
#undef RESC
#undef KBASE
#undef MASKT
#undef SEAM_K0
#undef HALF_STEP
}
#undef ROW
#undef VMW
#undef VMWN
#undef LD8
#undef SLOAD_H
#undef SWRITE_HK
#undef SWRITE_HV
#undef SWRITE_H

struct Tensors { const bf16_t* Q; const bf16_t* K; const bf16_t* V; bf16_t* O; const bf16_t* GZ; const float* BIAS; };
__device__ __forceinline__ BlockRef make_ref(const Tensors& T, int L, int pass) {
    const int xcd = L & 7, k = L >> 3, bh = xcd * 4 + (k >> 3), x = k & 7, qb = pass ? 15 - x : x, b = bh >> 4, h = bh & 15;
    BlockRef r;
    r.Q = T.Q + ((size_t)bh * SEQ + (size_t)qb * QB) * D; r.K = T.K + (size_t)bh * SKV * D; r.V = T.V + (size_t)bh * SKV * D;
    r.O = T.O + ((size_t)(b * SEQ + qb * QB)) * OST + h * D; r.GZ = T.GZ + ((size_t)(b * SEQ + qb * QB)) * OST + h * D;
    r.BIAS = T.BIAS + bh * SKV; r.P0 = KPAD + qb * QB;
    return r;
}
__device__ __forceinline__ void attn_phase(char* lds, const Tensors& T) {
    const int total = 256, stride = gridDim.x;
    int L = blockIdx.x; if (L >= total) return;
    Seam S;
    for (; L < total; L += stride)
        for (int pass = 0; pass < 2; ++pass) {
            const BlockRef cur = make_ref(T, L, pass);
            causal_prime(cur, lds, S);
            causal_block(cur, lds, S);
        }
}
#undef KSWZ
#undef SBAR
}
constexpr int NWAVES = 8, LDS_BYTES = 147456;
static_assert(pg8::STAGE_BYTES + 8192 <= LDS_BYTES - 256 && pg8::STAGE_BYTES <= LDS_BYTES && HG_END <= LDS_BYTES && attn::LDS_BYTES <= LDS_BYTES, "LDS budget");
constexpr int N_PHASES = 9;
constexpr size_t WS_BAR = 1376256;
constexpr int LDS_MISC = LDS_BYTES - 256;
static_assert(WS_BAR >= (size_t)SM_END * 4 && WS_BAR % 256 == 0 && WS_BAR + 3 * XCD_BAR_WORDS * 4 <= 2 * MiB && HG_END <= LDS_MISC, "barrier words");
struct Args { const float* in[15]; float* out; unsigned char* ws; int ph_lo, ph_hi, li, pad; };

__global__ void __launch_bounds__(NWAVES * 64, 2) yoco_fwd(Args args) {
    extern __shared__ __attribute__((aligned(16))) unsigned char lds_raw[];
    LAS unsigned char* lds = (LAS unsigned char*)lds_raw;
    const int tid = threadIdx.x, lane = tid & 63, wave = __builtin_amdgcn_readfirstlane(tid >> 6);
    const int G = gridDim.x, gw = blockIdx.x * NWAVES + wave, NGW = G * NWAVES;
    unsigned char* ws = args.ws;
    Ptrs P;
    P.x = args.in[0]; P.meta = args.in[1]; P.gamma_lb = args.in[2]; P.a_norm = args.in[3]; P.a_w_in = args.in[4]; P.a_out_norm = args.in[5]; P.a_w_out = args.in[6];
    P.kv_norm = args.in[7]; P.kv_w = args.in[8]; P.fox_b_f = args.in[9]; P.fox_k_norm = args.in[10]; P.b_norm = args.in[11]; P.b_w_in = args.in[12]; P.b_q_norm = args.in[13]; P.b_w_out = args.in[14];
    P.out = args.out; P.sm = (float*)(ws + WS_SMALL);
    P.WT_AIN = (bf16_t*)(ws + WS_WT_AIN); P.WT_AOUT = (bf16_t*)(ws + WS_WT_AOUT); P.WT_KVB = (bf16_t*)(ws + WS_WT_KVB); P.WT_BOUT = (bf16_t*)(ws + WS_WT_BOUT); P.WT_F = (bf16_t*)(ws + WS_WT_F);
    P.XN0 = (bf16_t*)(ws + WS_XN0); P.QS = (bf16_t*)(ws + WS_QS); P.VV = (bf16_t*)(ws + WS_VV); P.GZ = (bf16_t*)(ws + WS_GZ); P.OG = (bf16_t*)(ws + WS_OG);
    bf16_t* H1BF = (bf16_t*)(ws + WS_XN0); bf16_t* KB = (bf16_t*)(ws + WS_QS); bf16_t* VB = (bf16_t*)(ws + WS_VV); bf16_t* QB2 = (bf16_t*)(ws + WS_GZ); bf16_t* GZ2 = (bf16_t*)(ws + WS_OG);
    float* SEGS = (float*)(ws + WS_WT_AIN); bf16_t* OG2 = (bf16_t*)(ws + WS_WT_AIN);
    unsigned short* LOGF = (unsigned short*)args.out;
    const int lo = args.ph_lo, hi = args.ph_hi;
    volatile LAS unsigned* MISC = (volatile LAS unsigned*)(lds + LDS_MISC);
    if (tid < 2) MISC[tid] = 0u;
    __syncthreads();
    const XcdBarrier bar = xcd_barrier_post((unsigned*)(ws + WS_BAR) + args.li * XCD_BAR_WORDS, MISC);
#ifndef PH_MASK
#ifdef DBG_STOP
#define PH_MASK ((2 << DBG_STOP) - 1)
#else
#define PH_MASK 0x1ff
#endif
#endif
#define IN(k) (((PH_MASK >> (k)) & 1) && lo <= (k) && (k) < hi)
#define SEAM(k) do { if (IN(k) && IN((k) + 1)) xcd_barrier(bar); } while (0)

#ifndef PH_DUP
#define PH_DUP -1
#endif
#define GSYNC() xcd_barrier(bar)
#if PH_DUP < 0
#define REP(k)
#define REP_END
#else
#define REP(k) for (int rep_ = 0; rep_ < (PH_DUP == (k) ? 2 : 1); ++rep_) { if (PH_DUP == (k) && rep_ == 1) GSYNC();
#define REP_END }
#endif
#ifdef EXTRA_SYNCS
    for (int es = 0; es < EXTRA_SYNCS; ++es) GSYNC();
#endif
    REP(0)
    if (IN(0)) { p0_prologue(P, lds, gw, NGW, wave, lane); }
    REP_END
    SEAM(0);
    REP(1)
    if (IN(1)) {
        pg8::Gemm g{P.XN0, P.WT_AIN, MR, 8192, DM}; pg8::StaticOrder S; S.init(MR, 8192, G, (int)blockIdx.x);
        pg8::Epi1 E{P.QS, LOGF, P.VV, P.GZ, P.sm + SM_LBV};
        pg8::gemm_phase<pg8::Epi1, pg8::StaticOrder, true, true>(lds, g, S, E);
        p1_meta(P, lds, gw, NGW, wave, lane);
    }
    REP_END
    SEAM(1);
    REP(2)
    if (IN(2)) {
        for (int it = blockIdx.x; it < 32 * 7; it += G) { const int bh = it / 7, seg = it % 7;
            hgrn_item<0>(lds, P.QS, LOGF, (const unsigned short*)(P.sm + SM_LOGFM), P.VV, P.GZ, P.OG, SEGS, P.sm + SM_DSEG, bh >> 4, bh & 15, seg); }
    }
    REP_END
    SEAM(2);
    REP(3)
    if (IN(3)) {
        for (int it = blockIdx.x; it < 256; it += G) { const int bh = it >> 3, seg = it & 7;
            hgrn_item<1>(lds, P.QS, LOGF, (const unsigned short*)(P.sm + SM_LOGFM), P.VV, P.GZ, P.OG, SEGS, P.sm + SM_DSEG, bh >> 4, bh & 15, seg); }
    }
    REP_END
    SEAM(3);
    if (IN(4)) {
        pg8::Gemm g{P.OG, P.WT_AOUT, MR, DM, DM}; pg8::StaticOrder S; S.init(MR, DM, G, (int)blockIdx.x);
        pg8::Epi2 E{P.x, P.out, H1BF, P.sm + SM_ROWSS};
        pg8::gemm_phase<pg8::Epi2, pg8::StaticOrder, true, true>(lds, g, S, E);
        p4_meta(P, H1BF, lds, gw, NGW, wave, lane);
    }
    SEAM(4);
    REP(5)
    if (IN(5)) {
        pg8::Gemm g{H1BF, P.WT_KVB, MR, 8192, DM}; pg8::StaticOrder S; S.init(MR, 8192, G, (int)blockIdx.x);
        pg8::Epi3 E{KB, VB, QB2, GZ2, P.sm + SM_ROWSS, P.fox_k_norm, P.b_q_norm, (LAS float*)(lds + pg8::STAGE_BYTES)};
        pg8::gemm_phase<pg8::Epi3, pg8::StaticOrder, true, true>(lds, g, S, E);
        p5_side(P, H1BF, KB, VB, lds, gw, NGW, wave, lane);
    }
    REP_END
    SEAM(5);
    if (IN(6)) { p6_norm_scan(P, KB, QB2, gw, NGW, lane); }
    SEAM(6);
    REP(7)
    if (IN(7)) {
        const attn::Tensors T{QB2, KB, VB, OG2, GZ2, P.sm + SM_BIAS};
        attn::attn_phase((char*)lds_raw, T);
    }
    REP_END
    SEAM(7);
    if (IN(8)) {
        pg8::Gemm g{OG2, P.WT_BOUT, MR, DM, DM}; pg8::StaticOrder S; S.init(MR, DM, G, (int)blockIdx.x);
        pg8::Epi4 E{H1BF, P.out};
        pg8::gemm_phase<pg8::Epi4, pg8::StaticOrder, true, true>(lds, g, S, E);
    }
#ifdef DBG_STOP
    { xcd_barrier(bar);
      const size_t n = (size_t)MR * DM;
      for (size_t i = (size_t)blockIdx.x * 512 + tid; i < n; i += (size_t)G * 512) {
          float v = 0.f;
          if (DBG_STOP == 1) v = bf2f(P.QS[i]) + bf2f(P.VV[i]) + bf2f(P.GZ[i]);
          if (DBG_STOP == 2) v = (i < (size_t)224 * 16384 ? SEGS[(i / (7 * 16384)) * (8 * 16384) + (i % (7 * 16384))] : 0.f) + (i < 32768 ? P.sm[SM_LOGFM + i] : 0.f) + (i < 16 * DM ? bf2f(P.QS[(size_t)MR * DM + i]) + bf2f(P.VV[(size_t)MR * DM + i]) + bf2f(P.GZ[(size_t)MR * DM + i]) : 0.f);
          if (DBG_STOP == 3) v = bf2f(P.OG[i]);
          if (DBG_STOP == 4) v = args.out[i] + bf2f(H1BF[i]);
          if (DBG_STOP == 5 || DBG_STOP == 6) v = bf2f(KB[i]) + bf2f(VB[i]) + bf2f(QB2[i]) + bf2f(GZ2[i]) + (i < 32 * SKV ? P.sm[SM_BIAS + i] * 1e-3f : 0.f);
          if (DBG_STOP == 7) v = bf2f(OG2[i]);
          args.out[i] = v;
      } }
#endif
#undef IN
#undef SEAM
}

#ifndef MK_PER_PHASE
#define MK_PER_PHASE 0
#endif
extern "C" void kernel_launch(void* const* d_in, const int* in_sizes, int n_in, void* d_out, int out_size, void* d_ws, size_t ws_size, hipStream_t stream) {
    static int grid = 0;
    if (grid == 0) {
        if (n_in != 15 || out_size != MR * DM || ws_size < WS_END) { fprintf(stderr, "kernel_launch: unexpected shapes (n_in %d, out %d, ws %zu)\n", n_in, out_size, ws_size); grid = -1; return; }
        int dev = 0, cus = 0, per_cu = 0;
        (void)hipGetDevice(&dev); (void)hipDeviceGetAttribute(&cus, hipDeviceAttributeMultiprocessorCount, dev);
        if (hipFuncSetAttribute((const void*)yoco_fwd, hipFuncAttributeMaxDynamicSharedMemorySize, LDS_BYTES) != hipSuccess) { fprintf(stderr, "kernel_launch: hipFuncSetAttribute failed\n"); grid = -1; return; }
        if (hipOccupancyMaxActiveBlocksPerMultiprocessor(&per_cu, (const void*)yoco_fwd, NWAVES * 64, LDS_BYTES) != hipSuccess || per_cu < 1) { fprintf(stderr, "kernel_launch: occupancy query says %d blocks per CU\n", per_cu); per_cu = 1; }
        (void)hipGetLastError();
        grid = cus > 0 ? cus : 256;
    }
    if (grid < 0) return;
    if (hipMemsetAsync((char*)d_ws + WS_BAR, 0, 3 * XCD_BAR_WORDS * 4, stream) != hipSuccess) { fprintf(stderr, "kernel_launch: hipMemsetAsync failed\n"); return; }
    Args a{};
    for (int i = 0; i < 15; ++i) a.in[i] = (const float*)d_in[i];
    a.out = (float*)d_out; a.ws = (unsigned char*)d_ws;
#if defined(DUP_PHASE)
    {
        const int cuts[4][2] = {{0, DUP_PHASE + 1}, {DUP_PHASE, DUP_PHASE + 1}, {DUP_PHASE + 1, N_PHASES}, {0, 0}};
        for (int li = 0; li < 3; ++li) { if (cuts[li][0] >= cuts[li][1]) continue; a.ph_lo = cuts[li][0]; a.ph_hi = cuts[li][1]; a.li = li; void* kargs[] = {&a};
            hipError_t e = hipLaunchCooperativeKernel((const void*)yoco_fwd, dim3(grid), dim3(NWAVES * 64), kargs, LDS_BYTES, stream);
            if (e != hipSuccess) { fprintf(stderr, "kernel_launch: launch %d failed: %s\n", li, hipGetErrorString(e)); break; } }
    }
#elif MK_PER_PHASE
    for (int p = 0; p < N_PHASES; ++p) { a.ph_lo = p; a.ph_hi = p + 1; void* kargs[] = {&a};
        hipError_t e = hipLaunchCooperativeKernel((const void*)yoco_fwd, dim3(grid), dim3(NWAVES * 64), kargs, LDS_BYTES, stream);
        if (e != hipSuccess) { fprintf(stderr, "kernel_launch: launch of phase %d failed: %s\n", p, hipGetErrorString(e)); break; } }
#else
    a.ph_lo = 0; a.ph_hi = N_PHASES; void* kargs[] = {&a};
    hipError_t e = hipLaunchCooperativeKernel((const void*)yoco_fwd, dim3(grid), dim3(NWAVES * 64), kargs, LDS_BYTES, stream);
    if (e != hipSuccess) fprintf(stderr, "kernel_launch: cooperative launch failed: %s (grid %d)\n", hipGetErrorString(e), grid);
#endif
}
```

```cpp
#include <hip/hip_runtime.h>
#include <hip/hip_cooperative_groups.h>
#include <cstdio>
#include <cstdint>
namespace cg = cooperative_groups;

constexpr int NB = 2, SEQ = 4096, DM = 2048, NH = 16, HD = 128, NMETA = 16;
constexpr int MR = NB * SEQ;
constexpr int MT = MR + NMETA;
constexpr int KPAD = 64;
constexpr int SKV = SEQ + KPAD;
constexpr float EPS = 1e-6f;

constexpr size_t MiB = 1u << 20;
constexpr size_t WS_SMALL = 0;
constexpr size_t WS_WT_AIN = 2 * MiB;
constexpr size_t WS_WT_AOUT = 34 * MiB;
constexpr size_t WS_WT_KVB = 42 * MiB;
constexpr size_t WS_WT_BOUT = 74 * MiB;
constexpr size_t WS_WT_F = 82 * MiB;
constexpr size_t WS_XN0 = 83 * MiB;
constexpr size_t WS_QS = 116 * MiB;
constexpr size_t WS_VV = 149 * MiB;
constexpr size_t WS_GZ = 182 * MiB;
constexpr size_t WS_OG = 215 * MiB;
constexpr size_t WS_END = 248 * MiB;
static_assert(WS_VV - WS_QS == 33 * MiB && WS_GZ - WS_VV == 33 * MiB, "Epi1 selects QS | VV | GZ by stride");
constexpr int SM_ROWSS = 0;
constexpr int SM_LBV = 8448;
constexpr int SM_LOGFM = 10496;
constexpr int SM_LOGF2 = 43264;
constexpr int SM_BIAS = 174592;
constexpr int SM_DSEG = 307712;
constexpr int SM_END = 340480;
static_assert(SM_LBV >= SM_ROWSS + MT && SM_LOGFM >= SM_LBV + 2048 && SM_LOGF2 >= SM_LOGFM + 16 * 2048 && SM_BIAS >= SM_LOGF2 + MT * 16 && SM_DSEG >= SM_BIAS + 32 * SKV && SM_END >= SM_DSEG + 256 * 128 && SM_END * 4 <= 2 * (int)MiB, "small map");

#define LAS __attribute__((address_space(3)))
typedef unsigned short bf16_t;
typedef short bf16x8 __attribute__((ext_vector_type(8)));
typedef short s16x4 __attribute__((ext_vector_type(4)));
typedef float f32x4 __attribute__((ext_vector_type(4)));
typedef float f32x16 __attribute__((ext_vector_type(16)));
typedef unsigned u32x4 __attribute__((ext_vector_type(4)));
typedef unsigned u32x2 __attribute__((ext_vector_type(2)));

__device__ __forceinline__ float bf2f(bf16_t v) { return __uint_as_float(((unsigned)v) << 16); }
typedef __bf16 bf16x2_t __attribute__((ext_vector_type(2)));
typedef float f32x2_t __attribute__((ext_vector_type(2)));
__device__ __forceinline__ unsigned pkbf(float lo, float hi) { f32x2_t v = {lo, hi}; bf16x2_t b = __builtin_convertvector(v, bf16x2_t); return __builtin_bit_cast(unsigned, b); }
typedef _Float16 f16x2_t __attribute__((ext_vector_type(2)));
__device__ __forceinline__ unsigned pkh(float lo, float hi) { f32x2_t v = {lo, hi}; f16x2_t b = __builtin_convertvector(v, f16x2_t); return __builtin_bit_cast(unsigned, b); }
__device__ __forceinline__ float h2f(unsigned v) { return (float)__builtin_bit_cast(_Float16, (unsigned short)v); }
__device__ __forceinline__ float fexp(float x) { return __builtin_amdgcn_exp2f(x * 1.4426950408889634f); }
__device__ __forceinline__ float fsigmoid(float x) { return __builtin_amdgcn_rcpf(1.0f + fexp(-x)); }
__device__ __forceinline__ float fsilu(float x) { return x * fsigmoid(x); }
__device__ __forceinline__ float flog(float x) { return __builtin_amdgcn_logf(x) * 0.6931471805599453f; }
__device__ __forceinline__ float wave_sum(float v) {
#pragma unroll
    for (int o = 1; o < 64; o <<= 1) v += __shfl_xor(v, o);
    return v;
}
namespace pg8 {
#define PG8_LAS __attribute__((address_space(3)))
typedef unsigned short bf16_t;
typedef short bf16x8 __attribute__((ext_vector_type(8)));
typedef float f32x4 __attribute__((ext_vector_type(4)));
typedef unsigned u32x4 __attribute__((ext_vector_type(4)));
constexpr int BM = 256, BK = 64, HALF = 128, HTB = HALF * BK * 2  , STAGE_BYTES = 8 * HTB, NXCD = 8, WGM = 8;

__host__ __device__ __forceinline__ int lds_byte(int r, int c) { const int st = (r >> 4) * 2 + (c >> 5), rr = r & 15, cc = c & 31, ob = rr * 64 + cc * 2; return st * 1024 + (ob ^ (((ob >> 9) & 1) << 5)); }
__host__ __device__ __forceinline__ void stage_rc(int b, int& R, int& C) { const int st = b / 1024, sb = b % 1024, swz = sb ^ (((sb >> 9) & 1) << 5); R = (st >> 1) * 16 + swz / 64; C = (st & 1) * 32 + (swz % 64) / 2; }
__host__ __device__ __forceinline__ int perm32(int rho) { const int n = rho >> 4, i = rho & 15; return 8 * (i >> 2) + 4 * n + (i & 3); }

struct Unit { int pm, pn; };
struct Gemm { const bf16_t* A; const bf16_t* Bt; int M, N, K; };

struct StaticOrder {
    int nM, nN, nwg, G, c;
    __host__ __device__ void init(int M, int N, int G_, int c_) { nM = M / BM; nN = N / BM; nwg = nM * nN; G = G_; c = c_; }
    __host__ __device__ bool next(int i, Unit& u) const {
        const long L = (long)i * G + c; if (L >= nwg) return false;
        int wgid = (int)L; { const int q = nwg / NXCD, r = nwg % NXCD, xcd = wgid % NXCD, off = wgid / NXCD; wgid = (xcd < r ? xcd * (q + 1) : r * (q + 1) + (xcd - r) * q) + off; }
        const int nig = WGM * nN, gid = wgid / nig, fm = gid * WGM, gsz = (nM - fm) < WGM ? (nM - fm) : WGM;
        u.pm = fm + ((wgid % nig) % gsz); u.pn = (wgid % nig) / gsz; return true;
    }
    __device__ __forceinline__ void a_ready(const Unit&) const {}
    __device__ __forceinline__ void done(const Unit&) const {}
};
__device__ __forceinline__ unsigned cvt_pk_bf16(float lo, float hi) { unsigned r; asm volatile("v_cvt_pk_bf16_f32 %0, %1, %2" : "=v"(r) : "v"(lo), "v"(hi)); return r; }
struct Epi1 {
    static constexpr bool PERM = true, AFTER_DRAIN = false;
    bf16_t* QS; unsigned short* LOGF; bf16_t* VV; bf16_t* GZ; const float* lbv;
    __device__ __forceinline__ void operator()(const f32x4 (&acc)[2][2][4][2], const Unit& u, int wr, int wc, int fr, int fq) const {
        const int type = u.pn >> 3, colt = (u.pn & 7) * BM;
        const int row0 = u.pm * BM + wr * 64 + fr, col0 = colt + wc * 32 + 8 * fq;
        if (type == 1) {
#pragma unroll
            for (int bj = 0; bj < 2; ++bj) {
                const f32x4 l0 = *(const f32x4*)(lbv + col0 + bj * HALF), l1 = *(const f32x4*)(lbv + col0 + bj * HALF + 4);
#pragma unroll
                for (int ai = 0; ai < 2; ++ai)
#pragma unroll
                    for (int m = 0; m < 4; ++m) {
                        unsigned short* rowp = LOGF + (size_t)(row0 + ai * HALF + m * 16) * DM + col0 + bj * HALF;
                        f32x4 v0 = acc[ai][bj][m][0], v1 = acc[ai][bj][m][1], o0, o1;
#pragma unroll
                        for (int j = 0; j < 4; ++j) { o0[j] = flog(l0[j] + (1.0f - l0[j]) * fsigmoid(v0[j])); o1[j] = flog(l1[j] + (1.0f - l1[j]) * fsigmoid(v1[j])); }
                        u32x4 w; w.x = pkh(o0[0], o0[1]); w.y = pkh(o0[2], o0[3]); w.z = pkh(o1[0], o1[1]); w.w = pkh(o1[2], o1[3]);
                        *(u32x4*)rowp = w;
                    }
            }
        } else {
            bf16_t* base = QS + (size_t)(type - (type > 0 ? 1 : 0)) * (size_t)(33u << 19);
            const bool act = type != 2;
#pragma unroll
            for (int ai = 0; ai < 2; ++ai)
#pragma unroll
                for (int m = 0; m < 4; ++m) {
                    bf16_t* rowp = base + (size_t)(row0 + ai * HALF + m * 16) * DM + col0;
#pragma unroll
                    for (int bj = 0; bj < 2; ++bj) {
                        f32x4 v0 = acc[ai][bj][m][0], v1 = acc[ai][bj][m][1];
                        if (act) {
#pragma unroll
                            for (int j = 0; j < 4; ++j) { v0[j] = fsilu(v0[j]); v1[j] = fsilu(v1[j]); }
                        }
                        u32x4 w; w.x = pkbf(v0[0], v0[1]); w.y = pkbf(v0[2], v0[3]); w.z = pkbf(v1[0], v1[1]); w.w = pkbf(v1[2], v1[3]);
                        *(u32x4*)(rowp + bj * HALF) = w;
                    }
                }
        }
    }
};
struct Epi2 {
    static constexpr bool PERM = false, AFTER_DRAIN = false;
    const float* X; float* H1; bf16_t* H1BF; float* rowss;
    __device__ __forceinline__ void operator()(const f32x4 (&acc)[2][2][4][2], const Unit& u, int wr, int wc, int fr, int fq) const {
        const int row0 = u.pm * BM + wr * 64 + fr, col0 = u.pn * BM + wc * 32 + 4 * fq;
#pragma unroll
        for (int ai = 0; ai < 2; ++ai)
#pragma unroll
            for (int m = 0; m < 4; ++m) {
                const int row = row0 + ai * HALF + m * 16; const size_t off = (size_t)row * DM + col0; float ss = 0.f;
#pragma unroll
                for (int bj = 0; bj < 2; ++bj)
#pragma unroll
                    for (int n = 0; n < 2; ++n) {
                        const f32x4 h = *(const f32x4*)(X + off + bj * HALF + n * 16) + acc[ai][bj][m][n];
                        u32x2 w; w.x = pkbf(h[0], h[1]); w.y = pkbf(h[2], h[3]);
                        *(u32x2*)(H1BF + off + bj * HALF + n * 16) = w;
                        ss += (h[0] * h[0] + h[1] * h[1]) + (h[2] * h[2] + h[3] * h[3]);
                    }
                ss += __shfl_xor(ss, 16); ss += __shfl_xor(ss, 32);
                if (fq == 0) atomicAdd(rowss + row, ss);
                asm volatile("" ::: "memory");
            }
    }
};
struct Epi3 {
    static constexpr bool PERM = true, AFTER_DRAIN = false;
    bf16_t* KB; bf16_t* VB; bf16_t* QB2; bf16_t* GZ2; const float* rowss; const float* gk; const float* gq; PG8_LAS float* xs;
    __device__ __forceinline__ void operator()(const f32x4 (&acc)[2][2][4][2], const Unit& u, int wr, int wc, int fr, int fq) const {
        const int type = u.pn >> 3, row0 = u.pm * BM + wr * 64 + fr;
        const int b = row0 >> 12;
        float rs[2][4];
#pragma unroll
        for (int ai = 0; ai < 2; ++ai)
#pragma unroll
            for (int m = 0; m < 4; ++m) rs[ai][m] = __builtin_amdgcn_rsqf(rowss[row0 + ai * HALF + m * 16] * (1.0f / DM) + EPS);
        const bool normed = (type == 0 || type == 2);
        if (normed) {
#pragma unroll
            for (int ai = 0; ai < 2; ++ai)
#pragma unroll
                for (int m = 0; m < 4; ++m)
#pragma unroll
                    for (int bj = 0; bj < 2; ++bj) {
                        const f32x4 v0 = acc[ai][bj][m][0] * rs[ai][m], v1 = acc[ai][bj][m][1] * rs[ai][m];
                        float ss = (v0[0] * v0[0] + v0[1] * v0[1]) + (v0[2] * v0[2] + v0[3] * v0[3]) + (v1[0] * v1[0] + v1[1] * v1[1]) + (v1[2] * v1[2] + v1[3] * v1[3]);
                        ss += __shfl_xor(ss, 16); ss += __shfl_xor(ss, 32);
                        if (fq == 0) xs[((ai * HALF + wr * 64 + m * 16 + fr) * 2 + bj) * 4 + wc] = ss;
                    }
            asm volatile("s_waitcnt lgkmcnt(0)" ::: "memory"); __builtin_amdgcn_s_barrier(); asm volatile("" ::: "memory");
        }
#pragma unroll
        for (int bj = 0; bj < 2; ++bj) {
            const int head = (u.pn & 7) * 2 + bj, bh = b * NH + head;
            f32x4 g0 = {1.f, 1.f, 1.f, 1.f}, g1 = g0;
            if (normed) { const float* gp = (type == 0 ? gk : gq) + head * HD + wc * 32 + 8 * fq; g0 = *(const f32x4*)gp; g1 = *(const f32x4*)(gp + 4); }
#pragma unroll
            for (int ai = 0; ai < 2; ++ai)
#pragma unroll
                for (int m = 0; m < 4; ++m) {
                    const int row = row0 + ai * HALF + m * 16, t = row & (SEQ - 1);
                    float sc = rs[ai][m];
                    if (normed) { const f32x4 p4 = *(const PG8_LAS f32x4*)(xs + ((ai * HALF + wr * 64 + m * 16 + fr) * 2 + bj) * 4);
                        sc *= __builtin_amdgcn_rsqf(((p4[0] + p4[1]) + (p4[2] + p4[3])) * (1.0f / HD) + EPS); }
                    f32x4 v0 = acc[ai][bj][m][0] * sc * g0, v1 = acc[ai][bj][m][1] * sc * g1;
                    bf16_t* dst;
                    if (type == 3) {
#pragma unroll
                        for (int j = 0; j < 4; ++j) { v0[j] = fsilu(v0[j]); v1[j] = fsilu(v1[j]); }
                        dst = GZ2 + (size_t)row * DM + (u.pn & 7) * BM + bj * HALF + wc * 32 + 8 * fq;
                    } else if (type == 2) dst = QB2 + ((size_t)bh * SEQ + t) * HD + wc * 32 + 8 * fq;
                    else dst = (type == 0 ? KB : VB) + ((size_t)bh * SKV + KPAD + t) * HD + wc * 32 + 8 * fq;
                    u32x4 w; w.x = pkbf(v0[0], v0[1]); w.y = pkbf(v0[2], v0[3]); w.z = pkbf(v1[0], v1[1]); w.w = pkbf(v1[2], v1[3]);
                    *(u32x4*)dst = w;
                }
        }
    }
};
struct Epi4 {
    static constexpr bool PERM = false, AFTER_DRAIN = false;
    const bf16_t* H1BF; float* OUT;
    __device__ __forceinline__ void operator()(const f32x4 (&acc)[2][2][4][2], const Unit& u, int wr, int wc, int fr, int fq) const {
        const int row0 = u.pm * BM + wr * 64 + fr, col0 = u.pn * BM + wc * 32 + 4 * fq;
#pragma unroll
        for (int ai = 0; ai < 2; ++ai)
#pragma unroll
            for (int m = 0; m < 4; ++m) {
                const size_t off = (size_t)(row0 + ai * HALF + m * 16) * DM + col0;
#pragma unroll
                for (int bj = 0; bj < 2; ++bj)
#pragma unroll
                    for (int n = 0; n < 2; ++n) {
                        const u32x2 w = *(const u32x2*)(H1BF + off + bj * HALF + n * 16);
                        const f32x4 h = {__uint_as_float(w.x << 16), __uint_as_float(w.x & 0xffff0000u), __uint_as_float(w.y << 16), __uint_as_float(w.y & 0xffff0000u)};
                        *(f32x4*)(OUT + off + bj * HALF + n * 16) = h + acc[ai][bj][m][n];
                    }
                asm volatile("" ::: "memory");
            }
    }
};
template <class Epi, class Sched, bool ALIGN_EPI = false, bool SP2 = false>
__device__ __forceinline__ void gemm_phase(PG8_LAS unsigned char* lds, const Gemm g, const Sched& S, const Epi& E) {
    const int tid = threadIdx.x, wid = __builtin_amdgcn_readfirstlane(tid >> 6), lane = tid & 63, wr = wid >> 2, wc = wid & 3, fr = lane & 15, fq = lane >> 4;
    const int K = g.K, nt = K / BK;
    unsigned voffA[2], voffB[2];
#pragma unroll
    for (int i = 0; i < 2; ++i) { int R, C; stage_rc(tid * 16 + i * 8192, R, C); const int Rb = Epi::PERM ? ((R & ~31) + perm32(R & 31)) : R;
        voffA[i] = (unsigned)(R * K + C) * 2u; voffB[i] = (unsigned)(Rb * K + C) * 2u; }
    const size_t kstep = (size_t)(BK * 2);
    const size_t hstep = (size_t)HALF * K * 2;
    const size_t tstep = 2 * hstep;
    const unsigned ldsw = (unsigned)wid * 1024u;
    const int aoff = lds_byte(wr * 64 + fr, fq * 8), boff = lds_byte(wc * 32 + fr, fq * 8);
#define PG8_SA(b, h) (((b) * 2 + (h)) * HTB)
#define PG8_SB(b, h) ((4 + (b) * 2 + (h)) * HTB)
#define PG8_STAGE(bufoff, gbase, voff) do { _Pragma("unroll") for (int _i = 0; _i < 2; ++_i) \
        __builtin_amdgcn_global_load_lds((const unsigned*)((const char*)(gbase) + (voff)[_i]), (PG8_LAS unsigned*)(lds + (bufoff) + ldsw + _i * 8192), 16, 0, 0); } while (0)
#define PG8_LDA(dst, b, h) do { _Pragma("unroll") for (int m = 0; m < 4; ++m) _Pragma("unroll") for (int k = 0; k < 2; ++k) dst[m][k] = *(const PG8_LAS bf16x8*)(lds + PG8_SA(b, h) + aoff + m * 2048 + k * 1024); } while (0)
#define PG8_LDB(dst, b, h) do { _Pragma("unroll") for (int n = 0; n < 2; ++n) _Pragma("unroll") for (int k = 0; k < 2; ++k) dst[n][k] = *(const PG8_LAS bf16x8*)(lds + PG8_SB(b, h) + boff + n * 2048 + k * 1024); } while (0)
#define PG8_MMA(ai, bj, At, Bt) do { __builtin_amdgcn_s_setprio(1); _Pragma("unroll") for (int m = 0; m < 4; ++m) _Pragma("unroll") for (int n = 0; n < 2; ++n) _Pragma("unroll") for (int k = 0; k < 2; ++k) \
        acc[ai][bj][m][n] = __builtin_amdgcn_mfma_f32_16x16x32_bf16(Bt[n][k], At[m][k], acc[ai][bj][m][n], 0, 0, 0); __builtin_amdgcn_s_setprio(0); } while (0)
#define PG8_WAIT_V(n) asm volatile("s_waitcnt vmcnt(" #n ")" ::: "memory")
#define PG8_WAIT_L(n) asm volatile("s_waitcnt lgkmcnt(" #n ")" ::: "memory")
#define PG8_BAR __builtin_amdgcn_s_barrier()
#define PG8_SCHED __builtin_amdgcn_sched_barrier(0)
    Unit cur, nxt; int ui = 0;
    if (!S.next(0, cur)) return;
    f32x4 acc[2][2][4][2];
#pragma unroll
    for (int a = 0; a < 2; ++a)
#pragma unroll
        for (int b = 0; b < 2; ++b)
#pragma unroll
            for (int m = 0; m < 4; ++m)
#pragma unroll
                for (int n = 0; n < 2; ++n) acc[a][b][m][n] = (f32x4){0.f, 0.f, 0.f, 0.f};
    bf16x8 At[4][2], B0[2][2], B1[2][2];
    const char* cA = (const char*)g.A + (size_t)cur.pm * tstep; const char* cB = (const char*)g.Bt + (size_t)cur.pn * tstep;
    S.a_ready(cur);
    if constexpr (SP2) {
        PG8_STAGE(PG8_SB(0, 0), cB, voffB); PG8_STAGE(PG8_SB(0, 1), cB + hstep, voffB); PG8_STAGE(PG8_SA(0, 0), cA, voffA); PG8_STAGE(PG8_SA(0, 1), cA + hstep, voffA);
        if (wr == 1) PG8_BAR;
        PG8_WAIT_V(2); PG8_BAR;
        PG8_STAGE(PG8_SB(1, 0), cB + kstep, voffB); PG8_STAGE(PG8_SA(1, 0), cA + kstep, voffA); PG8_STAGE(PG8_SB(1, 1), cB + hstep + kstep, voffB);
        PG8_WAIT_V(6); PG8_BAR;
    } else {
        PG8_STAGE(PG8_SB(0, 0), cB, voffB); PG8_STAGE(PG8_SA(0, 0), cA, voffA); PG8_STAGE(PG8_SB(0, 1), cB + hstep, voffB); PG8_STAGE(PG8_SA(0, 1), cA + hstep, voffA);
        if (wr == 1) PG8_BAR;
        PG8_WAIT_V(4); PG8_BAR;
        PG8_STAGE(PG8_SB(1, 0), cB + kstep, voffB); PG8_STAGE(PG8_SA(1, 0), cA + kstep, voffA); PG8_STAGE(PG8_SB(1, 1), cB + hstep + kstep, voffB);
        PG8_WAIT_V(6); PG8_BAR;
    }
    for (;;) {
        const bool has_next = S.next(ui + 1, nxt);
        const char* nA = has_next ? (const char*)g.A + (size_t)nxt.pm * tstep : cA; const char* nB = has_next ? (const char*)g.Bt + (size_t)nxt.pn * tstep : cB;
        for (int t = 0; t < nt; t += 2) {
            const bool last = (t == nt - 2);
            const char* a1 = cA + (size_t)(t + 1) * kstep;
            const char* a2 = last ? nA : cA + (size_t)(t + 2) * kstep; const char* b2 = last ? nB : cB + (size_t)(t + 2) * kstep;
            const char* a3 = a2 + kstep; const char* b3 = b2 + kstep;
            if (last && has_next) S.a_ready(nxt);
            if constexpr (SP2) {
            PG8_LDB(B0, 0, 0); PG8_LDB(B1, 0, 1); PG8_SCHED; PG8_LDA(At, 0, 0); PG8_STAGE(PG8_SA(1, 1), a1 + hstep, voffA);
            PG8_WAIT_V(8); PG8_WAIT_L(0); PG8_BAR; PG8_MMA(0, 0, At, B0); PG8_MMA(0, 1, At, B1); PG8_BAR; PG8_SCHED;
            PG8_LDA(At, 0, 1); PG8_STAGE(PG8_SB(0, 0), b2, voffB); PG8_STAGE(PG8_SB(0, 1), b2 + hstep, voffB); PG8_STAGE(PG8_SA(0, 0), a2, voffA);
            PG8_WAIT_V(8); PG8_WAIT_L(0); PG8_BAR; PG8_MMA(1, 0, At, B0); PG8_MMA(1, 1, At, B1); PG8_BAR; PG8_SCHED;
            PG8_LDB(B0, 1, 0); PG8_LDB(B1, 1, 1); PG8_SCHED; PG8_LDA(At, 1, 0); PG8_STAGE(PG8_SA(0, 1), a2 + hstep, voffA);
            PG8_WAIT_V(8); PG8_WAIT_L(0); PG8_BAR; PG8_MMA(0, 0, At, B0); PG8_MMA(0, 1, At, B1); PG8_BAR; PG8_SCHED;
            PG8_LDA(At, 1, 1); PG8_STAGE(PG8_SB(1, 0), b3, voffB); PG8_STAGE(PG8_SB(1, 1), b3 + hstep, voffB); PG8_STAGE(PG8_SA(1, 0), a3, voffA);
            PG8_WAIT_V(8); PG8_WAIT_L(0); PG8_BAR; PG8_MMA(1, 0, At, B0); PG8_MMA(1, 1, At, B1); PG8_BAR; PG8_SCHED;
            } else {
            PG8_LDB(B0, 0, 0); PG8_SCHED; PG8_LDA(At, 0, 0); PG8_STAGE(PG8_SA(1, 1), a1 + hstep, voffA);
            PG8_WAIT_L(8); PG8_BAR; PG8_WAIT_L(0); PG8_MMA(0, 0, At, B0); PG8_BAR; PG8_SCHED;
            PG8_LDB(B1, 0, 1); PG8_STAGE(PG8_SB(0, 0), b2, voffB);
            PG8_BAR; PG8_WAIT_L(0); PG8_MMA(0, 1, At, B1); PG8_BAR;
            PG8_LDA(At, 0, 1); PG8_STAGE(PG8_SA(0, 0), a2, voffA);
            PG8_BAR; PG8_WAIT_L(0); PG8_MMA(1, 0, At, B0); PG8_BAR; PG8_SCHED;
            PG8_STAGE(PG8_SB(0, 1), b2 + hstep, voffB);
            PG8_WAIT_V(6); PG8_BAR; PG8_MMA(1, 1, At, B1); PG8_BAR;
            PG8_LDB(B0, 1, 0); PG8_SCHED; PG8_LDA(At, 1, 0); PG8_STAGE(PG8_SA(0, 1), a2 + hstep, voffA);
            PG8_WAIT_L(8); PG8_BAR; PG8_WAIT_L(0); PG8_MMA(0, 0, At, B0); PG8_BAR; PG8_SCHED;
            PG8_LDB(B1, 1, 1); PG8_STAGE(PG8_SB(1, 0), b3, voffB);
            PG8_BAR; PG8_WAIT_L(0); PG8_MMA(0, 1, At, B1); PG8_BAR;
            PG8_LDA(At, 1, 1); PG8_STAGE(PG8_SA(1, 0), a3, voffA);
            PG8_BAR; PG8_WAIT_L(0); PG8_MMA(1, 0, At, B0); PG8_BAR; PG8_SCHED;
            PG8_STAGE(PG8_SB(1, 1), b3 + hstep, voffB);
            PG8_WAIT_V(6); PG8_BAR; PG8_MMA(1, 1, At, B1); PG8_BAR;
            }
        }
        if constexpr (ALIGN_EPI) { if (wr == 0) PG8_BAR; }
        if constexpr (!Epi::AFTER_DRAIN) { E(acc, cur, wr, wc, fr, fq); S.done(cur); }
        if (!has_next) break;
#pragma unroll
        for (int a = 0; a < 2; ++a)
#pragma unroll
            for (int b = 0; b < 2; ++b)
#pragma unroll
                for (int m = 0; m < 4; ++m)
#pragma unroll
                    for (int n = 0; n < 2; ++n) acc[a][b][m][n] = (f32x4){0.f, 0.f, 0.f, 0.f};
        cur = nxt; cA = nA; cB = nB; ++ui;
        if constexpr (ALIGN_EPI) { if (wr == 1) PG8_BAR; }
    }
    PG8_WAIT_V(0);
    if constexpr (!ALIGN_EPI) { if (wr == 0) PG8_BAR; }
    PG8_BAR;
    if constexpr (Epi::AFTER_DRAIN) { E.fused(acc, cur, wr, wc, fr, fq, lds, wid, lane); S.done(cur); }
#undef PG8_SA
#undef PG8_SB
#undef PG8_STAGE
#undef PG8_LDA
#undef PG8_LDB
#undef PG8_MMA
#undef PG8_WAIT_V
#undef PG8_WAIT_L
#undef PG8_BAR
#undef PG8_SCHED
}
}
#define XB_LAS __attribute__((address_space(3)))
#define XB_TMO      128
#define XB_XCNT(j)  (256  + 64 * (j))
#define XB_XSUB(j)  (1280 + 64 * (j))
#define XB_XGEN(j)  (2304 + 64 * (j))
#define XB_TOP      3328
#define XB_TOPGEN   3392
#define XCD_BAR_WORDS 3456
#define XB_SPIN_CAP (1u << 18)

__device__ __forceinline__ unsigned xb_ld(unsigned* p)              { return __hip_atomic_load(p, __ATOMIC_RELAXED, __HIP_MEMORY_SCOPE_AGENT); }
__device__ __forceinline__ unsigned xb_add(unsigned* p, unsigned v) { return __hip_atomic_fetch_add(p, v, __ATOMIC_RELAXED, __HIP_MEMORY_SCOPE_AGENT); }
__device__ __forceinline__ unsigned xb_xcc_id() { return (unsigned)__builtin_amdgcn_s_getreg((3 << 11) | 20) & 0xFu; }
#define XB_SPIN(cond, bar) do { unsigned _sp = 0; while (cond) { __builtin_amdgcn_s_sleep(1); \
    if ((++_sp & 255u) == 0u) { if (xb_ld(&(bar)[XB_TMO])) break; if (_sp > XB_SPIN_CAP) { atomicAdd(&(bar)[XB_TMO], 1u); break; } } } } while (0)

struct XcdBarrier {
    unsigned* bar; unsigned x;
    volatile XB_LAS unsigned* st;
};

__device__ __forceinline__ XcdBarrier xcd_barrier_post(unsigned* bar, volatile XB_LAS unsigned* st) {
    XcdBarrier b; b.bar = bar; b.x = xb_xcc_id(); b.st = st;
    if (threadIdx.x == 0) (void)xb_add(&bar[XB_XCNT(b.x)], 1u);
    return b;
}
__device__ __forceinline__ void xcd_barrier_complete(unsigned* bar, unsigned x, unsigned& nloc, unsigned& nx) {
    const unsigned G = gridDim.x * gridDim.y * gridDim.z;
    unsigned sum, cnt, mine, sp = 0u;
    for (;;) {
        sum = 0u; cnt = 0u; mine = 0u;
#pragma unroll
        for (unsigned j = 0; j < 16; ++j) { const unsigned c = xb_ld(&bar[XB_XCNT(j)]); sum += c; cnt += (c > 0u) ? 1u : 0u; mine = (j == x) ? c : mine; }
        if (sum == G) break;
        __builtin_amdgcn_s_sleep(1);
        if ((++sp & 255u) == 0u) { if (xb_ld(&bar[XB_TMO])) break; if (sp > XB_SPIN_CAP) { atomicAdd(&bar[XB_TMO], 1u); break; } }
    }
    nloc = mine > 0u ? mine : 1u; nx = cnt > 0u ? cnt : 1u;
}

__device__ __forceinline__ void xcd_barrier(const XcdBarrier& b) {
    asm volatile("s_waitcnt vmcnt(0)" ::: "memory");
    __syncthreads();
    if (threadIdx.x == 0) {
        unsigned* bar = b.bar;
        __builtin_amdgcn_s_waitcnt(0);
        unsigned nloc = b.st[0], nx = b.st[1];
        if (nloc == 0u) { xcd_barrier_complete(bar, b.x, nloc, nx); b.st[0] = nloc; b.st[1] = nx; }
        const unsigned old = xb_add(&bar[XB_XSUB(b.x)], 1u);
        const unsigned gen = old / nloc;
        if (old + 1u == (gen + 1u) * nloc) {
            __builtin_amdgcn_fence(__ATOMIC_RELEASE, "agent");
            asm volatile("s_waitcnt vmcnt(0)" ::: "memory");
            const unsigned og = xb_add(&bar[XB_TOP], 1u);
            const unsigned tg = og / nx;
            if (og + 1u == (tg + 1u) * nx) xb_add(&bar[XB_TOPGEN], 1u);
            else XB_SPIN(xb_ld(&bar[XB_TOPGEN]) == tg, bar);
            __builtin_amdgcn_fence(__ATOMIC_ACQUIRE, "agent");
            xb_add(&bar[XB_XGEN(b.x)], 1u);
            asm volatile("s_waitcnt vmcnt(0)" ::: "memory");
        } else {
            XB_SPIN(xb_ld(&bar[XB_XGEN(b.x)]) == gen, bar);
            __builtin_amdgcn_fence(__ATOMIC_ACQUIRE, "agent");
            asm volatile("s_waitcnt vmcnt(0)" ::: "memory");
        }
    }
    __syncthreads();
}
struct Ptrs {
    const float *x, *meta, *gamma_lb, *a_norm, *a_w_in, *a_out_norm, *a_w_out, *kv_norm, *kv_w, *fox_b_f, *fox_k_norm, *b_norm, *b_w_in, *b_q_norm, *b_w_out;
    float* out; float* sm;
    bf16_t *WT_AIN, *WT_AOUT, *WT_KVB, *WT_BOUT, *WT_F, *XN0, *QS, *VV, *GZ, *OG;
};

struct P0Item { const float* W; const float* g; bf16_t* WT; int ldw, row_off, k0, n0; };
constexpr int P0_I_AIN = 32 * 128, P0_I_AOUT = 32 * 32, P0_I_KV = 32 * 64, P0_I_BIN = 32 * 64, P0_I_BOUT = 32 * 32;
constexpr int P0_NITEMS = P0_I_AIN + P0_I_AOUT + P0_I_KV + P0_I_BIN + P0_I_BOUT;
__device__ __forceinline__ P0Item p0_decode(const Ptrs& P, int it) {
    P0Item I; int r = it, nblk;
    if (r < P0_I_AIN) { I.W = P.a_w_in; I.ldw = 8192; I.g = P.a_norm; I.WT = P.WT_AIN; I.row_off = 0; nblk = 128; }
    else if ((r -= P0_I_AIN) < P0_I_AOUT) { I.W = P.a_w_out; I.ldw = 2048; I.g = P.a_out_norm; I.WT = P.WT_AOUT; I.row_off = 0; nblk = 32; }
    else if ((r -= P0_I_AOUT) < P0_I_KV) { I.W = P.kv_w; I.ldw = 4112; I.g = P.kv_norm; I.WT = P.WT_KVB; I.row_off = 0; nblk = 64; }
    else if ((r -= P0_I_KV) < P0_I_BIN) { I.W = P.b_w_in; I.ldw = 4096; I.g = P.b_norm; I.WT = P.WT_KVB; I.row_off = 4096; nblk = 64; }
    else { r -= P0_I_BIN; I.W = P.b_w_out; I.ldw = 2048; I.g = nullptr; I.WT = P.WT_BOUT; I.row_off = 0; nblk = 32; }
    I.k0 = 64 * (r / nblk); I.n0 = 64 * (r % nblk);
    return I;
}
__device__ __forceinline__ void p0_item_load(const P0Item& I, int lane, f32x4 (&v)[16], float (&gg)[16]) {
    const int c4 = lane & 15, rr = lane >> 4;
#pragma unroll
    for (int i = 0; i < 16; ++i) { const int k = I.k0 + 4 * i + rr; v[i] = *(const f32x4*)(I.W + (size_t)k * I.ldw + I.n0 + 4 * c4); gg[i] = I.g ? I.g[k] : 1.0f; }
}
__device__ __forceinline__ void p0_item_store(const P0Item& I, LAS float* scr, int lane, const f32x4 (&v)[16], const float (&gg)[16]) {
    const int c4 = lane & 15, rr = lane >> 4;
#pragma unroll
    for (int i = 0; i < 16; ++i) { LAS float* p = scr + (4 * i + rr) * 65 + 4 * c4; p[0] = v[i][0] * gg[i]; p[1] = v[i][1] * gg[i]; p[2] = v[i][2] * gg[i]; p[3] = v[i][3] * gg[i]; }
    asm volatile("s_waitcnt lgkmcnt(0)" ::: "memory");
    const int c = lane & 7, nn = lane >> 3;
#pragma unroll
    for (int j = 0; j < 8; ++j) { const int n = nn + 8 * j; const LAS float* q = scr + (8 * c) * 65 + n;
        u32x4 o; o.x = pkbf(q[0 * 65], q[1 * 65]); o.y = pkbf(q[2 * 65], q[3 * 65]); o.z = pkbf(q[4 * 65], q[5 * 65]); o.w = pkbf(q[6 * 65], q[7 * 65]);
        *(u32x4*)(I.WT + (size_t)(I.row_off + I.n0 + n) * DM + I.k0 + 8 * c) = o; }
    asm volatile("s_waitcnt lgkmcnt(0)" ::: "memory");
}
__device__ __forceinline__ void rms_row_to_bf16(const float* xrow, bf16_t* orow, int lane) {
    const f32x4* xr = (const f32x4*)xrow + lane;
    f32x4 v[8]; float s = 0.f;
#pragma unroll
    for (int j = 0; j < 8; ++j) { v[j] = xr[64 * j]; s += (v[j].x * v[j].x + v[j].y * v[j].y) + (v[j].z * v[j].z + v[j].w * v[j].w); }
    const float rstd = __builtin_amdgcn_rsqf(wave_sum(s) * (1.f / DM) + EPS);
    u32x2* o8 = (u32x2*)orow + lane;
#pragma unroll
    for (int j = 0; j < 8; ++j) { u32x2 w; w.x = pkbf(v[j].x * rstd, v[j].y * rstd); w.y = pkbf(v[j].z * rstd, v[j].w * rstd); o8[64 * j] = w; }
}
__device__ __forceinline__ void p0_prologue(const Ptrs& P, LAS unsigned char* lds, int gw, int NGW, int wave, int lane) {
    LAS float* scr = (LAS float*)(lds + wave * 16640);
    {
        int it = gw; f32x4 va[16]; float ga[16];
        if (it < P0_NITEMS) p0_item_load(p0_decode(P, it), lane, va, ga);
        while (it < P0_NITEMS) {
            const int nx = it + NGW; f32x4 vb[16]; float gb[16];
            if (nx < P0_NITEMS) p0_item_load(p0_decode(P, nx), lane, vb, gb);
            p0_item_store(p0_decode(P, it), scr, lane, va, ga);
#pragma unroll
            for (int i = 0; i < 16; ++i) { va[i] = vb[i]; ga[i] = gb[i]; }
            it = nx;
        }
    }
    for (int idx = gw * 64 + lane; idx < 16 * DM; idx += NGW * 64) { const int k = idx >> 4, n = idx & 15;
        P.WT_F[(size_t)n * DM + k] = (bf16_t)(pkbf(P.kv_w[(size_t)k * 4112 + 4096 + n] * P.kv_norm[k], 0.f) & 0xffffu); }
    for (int m = gw; m < MT; m += NGW) rms_row_to_bf16(m < MR ? P.x + (size_t)m * DM : P.meta + (size_t)(m - MR) * DM, P.XN0 + (size_t)m * DM, lane);
    for (int idx = gw * 64 + lane; idx < DM; idx += NGW * 64) P.sm[SM_LBV + idx] = fsigmoid(P.gamma_lb[idx] - P.gamma_lb[DM + idx]);
    for (int idx = gw * 64 + lane; idx < MT; idx += NGW * 64) P.sm[SM_ROWSS + idx] = 0.f;
}

__device__ __forceinline__ f32x4 skinny_tile(const bf16_t* A, const bf16_t* Bt, int lane) {
    const int r = lane & 15, g = lane >> 4;
    const bf16x8* pa = (const bf16x8*)(A + (size_t)r * DM + 8 * g);
    const bf16x8* pb = (const bf16x8*)(Bt + (size_t)r * DM + 8 * g);
    f32x4 acc = {0.f, 0.f, 0.f, 0.f};
#pragma unroll 16
    for (int k = 0; k < DM / 32; ++k) acc = __builtin_amdgcn_mfma_f32_16x16x32_bf16(pa[4 * k], pb[4 * k], acc, 0, 0, 0);
    return acc;
}
__device__ __forceinline__ f32x4 skinny_tile4(const bf16_t* A, const bf16_t* Bt, int lane, int wave, LAS f32x4* xs) {
    const int r = lane & 15, g = lane >> 4, part = wave & 3;
    const bf16x8* pa = (const bf16x8*)(A + (size_t)r * DM + 8 * g + part * (DM / 4));
    const bf16x8* pb = (const bf16x8*)(Bt + (size_t)r * DM + 8 * g + part * (DM / 4));
    f32x4 acc = {0.f, 0.f, 0.f, 0.f};
#pragma unroll
    for (int k = 0; k < DM / 128; ++k) acc = __builtin_amdgcn_mfma_f32_16x16x32_bf16(pa[4 * k], pb[4 * k], acc, 0, 0, 0);
    xs[wave * 64 + lane] = acc;
    __syncthreads();
    const int w0 = wave & ~3;
    const f32x4 t = (xs[w0 * 64 + lane] + xs[(w0 + 1) * 64 + lane]) + (xs[(w0 + 2) * 64 + lane] + xs[(w0 + 3) * 64 + lane]);
    __syncthreads();
    return t;
}
constexpr int HG_LD128 = 136, HG_LD64 = 72, HG_LDO = 132;
constexpr int HG_QI = 0, HG_KI = HG_QI + 64 * HG_LD128 * 2, HG_QD = HG_KI + 64 * HG_LD128 * 2, HG_KDT = HG_QD + 64 * HG_LD128 * 2,
              HG_VT = HG_KDT + 128 * HG_LD64 * 2, HG_AL = HG_VT + 128 * HG_LD64 * 2, HG_ST = HG_AL + 64 * HG_LD64 * 2, HG_RT = HG_ST + 128 * HG_LD128 * 2,
              HG_DEC = HG_RT + 4 * 128 * 4, HG_END = HG_DEC + 128 * 4;
static_assert(HG_END <= 140000 && 64 * HG_LDO * 4 <= HG_QD, "hgrn LDS map (O tile overlays QI + KI)");

template <int MODE>
__device__ __forceinline__ void hgrn_item(LAS unsigned char* lds, const bf16_t* QS, const unsigned short* LOGF, const unsigned short* LOGFM, const bf16_t* VV, const bf16_t* GZ, bf16_t* OG,
                                          float* SEGS, float* DSEG, int b, int h, int seg) {
    const int tid = threadIdx.x, wid = __builtin_amdgcn_readfirstlane(tid >> 6), lane = tid & 63, r = lane & 15, g = lane >> 4;
    const int d = tid & 127, rq = tid >> 7, t0 = 16 * rq;
    LAS bf16_t* QI = (LAS bf16_t*)(lds + HG_QI); LAS bf16_t* KI = (LAS bf16_t*)(lds + HG_KI); LAS bf16_t* QD = (LAS bf16_t*)(lds + HG_QD);
    LAS bf16_t* KDT = (LAS bf16_t*)(lds + HG_KDT); LAS bf16_t* VT = (LAS bf16_t*)(lds + HG_VT); LAS bf16_t* AL = (LAS bf16_t*)(lds + HG_AL);
    LAS bf16_t* ST = (LAS bf16_t*)(lds + HG_ST); LAS float* RT = (LAS float*)(lds + HG_RT); LAS float* DEC = (LAS float*)(lds + HG_DEC);
    LAS float* OL = (LAS float*)(lds + HG_QI);
    const int item = (b * NH + h) * 8 + seg;
    const int c_begin = seg == 0 ? 0 : 8 * seg + 1, c_end = 8 * seg + 9;
    f32x4 Sacc[8];
#pragma unroll
    for (int dt = 0; dt < 8; ++dt) Sacc[dt] = (f32x4){0.f, 0.f, 0.f, 0.f};
    float dsum = 0.f;
    if (MODE == 1) {
#ifdef HG_NOFOLD
        for (int j = 0; j < 0; ++j) {
#else
        for (int j = 0; j < seg; ++j) {
#endif
            const int itj = (b * NH + h) * 8 + j;
            const float* sj = SEGS + (size_t)itj * 16384; const float* dj = DSEG + itj * 128;
#pragma unroll
            for (int dt = 0; dt < 8; ++dt) {
                const f32x4 l4 = *(const f32x4*)(dj + 16 * dt + 4 * g);
#pragma unroll
                for (int q = 0; q < 4; ++q) Sacc[dt][q] = fexp(l4[q]) * Sacc[dt][q] + sj[(16 * dt + 4 * g + q) * 128 + 16 * wid + r];
            }
        }
#pragma unroll
        for (int dt = 0; dt < 8; ++dt) { u32x2 w; w.x = pkbf(Sacc[dt][0], Sacc[dt][1]); w.y = pkbf(Sacc[dt][2], Sacc[dt][3]);
            *(LAS u32x2*)(ST + (16 * wid + r) * HG_LD128 + 16 * dt + 4 * g) = w; }
    }
    float lf[16]; unsigned q16[16], v16[16];
#define HG_LOAD(cc) do { const int c_ = (cc); const bool vld_ = c_ > 0 || rq == 3; const int rb_ = b * SEQ + (c_ - 1) * 64;                                   \
        const unsigned short* lp = c_ == 0 ? LOGFM + h * HD + d : LOGF + (size_t)(rb_ + t0) * DM + h * HD + d;                                                       \
        const size_t o16 = c_ == 0 ? (size_t)MR * DM + h * HD + d : (size_t)(rb_ + t0) * DM + h * HD + d;                                                   \
        _Pragma("unroll") for (int i = 0; i < 16; ++i) { const float x = h2f(lp[(size_t)i * DM]); const unsigned vv = VV[o16 + (size_t)i * DM];                   \
            lf[i] = vld_ ? x : 0.f; v16[i] = vld_ ? vv : 0u;                                                                                                \
            if (MODE == 1) { const unsigned qq = QS[o16 + (size_t)i * DM]; q16[i] = vld_ ? qq : 0u; } } } while (0)
    for (int c = c_begin; c < c_end; ++c) {
        HG_LOAD(c);
        const int rowbase = c == 0 ? (MR - 48) : b * SEQ + (c - 1) * 64;
        float cs[16];
        float run = 0.f;
#pragma unroll
        for (int i = 0; i < 16; ++i) { run += lf[i]; cs[i] = run; }
        RT[rq * 128 + d] = run;
        __syncthreads();
        const float r0 = RT[d], r1 = RT[128 + d], r2 = RT[256 + d], r3 = RT[384 + d];
        const float off = (rq > 0 ? r0 : 0.f) + (rq > 1 ? r1 : 0.f) + (rq > 2 ? r2 : 0.f);
        const float bmid = r0 + r1, blast = (r0 + r1) + (r2 + r3);
        if (rq == 0) { DEC[d] = fexp(blast); dsum += blast; }
        const float emid = fexp(bmid), elast = fexp(blast - bmid);
        {
            float kdv[16];
#pragma unroll
            for (int i = 0; i < 16; ++i) {
                const float bb = off + cs[i];
                const float kk = 1.0f - fexp(lf[i]);
                const float e1 = fexp(bb - bmid), e2 = fexp(bmid - bb);
                const float ki = kk * e2;
                kdv[i] = ki * elast;
                if (MODE == 1) {
                    const float qi = __uint_as_float(q16[i] << 16) * e1;
                    QI[(t0 + i) * HG_LD128 + d] = (bf16_t)(pkbf(qi, 0.f) & 0xffffu);
                    KI[(t0 + i) * HG_LD128 + d] = (bf16_t)(pkbf(ki, 0.f) & 0xffffu);
                    QD[(t0 + i) * HG_LD128 + d] = (bf16_t)(pkbf(qi * emid, 0.f) & 0xffffu);
                }
            }
            u32x4 w0, w1, x0, x1;
            w0.x = pkbf(kdv[0], kdv[1]); w0.y = pkbf(kdv[2], kdv[3]); w0.z = pkbf(kdv[4], kdv[5]); w0.w = pkbf(kdv[6], kdv[7]);
            w1.x = pkbf(kdv[8], kdv[9]); w1.y = pkbf(kdv[10], kdv[11]); w1.z = pkbf(kdv[12], kdv[13]); w1.w = pkbf(kdv[14], kdv[15]);
            x0.x = v16[0] | (v16[1] << 16); x0.y = v16[2] | (v16[3] << 16); x0.z = v16[4] | (v16[5] << 16); x0.w = v16[6] | (v16[7] << 16);
            x1.x = v16[8] | (v16[9] << 16); x1.y = v16[10] | (v16[11] << 16); x1.z = v16[12] | (v16[13] << 16); x1.w = v16[14] | (v16[15] << 16);
            *(LAS u32x4*)(KDT + d * HG_LD64 + t0) = w0; *(LAS u32x4*)(KDT + d * HG_LD64 + t0 + 8) = w1;
            *(LAS u32x4*)(VT + d * HG_LD64 + t0) = x0; *(LAS u32x4*)(VT + d * HG_LD64 + t0 + 8) = x1;
        }
        __syncthreads();
        const int tF = tid >> 3, e0F = 16 * (tid & 7);
        const bool wr_ok = c > 0 ? true : (tF >= 48 && b == 0);
        const size_t off2 = (size_t)(wr_ok ? rowbase + tF : MR) * DM + h * HD + e0F;
        u32x4 z0 = {0u, 0u, 0u, 0u}, z1 = z0;
        if (MODE == 1) { z0 = *(const u32x4*)(GZ + off2); z1 = *(const u32x4*)(GZ + off2 + 8); }
        if (MODE == 1) {
            const int ti = wid & 3, si0 = 2 * (wid >> 2);
#pragma unroll
            for (int sj = 0; sj < 2; ++sj) {
                const int si = si0 + sj;
                f32x4 a4 = {0.f, 0.f, 0.f, 0.f};
                if (si <= ti) {
#pragma unroll
                    for (int k4 = 0; k4 < 4; ++k4) {
                        const bf16x8 fa = *(const LAS bf16x8*)(KI + (16 * si + r) * HG_LD128 + 32 * k4 + 8 * g);
                        const bf16x8 fb = *(const LAS bf16x8*)(QI + (16 * ti + r) * HG_LD128 + 32 * k4 + 8 * g);
                        a4 = __builtin_amdgcn_mfma_f32_16x16x32_bf16(fa, fb, a4, 0, 0, 0);
                    }
                    if (si == ti) {
#pragma unroll
                        for (int q = 0; q < 4; ++q) if (4 * g + q > r) a4[q] = 0.f;
                    }
                }
                u32x2 w; w.x = pkbf(a4[0], a4[1]); w.y = pkbf(a4[2], a4[3]);
                *(LAS u32x2*)(AL + (16 * ti + r) * HG_LD64 + 16 * si + 4 * g) = w;
            }
            __syncthreads();
        }
        bf16x8 bv[2];
        bv[0] = *(const LAS bf16x8*)(VT + (16 * wid + r) * HG_LD64 + 8 * g);
        bv[1] = *(const LAS bf16x8*)(VT + (16 * wid + r) * HG_LD64 + 32 + 8 * g);
        if (MODE == 1) {
            bf16x8 sf[4];
#pragma unroll
            for (int k4 = 0; k4 < 4; ++k4) sf[k4] = *(const LAS bf16x8*)(ST + (16 * wid + r) * HG_LD128 + 32 * k4 + 8 * g);
#pragma unroll
            for (int ti = 0; ti < 4; ++ti) {
                f32x4 o4 = {0.f, 0.f, 0.f, 0.f};
#pragma unroll
                for (int k4 = 0; k4 < 4; ++k4) {
                    const bf16x8 fa = *(const LAS bf16x8*)(QD + (16 * ti + r) * HG_LD128 + 32 * k4 + 8 * g);
                    o4 = __builtin_amdgcn_mfma_f32_16x16x32_bf16(fa, sf[k4], o4, 0, 0, 0);
                }
#pragma unroll
                for (int ks = 0; ks < 2; ++ks) {
                    if (ks == 1 && ti < 2) continue;
                    const bf16x8 fa = *(const LAS bf16x8*)(AL + (16 * ti + r) * HG_LD64 + 32 * ks + 8 * g);
                    o4 = __builtin_amdgcn_mfma_f32_16x16x32_bf16(fa, bv[ks], o4, 0, 0, 0);
                }
#pragma unroll
                for (int q = 0; q < 4; ++q) OL[(16 * ti + 4 * g + q) * HG_LDO + 16 * wid + r] = o4[q];
            }
        }
#pragma unroll
        for (int dt = 0; dt < 8; ++dt) {
            const f32x4 dc = *(const LAS f32x4*)(DEC + 16 * dt + 4 * g);
            Sacc[dt] = Sacc[dt] * dc;
#pragma unroll
            for (int ks = 0; ks < 2; ++ks) {
                const bf16x8 fa = *(const LAS bf16x8*)(KDT + (16 * dt + r) * HG_LD64 + 32 * ks + 8 * g);
                Sacc[dt] = __builtin_amdgcn_mfma_f32_16x16x32_bf16(fa, bv[ks], Sacc[dt], 0, 0, 0);
            }
        }
        if (MODE == 1) {
#pragma unroll
            for (int dt = 0; dt < 8; ++dt) { u32x2 w; w.x = pkbf(Sacc[dt][0], Sacc[dt][1]); w.y = pkbf(Sacc[dt][2], Sacc[dt][3]);
                *(LAS u32x2*)(ST + (16 * wid + r) * HG_LD128 + 16 * dt + 4 * g) = w; }
            __syncthreads();
            const int t = tF, e0 = e0F;
            f32x4 o[4]; float ss = 0.f;
#pragma unroll
            for (int q = 0; q < 4; ++q) { o[q] = *(const LAS f32x4*)(OL + t * HG_LDO + e0 + 4 * q); ss += (o[q][0] * o[q][0] + o[q][1] * o[q][1]) + (o[q][2] * o[q][2] + o[q][3] * o[q][3]); }
            ss += __shfl_xor(ss, 1); ss += __shfl_xor(ss, 2); ss += __shfl_xor(ss, 4);
            const float rstd = __builtin_amdgcn_rsqf(ss * (1.0f / HD) + EPS);
            if (wr_ok) {
                u32x4 w0, w1;
#define HG_G(zw, a, b_) pkbf((a) * rstd * __uint_as_float((zw) << 16), (b_) * rstd * __uint_as_float((zw) & 0xffff0000u))
                w0.x = HG_G(z0.x, o[0][0], o[0][1]); w0.y = HG_G(z0.y, o[0][2], o[0][3]); w0.z = HG_G(z0.z, o[1][0], o[1][1]); w0.w = HG_G(z0.w, o[1][2], o[1][3]);
                w1.x = HG_G(z1.x, o[2][0], o[2][1]); w1.y = HG_G(z1.y, o[2][2], o[2][3]); w1.z = HG_G(z1.z, o[3][0], o[3][1]); w1.w = HG_G(z1.w, o[3][2], o[3][3]);
#undef HG_G
                *(u32x4*)(OG + off2) = w0; *(u32x4*)(OG + off2 + 8) = w1;
            }
        }
        __syncthreads();
    }
#undef HG_LOAD
    if (MODE == 0) {
        float* sj = SEGS + (size_t)item * 16384;
#pragma unroll
        for (int dt = 0; dt < 8; ++dt)
#pragma unroll
            for (int q = 0; q < 4; ++q) sj[(16 * dt + 4 * g + q) * 128 + 16 * wid + r] = Sacc[dt][q];
        if (rq == 0) DSEG[item * 128 + d] = dsum;
    }
}
__device__ __forceinline__ void p1_meta(const Ptrs& P, LAS unsigned char* lds, int gw, int NGW, int wave, int lane) {
    const int r = lane & 15, g = lane >> 4; LAS f32x4* xs = (LAS f32x4*)lds;
    for (int base = 0; base < 512; base += NGW / 4) {
        const int tl = base + (gw >> 2); const bool ok = tl < 512 && (wave & 3) == 0;
        const f32x4 acc = skinny_tile4(P.XN0 + (size_t)MR * DM, P.WT_AIN + (size_t)(tl < 512 ? tl : 0) * 16 * DM, lane, wave, xs);
        if (!ok) continue;
        const int col = tl * 16 + r, type = col >> 11, c = col & 2047;
#pragma unroll
        for (int q = 0; q < 4; ++q) {
            const int mr = 4 * g + q; const float v = acc[q];
            if (type == 0) P.QS[(size_t)(MR + mr) * DM + c] = (bf16_t)(pkbf(fsilu(v), 0.f) & 0xffffu);
            else if (type == 1) { const float lb = P.sm[SM_LBV + c]; ((unsigned short*)(P.sm + SM_LOGFM))[mr * DM + c] = (unsigned short)(pkh(flog(lb + (1.0f - lb) * fsigmoid(v)), 0.f) & 0xffffu); }
            else if (type == 2) P.VV[(size_t)(MR + mr) * DM + c] = (bf16_t)(pkbf(v, 0.f) & 0xffffu);
            else P.GZ[(size_t)(MR + mr) * DM + c] = (bf16_t)(pkbf(fsilu(v), 0.f) & 0xffffu);
        }
    }
}
__device__ __forceinline__ void p4_meta(const Ptrs& P, bf16_t* H1BF, LAS unsigned char* lds, int gw, int NGW, int wave, int lane) {
    const int r = lane & 15, g = lane >> 4; LAS f32x4* xs = (LAS f32x4*)lds;
    for (int base = 0; base < 128; base += NGW / 4) {
        const int tl = base + (gw >> 2); const bool ok = tl < 128 && (wave & 3) == 0;
        const f32x4 acc = skinny_tile4(P.OG + (size_t)MR * DM, P.WT_AOUT + (size_t)(tl < 128 ? tl : 0) * 16 * DM, lane, wave, xs);
        if (!ok) continue;
        const int col = tl * 16 + r;
#pragma unroll
        for (int q = 0; q < 4; ++q) {
            const int mr = 4 * g + q; const float hv = P.meta[mr * DM + col] + acc[q];
            H1BF[(size_t)(MR + mr) * DM + col] = (bf16_t)(pkbf(hv, 0.f) & 0xffffu);
            float ss = hv * hv; ss += __shfl_xor(ss, 1); ss += __shfl_xor(ss, 2); ss += __shfl_xor(ss, 4); ss += __shfl_xor(ss, 8);
            if (r == 0) atomicAdd(P.sm + SM_ROWSS + MR + mr, ss);
        }
    }
}
__device__ __forceinline__ void p5_side(const Ptrs& P, const bf16_t* H1BF, bf16_t* KB, bf16_t* VB, LAS unsigned char* lds, int gw, int NGW, int wave, int lane) {
    const int r = lane & 15, g = lane >> 4; LAS f32x4* xs = (LAS f32x4*)lds;
    for (int base = 0; base < 256 + 513; base += NGW / 4) {
        const int tl = base + (gw >> 2); const bool inr = tl < 256 + 513, ok = inr && (wave & 3) == 0;
        const bool meta = !inr || tl < 256; const int rt = meta ? 0 : tl - 256;
        const bf16_t* A = meta ? H1BF + (size_t)MR * DM : H1BF + (size_t)rt * 16 * DM;
        const bf16_t* Bt = meta ? P.WT_KVB + (size_t)(inr ? tl : 0) * 16 * DM : P.WT_F;
        const f32x4 acc = skinny_tile4(A, Bt, lane, wave, xs);
        if (!ok) continue;
        if (tl < 256) {
            const int col = tl * 16 + r, isv = col >> 11, c = col & 2047, head = c >> 7, dd = c & 127;
#pragma unroll
            for (int q = 0; q < 4; ++q) {
                const int mr = 4 * g + q;
                const float rs = __builtin_amdgcn_rsqf(P.sm[SM_ROWSS + MR + mr] * (1.0f / DM) + EPS);
                const bf16_t v = (bf16_t)(pkbf(acc[q] * rs, 0.f) & 0xffffu);
                bf16_t* bs = isv ? VB : KB;
                bs[((size_t)(0 * NH + head) * SKV + 48 + mr) * HD + dd] = v;
                bs[((size_t)(1 * NH + head) * SKV + 48 + mr) * HD + dd] = v;
            }
        } else {
            const float bf = P.fox_b_f[r];
#pragma unroll
            for (int q = 0; q < 4; ++q) {
                const int row = rt * 16 + 4 * g + q;
                const float rs = __builtin_amdgcn_rsqf(P.sm[SM_ROWSS + row] * (1.0f / DM) + EPS);
                const float xl = acc[q] * rs + bf;
                P.sm[SM_LOGF2 + row * 16 + r] = fminf(xl, 0.f) - flog(1.0f + fexp(-fabsf(xl)));
            }
        }
    }
    for (int idx = gw * 64 + lane; idx < 32 * 48 * 16; idx += NGW * 64) {
        const int bh = idx / (48 * 16), rem = idx % (48 * 16);
        const u32x4 z = {0u, 0u, 0u, 0u};
        *(u32x4*)(KB + (size_t)bh * SKV * HD + rem * 8) = z; *(u32x4*)(VB + (size_t)bh * SKV * HD + rem * 8) = z;
    }
}
__device__ __forceinline__ void p6_norm_scan(const Ptrs& P, bf16_t* KB, bf16_t* QB2, int gw, int NGW, int lane) {
    const int sub = lane >> 4, l16 = lane & 15;
    constexpr int NKR = 32 * SKV, NQR = 32 * SEQ;
    (void)NKR; (void)NQR; (void)QB2;
    for (int r4 = gw; r4 < 32 * 16 / 4; r4 += NGW) {
        const int rr = r4 * 4 + sub, bh = rr >> 4, mr = rr & 15;
        bf16_t* p = KB + ((size_t)bh * SKV + 48 + mr) * HD; const float* gn = P.fox_k_norm + (bh & 15) * HD;
        const u32x4 w = *(const u32x4*)(p + 8 * l16);
        float v[8];
        v[0] = __uint_as_float(w.x << 16); v[1] = __uint_as_float(w.x & 0xffff0000u); v[2] = __uint_as_float(w.y << 16); v[3] = __uint_as_float(w.y & 0xffff0000u);
        v[4] = __uint_as_float(w.z << 16); v[5] = __uint_as_float(w.z & 0xffff0000u); v[6] = __uint_as_float(w.w << 16); v[7] = __uint_as_float(w.w & 0xffff0000u);
        float ss = 0.f;
#pragma unroll
        for (int j = 0; j < 8; ++j) ss += v[j] * v[j];
        ss += __shfl_xor(ss, 1); ss += __shfl_xor(ss, 2); ss += __shfl_xor(ss, 4); ss += __shfl_xor(ss, 8);
        const float rs = __builtin_amdgcn_rsqf(ss * (1.0f / HD) + EPS);
        const f32x4 g0 = *(const f32x4*)(gn + 8 * l16), g1 = *(const f32x4*)(gn + 8 * l16 + 4);
        u32x4 o; o.x = pkbf(v[0] * rs * g0[0], v[1] * rs * g0[1]); o.y = pkbf(v[2] * rs * g0[2], v[3] * rs * g0[3]);
        o.z = pkbf(v[4] * rs * g1[0], v[5] * rs * g1[1]); o.w = pkbf(v[6] * rs * g1[2], v[7] * rs * g1[3]);
        *(u32x4*)(p + 8 * l16) = o;
    }
    if (gw < 32) {
        const int b = gw >> 4, h = gw & 15; float* bias = P.sm + SM_BIAS + gw * SKV;
        if (lane < 48) bias[lane] = -1e30f;
        constexpr int NPOS = NMETA + SEQ, PER = 65;
        float v[PER];
#pragma unroll
        for (int k = 0; k < PER; ++k) {
            const int pos = lane * PER + k, pc = pos < NPOS ? pos : NPOS - 1;
            const int row = pc < NMETA ? MR + pc : b * SEQ + pc - NMETA;
            const float x = P.sm[SM_LOGF2 + row * 16 + h];
            v[k] = pos < NPOS ? x : 0.f;
        }
        float run = 0.f;
#pragma unroll
        for (int k = 0; k < PER; ++k) { run += v[k]; v[k] = run; }
        float tot = run;
#pragma unroll
        for (int o = 1; o < 64; o <<= 1) { const float n = __shfl_up(tot, o); if (lane >= o) tot += n; }
        const float base = tot - run;
#pragma unroll
        for (int k = 0; k < PER; ++k) { const int pos = lane * PER + k; if (pos < NPOS) bias[48 + pos] = -(base + v[k]) * 11.313708498984761f; }
    }
}
namespace attn {
constexpr float SCALE = 0.08838834764831845f;
constexpr float THR = 14.f;
constexpr int NW = 8, QBLK = 32, KVBLK = 64, QB = NW * QBLK, D = 128, OST = 2048;
constexpr int SHM_V = KVBLK * D * 2, SHM_K = KVBLK * D * 2;
constexpr int OFF_WS = 2 * SHM_V + 2 * SHM_K, OFF_BIAS = OFF_WS + NW * 64 * 4, LDS_BYTES = OFF_BIAS + SKV * 4;
constexpr unsigned WBIG = 1u << 30;

#define KSWZ(row, colB) ((row) * 256 + ((colB) ^ (((row) & 7) << 4)))
#define SBAR() __builtin_amdgcn_sched_barrier(0)
__device__ __forceinline__ int v_st(int k, int c) { const int kk = (k & ~0xC) | ((k & 4) << 1) | ((k & 8) >> 1); return ((kk >> 3) * 4 + (c >> 5)) * 512 + ((kk & 7) * 32 + (c & 31)) * 2; }
__device__ __forceinline__ int v_rd_base(int lane) { return ((lane & 3) << 3) | (((lane >> 2) & 3) << 6) | (((lane >> 4) & 1) << 5) | (((lane >> 5) & 1) << 8); }
constexpr int v_rd_off(int d0, int ks, int half) { return d0 * 512 + ks * 4096 + half * 2048; }
__device__ __forceinline__ int crow(int r, int hi) { return (r & 3) + 8 * (r >> 2) + 4 * hi; }
__device__ __forceinline__ void mask_tile(f32x16& p0, f32x16& p1, int dq, unsigned W) {
    const float NEG = -__builtin_inff();
#pragma unroll
    for (int r = 0; r < 16; ++r) {
        const int c = (r & 3) + 8 * (r >> 2);
        if ((unsigned)(dq - c) >= W) p0[r] = NEG;
        if ((unsigned)(dq - c - 32) >= W) p1[r] = NEG;
    }
}
__device__ __forceinline__ void partialSM(f32x16& p0, f32x16& p1, float& m_reg, float& mn, float& alpha) {
    float pmax = p0[0]; for (int r = 1; r < 16; ++r) pmax = fmaxf(pmax, p0[r]); for (int r = 0; r < 16; ++r) pmax = fmaxf(pmax, p1[r]);
    { auto rr = __builtin_amdgcn_permlane32_swap(__float_as_uint(pmax), __float_as_uint(pmax), false, false);
      pmax = fmaxf(__uint_as_float(rr[0]), __uint_as_float(rr[1])); }
    constexpr float C2 = 1.4426950408889634f * SCALE;
    if (__builtin_expect(__all((pmax - m_reg) * SCALE <= THR), 1)) { mn = m_reg; alpha = 1.f; }
    else { mn = fmaxf(m_reg, pmax); alpha = __builtin_amdgcn_exp2f((m_reg - mn) * C2); m_reg = mn; }
    const float mnL = -mn * C2;
    for (int r = 0; r < 16; ++r) p0[r] = fmaf(p0[r], C2, mnL); for (int r = 0; r < 16; ++r) p1[r] = fmaf(p1[r], C2, mnL);
    for (int r = 0; r < 16; ++r) p0[r] = __builtin_amdgcn_exp2f(p0[r]);
}
__device__ __forceinline__ void finishSM(f32x16& p0, f32x16& p1, float alpha, float& l_reg, bf16x8& pa0, bf16x8& pa1, bf16x8& pa2, bf16x8& pa3) {
    for (int r = 0; r < 16; ++r) p1[r] = __builtin_amdgcn_exp2f(p1[r]);
    float ps = 0; for (int r = 0; r < 16; ++r) ps += p0[r]; for (int r = 0; r < 16; ++r) ps += p1[r];
    { auto rr = __builtin_amdgcn_permlane32_swap(__float_as_uint(ps), __float_as_uint(ps), false, false);
      ps = __uint_as_float(rr[0]) + __uint_as_float(rr[1]); }
    l_reg = l_reg * alpha + ps;
#define PK4(P, B_, OUT) do { unsigned a0 = pkbf(P[B_+0], P[B_+1]), a1 = pkbf(P[B_+2], P[B_+3]);                          \
        unsigned b0 = pkbf(P[B_+4], P[B_+5]), b1 = pkbf(P[B_+6], P[B_+7]);                                             \
        auto r0 = __builtin_amdgcn_permlane32_swap(a0, b0, false, false); auto r1 = __builtin_amdgcn_permlane32_swap(a1, b1, false, false); \
        u32x4 w = {r0[0], r1[0], r0[1], r1[1]}; OUT = *reinterpret_cast<bf16x8*>(&w); } while (0)
    PK4(p0, 0, pa0); PK4(p0, 8, pa1); PK4(p1, 0, pa2); PK4(p1, 8, pa3);
#undef PK4
}
template <int KB>
__device__ __forceinline__ void qkt(f32x16& p0, f32x16& p1, const char* K_lds, const float* bl, int r32, int hi, const bf16x8* qr) {
    {
        const f32x4 a0 = *(const f32x4*)(bl), a1 = *(const f32x4*)(bl + 8), a2 = *(const f32x4*)(bl + 16), a3 = *(const f32x4*)(bl + 24);
        const f32x4 c0 = *(const f32x4*)(bl + 32), c1 = *(const f32x4*)(bl + 40), c2 = *(const f32x4*)(bl + 48), c3 = *(const f32x4*)(bl + 56);
        p0 = (f32x16){a0[0], a0[1], a0[2], a0[3], a1[0], a1[1], a1[2], a1[3], a2[0], a2[1], a2[2], a2[3], a3[0], a3[1], a3[2], a3[3]};
        p1 = (f32x16){c0[0], c0[1], c0[2], c0[3], c1[0], c1[1], c1[2], c1[3], c2[0], c2[1], c2[2], c2[3], c3[0], c3[1], c3[2], c3[3]};
    }
    const char* kb[4];
#pragma unroll
    for (int dd = 0; dd < 4; ++dd) kb[dd] = K_lds + KB * SHM_K + KSWZ(r32, (dd * 16 + hi * 8) * 2);
#pragma unroll
    for (int d0 = 0; d0 < 8; ++d0) { const char* a = kb[d0 & 3] + (d0 >> 2) * 128;
        bf16x8 b0 = *reinterpret_cast<const bf16x8*>(a);
        bf16x8 b1 = *reinterpret_cast<const bf16x8*>(a + 32 * 256);
        p0 = __builtin_amdgcn_mfma_f32_32x32x16_bf16(b0, qr[d0], p0, 0, 0, 0);
        p1 = __builtin_amdgcn_mfma_f32_32x32x16_bf16(b1, qr[d0], p1, 0, 0, 0); }
}
template <int VB>
__device__ __forceinline__ void pv_tile(f32x16* o, int vb0, bf16x8 pa0, bf16x8 pa1, bf16x8 pa2, bf16x8 pa3) {
#define TRRD(dst, off) asm volatile("ds_read_b64_tr_b16 %0, %1 offset:%2" : "=&v"(dst) : "v"(vb0), "i"(off) : "memory")
#define PV_D0(d0) do { s16x4 l0, l1, l2, l3, h0, h1, h2, h3; constexpr int b_ = VB * SHM_V + v_rd_off(d0, 0, 0); \
        TRRD(l0, b_); TRRD(h0, b_ + 2048); TRRD(l1, b_ + 4096); TRRD(h1, b_ + 6144); TRRD(l2, b_ + 8192); TRRD(h2, b_ + 10240); TRRD(l3, b_ + 12288); TRRD(h3, b_ + 14336); \
        asm volatile("s_waitcnt lgkmcnt(0)" ::: "memory"); SBAR();   \
        o[d0] = __builtin_amdgcn_mfma_f32_32x32x16_bf16(pa0, (bf16x8){l0[0], l0[1], l0[2], l0[3], h0[0], h0[1], h0[2], h0[3]}, o[d0], 0, 0, 0);   \
        o[d0] = __builtin_amdgcn_mfma_f32_32x32x16_bf16(pa1, (bf16x8){l1[0], l1[1], l1[2], l1[3], h1[0], h1[1], h1[2], h1[3]}, o[d0], 0, 0, 0);   \
        o[d0] = __builtin_amdgcn_mfma_f32_32x32x16_bf16(pa2, (bf16x8){l2[0], l2[1], l2[2], l2[3], h2[0], h2[1], h2[2], h2[3]}, o[d0], 0, 0, 0);   \
        o[d0] = __builtin_amdgcn_mfma_f32_32x32x16_bf16(pa3, (bf16x8){l3[0], l3[1], l3[2], l3[3], h3[0], h3[1], h3[2], h3[3]}, o[d0], 0, 0, 0); } while (0)
    PV_D0(0); PV_D0(1); PV_D0(2); PV_D0(3);
#undef PV_D0
#undef TRRD
}

struct BlockRef { const bf16_t* Q; const bf16_t* K; const bf16_t* V; bf16_t* O; const bf16_t* GZ; const float* BIAS; int P0; };
struct Seam { bf16x8 qr[8]; bf16x8 st_v0, st_v1, st_k0, st_k1; };
#define ROW(p, k0, rr) ((p) + (size_t)((k0) + (rr)) * D + sc)
#define VMW() asm volatile("s_waitcnt vmcnt(0)" ::: "memory")
#define VMWN(n) asm volatile("s_waitcnt vmcnt(%0)" :: "i"(n) : "memory")
#define LD8(p) (*reinterpret_cast<const bf16x8*>(p))
#define SLOAD_H(Kp, Vp, k0) do { S.st_v0 = LD8(ROW(Vp, k0, sr)); S.st_v1 = LD8(ROW(Vp, k0, 32 + sr));              \
                         S.st_k0 = LD8(ROW(Kp, k0, sr)); S.st_k1 = LD8(ROW(Kp, k0, 32 + sr)); } while (0)
#define SWRITE_HK(bf) do { *(bf16x8*)(K_lds + (bf) * SHM_K + kws) = S.st_k0; *(bf16x8*)(K_lds + (bf) * SHM_K + kws + 32 * 256) = S.st_k1; } while (0)
#define SWRITE_HV(bf) do { *(bf16x8*)(V_lds + (bf) * SHM_V + vst0) = S.st_v0; *(bf16x8*)(V_lds + (bf) * SHM_V + vst1) = S.st_v1; } while (0)
#define SWRITE_H(bf) do { SWRITE_HV(bf); SWRITE_HK(bf); } while (0)
__device__ __forceinline__ void causal_prime(const BlockRef& cur, char* lds, Seam& S) {
    const int tid = threadIdx.x, wid = __builtin_amdgcn_readfirstlane(tid >> 6), lane = tid & 63, r32 = lane & 31, hi = lane >> 5;
    const int sr = tid >> 4, sc = (tid & 15) * 8, kws = KSWZ(sr, sc * 2); char* K_lds = lds + 2 * SHM_V;
    for (int d0 = 0; d0 < 8; ++d0) S.qr[d0] = LD8(cur.Q + (size_t)(wid * QBLK + r32) * D + d0 * 16 + hi * 8);
    SLOAD_H(cur.K, cur.V, 0); VMW(); SWRITE_HK(0);
    __syncthreads();
}
__device__ __forceinline__ void causal_block(const BlockRef& cur, char* lds, Seam& S) {
    const int tid = threadIdx.x, wid = __builtin_amdgcn_readfirstlane(tid >> 6), lane = tid & 63, r32 = lane & 31, hi = lane >> 5;
    const int NT = (cur.P0 + QB - 1) / KVBLK + 1;
    const int qlo = cur.P0 + wid * QBLK, qm = qlo + r32 - 4 * hi;
    char* V_lds = lds; char* K_lds = lds + 2 * SHM_V;
    float* ws = (float*)(lds + OFF_WS) + wid * 64; float* li_l = ws, * al_l = ws + 32;
    float* bias_l = (float*)(lds + OFF_BIAS);
    for (int i = tid * 4; i < cur.P0 + QB; i += NW * 64 * 4) *(f32x4*)(bias_l + i) = *(const f32x4*)(cur.BIAS + i);
    __syncthreads();
    float m_reg = -1e30f, l_reg = 0; f32x16 o[4] = {};
    const int sr = tid >> 4, sc = (tid & 15) * 8, vst0 = v_st(sr, sc), vst1 = v_st(32 + sr, sc), kws = KSWZ(sr, sc * 2);
    const int vb0 = (int)(uintptr_t)V_lds + v_rd_base(lane);
    const bf16_t* Kh = cur.K; const bf16_t* Vh = cur.V;
#define RESC(a) do { if (__any((a) < 1.f)) { if (hi == 0) al_l[r32] = (a); asm volatile("s_waitcnt lgkmcnt(0)" ::: "memory");              \
                     for (int d_ = 0; d_ < 4; ++d_) for (int r = 0; r < 16; ++r) o[d_][r] *= al_l[crow(r, hi)]; } } while (0)
#define KBASE(t) ((t) * KVBLK)
#define MASKT(P0_, P1_, t) do { const int kb_ = KBASE(t); if (kb_ + KVBLK - 1 > qlo) mask_tile(P0_, P1_, qm - kb_, WBIG); } while (0)
    constexpr int NQL = 8;
#define SEAM_K0() do { VMWN(NQL); SWRITE_HK(0); SBAR(); } while (0)
    f32x16 pA0, pA1, pB0, pB1; float mnA, mnB, alA, alB; bf16x8 pa0, pa1, pa2, pa3;
    SWRITE_HV(0); SBAR();
    if (NT > 1) { SLOAD_H(Kh, Vh, KBASE(1)); }
    SBAR(); qkt<0>(pA0, pA1, K_lds, bias_l + 4 * hi + KBASE(0), r32, hi, S.qr);
    MASKT(pA0, pA1, 0); partialSM(pA0, pA1, m_reg, mnA, alA);
    if (NT > 1) { VMW(); SWRITE_H(1); }
    __syncthreads();
#define HALF_STEP(PX0, PX1, mnX, alX, PY0, PY1, alY, t, KB, VB, SB) do {                                                      \
        SBAR(); qkt<KB>(PX0, PX1, K_lds, bias_l + 4 * hi + KBASE(t), r32, hi, S.qr);                                             \
        finishSM(PY0, PY1, alY, l_reg, pa0, pa1, pa2, pa3); SBAR();                                                           \
        if ((t) + 1 < NT) { SLOAD_H(Kh, Vh, KBASE((t) + 1)); SBAR(); }                                               \
        pv_tile<VB>(o, vb0, pa0, pa1, pa2, pa3); MASKT(PX0, PX1, (t)); partialSM(PX0, PX1, m_reg, mnX, alX);                                        \
        __syncthreads();                                                                                                      \
        if ((t) + 1 < NT) { VMW(); SWRITE_H(SB); }                                                                          \
        RESC(alX); __syncthreads(); } while (0)
    for (int t = 1; t + 1 < NT; t += 2) {
        HALF_STEP(pB0, pB1, mnB, alB, pA0, pA1, alA, t, 1, 0, 0);
        HALF_STEP(pA0, pA1, mnA, alA, pB0, pB1, alB, t + 1, 0, 1, 1);
    }
    const bool even = (NT & 1) == 0;
    if (even) { SBAR(); qkt<1>(pB0, pB1, K_lds, bias_l + 4 * hi + KBASE(NT - 1), r32, hi, S.qr); SBAR(); }
    SBAR();
    finishSM(pA0, pA1, alA, l_reg, pa0, pa1, pa2, pa3); SBAR();
    pv_tile<0>(o, vb0, pa0, pa1, pa2, pa3);
    if (even) { MASKT(pB0, pB1, NT - 1); partialSM(pB0, pB1, m_reg, mnB, alB); __syncthreads(); RESC(alB);
        finishSM(pB0, pB1, alB, l_reg, pa0, pa1, pa2, pa3); SBAR(); pv_tile<1>(o, vb0, pa0, pa1, pa2, pa3); }
    SBAR();
    if (hi == 0) li_l[r32] = l_reg; asm volatile("s_waitcnt lgkmcnt(0)" ::: "memory");
    float rli[16];
#pragma unroll
    for (int r = 0; r < 16; ++r) rli[r] = __builtin_amdgcn_rcpf(li_l[crow(r, hi)]);
    int eoff = 4 * hi * OST + r32;
    asm volatile("" : "+v"(eoff));
    bf16_t* Ow = cur.O + (size_t)(wid * QBLK) * OST + eoff; const bf16_t* Gw = cur.GZ + (size_t)(wid * QBLK) * OST + eoff;
    unsigned gzv[16][4];
#pragma unroll
    for (int r = 0; r < 16; ++r) { const int ro = ((r & 3) + 8 * (r >> 2)) * OST;
#pragma unroll
        for (int d0 = 0; d0 < 4; ++d0) gzv[r][d0] = Gw[ro + d0 * 32]; }
#pragma unroll
    for (int r = 0; r < 16; ++r) { const int ro = ((r & 3) + 8 * (r >> 2)) * OST;
#pragma unroll
        for (int d0 = 0; d0 < 4; ++d0) { const float v = o[d0][r] * rli[r] * __uint_as_float(gzv[r][d0] << 16);
            const float vn = __shfl_xor(v, 1);
            if ((r32 & 1) == 0) *(unsigned*)(Ow + ro + d0 * 32) = pkbf(v, vn); } }
    __syncthreads();
#undef RESC
#undef KBASE
#undef MASKT
#undef SEAM_K0
#undef HALF_STEP
}
#undef ROW
#undef VMW
#undef VMWN
#undef LD8
#undef SLOAD_H
#undef SWRITE_HK
#undef SWRITE_HV
#undef SWRITE_H

struct Tensors { const bf16_t* Q; const bf16_t* K; const bf16_t* V; bf16_t* O; const bf16_t* GZ; const float* BIAS; };
__device__ __forceinline__ BlockRef make_ref(const Tensors& T, int L, int pass) {
    const int xcd = L & 7, k = L >> 3, bh = xcd * 4 + (k >> 3), x = k & 7, qb = pass ? 15 - x : x, b = bh >> 4, h = bh & 15;
    BlockRef r;
    r.Q = T.Q + ((size_t)bh * SEQ + (size_t)qb * QB) * D; r.K = T.K + (size_t)bh * SKV * D; r.V = T.V + (size_t)bh * SKV * D;
    r.O = T.O + ((size_t)(b * SEQ + qb * QB)) * OST + h * D; r.GZ = T.GZ + ((size_t)(b * SEQ + qb * QB)) * OST + h * D;
    r.BIAS = T.BIAS + bh * SKV; r.P0 = KPAD + qb * QB;
    return r;
}
__device__ __forceinline__ void attn_phase(char* lds, const Tensors& T) {
    const int total = 256, stride = gridDim.x;
    int L = blockIdx.x; if (L >= total) return;
    Seam S;
    for (; L < total; L += stride)
        for (int pass = 0; pass < 2; ++pass) {
            const BlockRef cur = make_ref(T, L, pass);
            causal_prime(cur, lds, S);
            causal_block(cur, lds, S);
        }
}
#undef KSWZ
#undef SBAR
}
constexpr int NWAVES = 8, LDS_BYTES = 147456;
static_assert(pg8::STAGE_BYTES + 8192 <= LDS_BYTES - 256 && pg8::STAGE_BYTES <= LDS_BYTES && HG_END <= LDS_BYTES && attn::LDS_BYTES <= LDS_BYTES, "LDS budget");
constexpr int N_PHASES = 9;
constexpr size_t WS_BAR = 1376256;
constexpr int LDS_MISC = LDS_BYTES - 256;
static_assert(WS_BAR >= (size_t)SM_END * 4 && WS_BAR % 256 == 0 && WS_BAR + 3 * XCD_BAR_WORDS * 4 <= 2 * MiB && HG_END <= LDS_MISC, "barrier words");
struct Args { const float* in[15]; float* out; unsigned char* ws; int ph_lo, ph_hi, li, pad; };

__global__ void __launch_bounds__(NWAVES * 64, 2) yoco_fwd(Args args) {
    extern __shared__ __attribute__((aligned(16))) unsigned char lds_raw[];
    LAS unsigned char* lds = (LAS unsigned char*)lds_raw;
    const int tid = threadIdx.x, lane = tid & 63, wave = __builtin_amdgcn_readfirstlane(tid >> 6);
    const int G = gridDim.x, gw = blockIdx.x * NWAVES + wave, NGW = G * NWAVES;
    unsigned char* ws = args.ws;
    Ptrs P;
    P.x = args.in[0]; P.meta = args.in[1]; P.gamma_lb = args.in[2]; P.a_norm = args.in[3]; P.a_w_in = args.in[4]; P.a_out_norm = args.in[5]; P.a_w_out = args.in[6];
    P.kv_norm = args.in[7]; P.kv_w = args.in[8]; P.fox_b_f = args.in[9]; P.fox_k_norm = args.in[10]; P.b_norm = args.in[11]; P.b_w_in = args.in[12]; P.b_q_norm = args.in[13]; P.b_w_out = args.in[14];
    P.out = args.out; P.sm = (float*)(ws + WS_SMALL);
    P.WT_AIN = (bf16_t*)(ws + WS_WT_AIN); P.WT_AOUT = (bf16_t*)(ws + WS_WT_AOUT); P.WT_KVB = (bf16_t*)(ws + WS_WT_KVB); P.WT_BOUT = (bf16_t*)(ws + WS_WT_BOUT); P.WT_F = (bf16_t*)(ws + WS_WT_F);
    P.XN0 = (bf16_t*)(ws + WS_XN0); P.QS = (bf16_t*)(ws + WS_QS); P.VV = (bf16_t*)(ws + WS_VV); P.GZ = (bf16_t*)(ws + WS_GZ); P.OG = (bf16_t*)(ws + WS_OG);
    bf16_t* H1BF = (bf16_t*)(ws + WS_XN0); bf16_t* KB = (bf16_t*)(ws + WS_QS); bf16_t* VB = (bf16_t*)(ws + WS_VV); bf16_t* QB2 = (bf16_t*)(ws + WS_GZ); bf16_t* GZ2 = (bf16_t*)(ws + WS_OG);
    float* SEGS = (float*)(ws + WS_WT_AIN); bf16_t* OG2 = (bf16_t*)(ws + WS_WT_AIN);
    unsigned short* LOGF = (unsigned short*)args.out;
    const int lo = args.ph_lo, hi = args.ph_hi;
    volatile LAS unsigned* MISC = (volatile LAS unsigned*)(lds + LDS_MISC);
    if (tid < 2) MISC[tid] = 0u;
    __syncthreads();
    const XcdBarrier bar = xcd_barrier_post((unsigned*)(ws + WS_BAR) + args.li * XCD_BAR_WORDS, MISC);
#ifndef PH_MASK
#ifdef DBG_STOP
#define PH_MASK ((2 << DBG_STOP) - 1)
#else
#define PH_MASK 0x1ff
#endif
#endif
#define IN(k) (((PH_MASK >> (k)) & 1) && lo <= (k) && (k) < hi)
#define SEAM(k) do { if (IN(k) && IN((k) + 1)) xcd_barrier(bar); } while (0)

#ifndef PH_DUP
#define PH_DUP -1
#endif
#define GSYNC() xcd_barrier(bar)
#if PH_DUP < 0
#define REP(k)
#define REP_END
#else
#define REP(k) for (int rep_ = 0; rep_ < (PH_DUP == (k) ? 2 : 1); ++rep_) { if (PH_DUP == (k) && rep_ == 1) GSYNC();
#define REP_END }
#endif
#ifdef EXTRA_SYNCS
    for (int es = 0; es < EXTRA_SYNCS; ++es) GSYNC();
#endif
    REP(0)
    if (IN(0)) { p0_prologue(P, lds, gw, NGW, wave, lane); }
    REP_END
    SEAM(0);
    REP(1)
    if (IN(1)) {
        pg8::Gemm g{P.XN0, P.WT_AIN, MR, 8192, DM}; pg8::StaticOrder S; S.init(MR, 8192, G, (int)blockIdx.x);
        pg8::Epi1 E{P.QS, LOGF, P.VV, P.GZ, P.sm + SM_LBV};
        pg8::gemm_phase<pg8::Epi1, pg8::StaticOrder, true, true>(lds, g, S, E);
        p1_meta(P, lds, gw, NGW, wave, lane);
    }
    REP_END
    SEAM(1);
    REP(2)
    if (IN(2)) {
        for (int it = blockIdx.x; it < 32 * 7; it += G) { const int bh = it / 7, seg = it % 7;
            hgrn_item<0>(lds, P.QS, LOGF, (const unsigned short*)(P.sm + SM_LOGFM), P.VV, P.GZ, P.OG, SEGS, P.sm + SM_DSEG, bh >> 4, bh & 15, seg); }
    }
    REP_END
    SEAM(2);
    REP(3)
    if (IN(3)) {
        for (int it = blockIdx.x; it < 256; it += G) { const int bh = it >> 3, seg = it & 7;
            hgrn_item<1>(lds, P.QS, LOGF, (const unsigned short*)(P.sm + SM_LOGFM), P.VV, P.GZ, P.OG, SEGS, P.sm + SM_DSEG, bh >> 4, bh & 15, seg); }
    }
    REP_END
    SEAM(3);
    if (IN(4)) {
        pg8::Gemm g{P.OG, P.WT_AOUT, MR, DM, DM}; pg8::StaticOrder S; S.init(MR, DM, G, (int)blockIdx.x);
        pg8::Epi2 E{P.x, P.out, H1BF, P.sm + SM_ROWSS};
        pg8::gemm_phase<pg8::Epi2, pg8::StaticOrder, true, true>(lds, g, S, E);
        p4_meta(P, H1BF, lds, gw, NGW, wave, lane);
    }
    SEAM(4);
    REP(5)
    if (IN(5)) {
        pg8::Gemm g{H1BF, P.WT_KVB, MR, 8192, DM}; pg8::StaticOrder S; S.init(MR, 8192, G, (int)blockIdx.x);
        pg8::Epi3 E{KB, VB, QB2, GZ2, P.sm + SM_ROWSS, P.fox_k_norm, P.b_q_norm, (LAS float*)(lds + pg8::STAGE_BYTES)};
        pg8::gemm_phase<pg8::Epi3, pg8::StaticOrder, true, true>(lds, g, S, E);
        p5_side(P, H1BF, KB, VB, lds, gw, NGW, wave, lane);
    }
    REP_END
    SEAM(5);
    if (IN(6)) { p6_norm_scan(P, KB, QB2, gw, NGW, lane); }
    SEAM(6);
    REP(7)
    if (IN(7)) {
        const attn::Tensors T{QB2, KB, VB, OG2, GZ2, P.sm + SM_BIAS};
        attn::attn_phase((char*)lds_raw, T);
    }
    REP_END
    SEAM(7);
    if (IN(8)) {
        pg8::Gemm g{OG2, P.WT_BOUT, MR, DM, DM}; pg8::StaticOrder S; S.init(MR, DM, G, (int)blockIdx.x);
        pg8::Epi4 E{H1BF, P.out};
        pg8::gemm_phase<pg8::Epi4, pg8::StaticOrder, true, true>(lds, g, S, E);
    }
#ifdef DBG_STOP
    { xcd_barrier(bar);
      const size_t n = (size_t)MR * DM;
      for (size_t i = (size_t)blockIdx.x * 512 + tid; i < n; i += (size_t)G * 512) {
          float v = 0.f;
          if (DBG_STOP == 1) v = bf2f(P.QS[i]) + bf2f(P.VV[i]) + bf2f(P.GZ[i]);
          if (DBG_STOP == 2) v = (i < (size_t)224 * 16384 ? SEGS[(i / (7 * 16384)) * (8 * 16384) + (i % (7 * 16384))] : 0.f) + (i < 32768 ? P.sm[SM_LOGFM + i] : 0.f) + (i < 16 * DM ? bf2f(P.QS[(size_t)MR * DM + i]) + bf2f(P.VV[(size_t)MR * DM + i]) + bf2f(P.GZ[(size_t)MR * DM + i]) : 0.f);
          if (DBG_STOP == 3) v = bf2f(P.OG[i]);
          if (DBG_STOP == 4) v = args.out[i] + bf2f(H1BF[i]);
          if (DBG_STOP == 5 || DBG_STOP == 6) v = bf2f(KB[i]) + bf2f(VB[i]) + bf2f(QB2[i]) + bf2f(GZ2[i]) + (i < 32 * SKV ? P.sm[SM_BIAS + i] * 1e-3f : 0.f);
          if (DBG_STOP == 7) v = bf2f(OG2[i]);
          args.out[i] = v;
      } }
#endif
#undef IN
#undef SEAM
}

#ifndef MK_PER_PHASE
#define MK_PER_PHASE 0
#endif
extern "C" void kernel_launch(void* const* d_in, const int* in_sizes, int n_in, void* d_out, int out_size, void* d_ws, size_t ws_size, hipStream_t stream) {
    static int grid = 0;
    if (grid == 0) {
        if (n_in != 15 || out_size != MR * DM || ws_size < WS_END) { fprintf(stderr, "kernel_launch: unexpected shapes (n_in %d, out %d, ws %zu)\n", n_in, out_size, ws_size); grid = -1; return; }
        int dev = 0, cus = 0, per_cu = 0;
        (void)hipGetDevice(&dev); (void)hipDeviceGetAttribute(&cus, hipDeviceAttributeMultiprocessorCount, dev);
        if (hipFuncSetAttribute((const void*)yoco_fwd, hipFuncAttributeMaxDynamicSharedMemorySize, LDS_BYTES) != hipSuccess) { fprintf(stderr, "kernel_launch: hipFuncSetAttribute failed\n"); grid = -1; return; }
        if (hipOccupancyMaxActiveBlocksPerMultiprocessor(&per_cu, (const void*)yoco_fwd, NWAVES * 64, LDS_BYTES) != hipSuccess || per_cu < 1) { fprintf(stderr, "kernel_launch: occupancy query says %d blocks per CU\n", per_cu); per_cu = 1; }
        (void)hipGetLastError();
        grid = cus > 0 ? cus : 256;
    }
    if (grid < 0) return;
    if (hipMemsetAsync((char*)d_ws + WS_BAR, 0, 3 * XCD_BAR_WORDS * 4, stream) != hipSuccess) { fprintf(stderr, "kernel_launch: hipMemsetAsync failed\n"); return; }
    Args a{};
    for (int i = 0; i < 15; ++i) a.in[i] = (const float*)d_in[i];
    a.out = (float*)d_out; a.ws = (unsigned char*)d_ws;
#if defined(DUP_PHASE)
    {
        const int cuts[4][2] = {{0, DUP_PHASE + 1}, {DUP_PHASE, DUP_PHASE + 1}, {DUP_PHASE + 1, N_PHASES}, {0, 0}};
        for (int li = 0; li < 3; ++li) { if (cuts[li][0] >= cuts[li][1]) continue; a.ph_lo = cuts[li][0]; a.ph_hi = cuts[li][1]; a.li = li; void* kargs[] = {&a};
            hipError_t e = hipLaunchCooperativeKernel((const void*)yoco_fwd, dim3(grid), dim3(NWAVES * 64), kargs, LDS_BYTES, stream);
            if (e != hipSuccess) { fprintf(stderr, "kernel_launch: launch %d failed: %s\n", li, hipGetErrorString(e)); break; } }
    }
#elif MK_PER_PHASE
    for (int p = 0; p < N_PHASES; ++p) { a.ph_lo = p; a.ph_hi = p + 1; void* kargs[] = {&a};
        hipError_t e = hipLaunchCooperativeKernel((const void*)yoco_fwd, dim3(grid), dim3(NWAVES * 64), kargs, LDS_BYTES, stream);
        if (e != hipSuccess) { fprintf(stderr, "kernel_launch: launch of phase %d failed: %s\n", p, hipGetErrorString(e)); break; } }
#else
    a.ph_lo = 0; a.ph_hi = N_PHASES; void* kargs[] = {&a};
    hipError_t e = hipLaunchCooperativeKernel((const void*)yoco_fwd, dim3(grid), dim3(NWAVES * 64), kargs, LDS_BYTES, stream);
    if (e != hipSuccess) fprintf(stderr, "kernel_launch: cooperative launch failed: %s (grid %d)\n", hipGetErrorString(e), grid);
#endif
}
```

```cpp
#include <hip/hip_runtime.h>
#include <hip/hip_cooperative_groups.h>
#include <cstdio>
#include <cstdint>
namespace cg = cooperative_groups;

constexpr int NB = 2, SEQ = 4096, DM = 2048, NH = 16, HD = 128, NMETA = 16;
constexpr int MR = NB * SEQ;
constexpr int MT = MR + NMETA;
constexpr int KPAD = 64;
constexpr int SKV = SEQ + KPAD;
constexpr float EPS = 1e-6f;

constexpr size_t MiB = 1u << 20;
constexpr size_t WS_SMALL = 0;
constexpr size_t WS_WT_AIN = 2 * MiB;
constexpr size_t WS_WT_AOUT = 34 * MiB;
constexpr size_t WS_WT_KVB = 42 * MiB;
constexpr size_t WS_WT_BOUT = 74 * MiB;
constexpr size_t WS_WT_F = 82 * MiB;
constexpr size_t WS_XN0 = 83 * MiB;
constexpr size_t WS_QS = 116 * MiB;
constexpr size_t WS_VV = 149 * MiB;
constexpr size_t WS_GZ = 182 * MiB;
constexpr size_t WS_OG = 215 * MiB;
constexpr size_t WS_END = 248 * MiB;
static_assert(WS_VV - WS_QS == 33 * MiB && WS_GZ - WS_VV == 33 * MiB, "Epi1 selects QS | VV | GZ by stride");
constexpr int SM_ROWSS = 0;
constexpr int SM_LBV = 8448;
constexpr int SM_LOGFM = 10496;
constexpr int SM_LOGF2 = 43264;
constexpr int SM_BIAS = 174592;
constexpr int SM_DSEG = 307712;
constexpr int SM_END = 340480;
static_assert(SM_LBV >= SM_ROWSS + MT && SM_LOGFM >= SM_LBV + 2048 && SM_LOGF2 >= SM_LOGFM + 16 * 2048 && SM_BIAS >= SM_LOGF2 + MT * 16 && SM_DSEG >= SM_BIAS + 32 * SKV && SM_END >= SM_DSEG + 256 * 128 && SM_END * 4 <= 2 * (int)MiB, "small map");

#define LAS __attribute__((address_space(3)))
typedef unsigned short bf16_t;
typedef short bf16x8 __attribute__((ext_vector_type(8)));
typedef short s16x4 __attribute__((ext_vector_type(4)));
typedef float f32x4 __attribute__((ext_vector_type(4)));
typedef float f32x16 __attribute__((ext_vector_type(16)));
typedef unsigned u32x4 __attribute__((ext_vector_type(4)));
typedef unsigned u32x2 __attribute__((ext_vector_type(2)));

__device__ __forceinline__ float bf2f(bf16_t v) { return __uint_as_float(((unsigned)v) << 16); }
typedef __bf16 bf16x2_t __attribute__((ext_vector_type(2)));
typedef float f32x2_t __attribute__((ext_vector_type(2)));
__device__ __forceinline__ unsigned pkbf(float lo, float hi) { f32x2_t v = {lo, hi}; bf16x2_t b = __builtin_convertvector(v, bf16x2_t); return __builtin_bit_cast(unsigned, b); }
typedef _Float16 f16x2_t __attribute__((ext_vector_type(2)));
__device__ __forceinline__ unsigned pkh(float lo, float hi) { f32x2_t v = {lo, hi}; f16x2_t b = __builtin_convertvector(v, f16x2_t); return __builtin_bit_cast(unsigned, b); }
__device__ __forceinline__ float h2f(unsigned v) { return (float)__builtin_bit_cast(_Float16, (unsigned short)v); }
__device__ __forceinline__ float fexp(float x) { return __builtin_amdgcn_exp2f(x * 1.4426950408889634f); }
__device__ __forceinline__ float fsigmoid(float x) { return __builtin_amdgcn_rcpf(1.0f + fexp(-x)); }
__device__ __forceinline__ float fsilu(float x) { return x * fsigmoid(x); }
__device__ __forceinline__ float flog(float x) { return __builtin_amdgcn_logf(x) * 0.6931471805599453f; }
__device__ __forceinline__ float wave_sum(float v) {
#pragma unroll
    for (int o = 1; o < 64; o <<= 1) v += __shfl_xor(v, o);
    return v;
}
namespace pg8 {
#define PG8_LAS __attribute__((address_space(3)))
typedef unsigned short bf16_t;
typedef short bf16x8 __attribute__((ext_vector_type(8)));
typedef float f32x4 __attribute__((ext_vector_type(4)));
typedef unsigned u32x4 __attribute__((ext_vector_type(4)));
constexpr int BM = 256, BK = 64, HALF = 128, HTB = HALF * BK * 2  , STAGE_BYTES = 8 * HTB, NXCD = 8, WGM = 8;

__host__ __device__ __forceinline__ int lds_byte(int r, int c) { const int st = (r >> 4) * 2 + (c >> 5), rr = r & 15, cc = c & 31, ob = rr * 64 + cc * 2; return st * 1024 + (ob ^ (((ob >> 9) & 1) << 5)); }
__host__ __device__ __forceinline__ void stage_rc(int b, int& R, int& C) { const int st = b / 1024, sb = b % 1024, swz = sb ^ (((sb >> 9) & 1) << 5); R = (st >> 1) * 16 + swz / 64; C = (st & 1) * 32 + (swz % 64) / 2; }
__host__ __device__ __forceinline__ int perm32(int rho) { const int n = rho >> 4, i = rho & 15; return 8 * (i >> 2) + 4 * n + (i & 3); }

struct Unit { int pm, pn; };
struct Gemm { const bf16_t* A; const bf16_t* Bt; int M, N, K; };

struct StaticOrder {
    int nM, nN, nwg, G, c;
    __host__ __device__ void init(int M, int N, int G_, int c_) { nM = M / BM; nN = N / BM; nwg = nM * nN; G = G_; c = c_; }
    __host__ __device__ bool next(int i, Unit& u) const {
        const long L = (long)i * G + c; if (L >= nwg) return false;
        int wgid = (int)L; { const int q = nwg / NXCD, r = nwg % NXCD, xcd = wgid % NXCD, off = wgid / NXCD; wgid = (xcd < r ? xcd * (q + 1) : r * (q + 1) + (xcd - r) * q) + off; }
        const int nig = WGM * nN, gid = wgid / nig, fm = gid * WGM, gsz = (nM - fm) < WGM ? (nM - fm) : WGM;
        u.pm = fm + ((wgid % nig) % gsz); u.pn = (wgid % nig) / gsz; return true;
    }
    __device__ __forceinline__ void a_ready(const Unit&) const {}
    __device__ __forceinline__ void done(const Unit&) const {}
};
__device__ __forceinline__ unsigned cvt_pk_bf16(float lo, float hi) { unsigned r; asm volatile("v_cvt_pk_bf16_f32 %0, %1, %2" : "=v"(r) : "v"(lo), "v"(hi)); return r; }
struct Epi1 {
    static constexpr bool PERM = true, AFTER_DRAIN = false;
    bf16_t* QS; unsigned short* LOGF; bf16_t* VV; bf16_t* GZ; const float* lbv;
    __device__ __forceinline__ void operator()(const f32x4 (&acc)[2][2][4][2], const Unit& u, int wr, int wc, int fr, int fq) const {
        const int type = u.pn >> 3, colt = (u.pn & 7) * BM;
        const int row0 = u.pm * BM + wr * 64 + fr, col0 = colt + wc * 32 + 8 * fq;
        if (type == 1) {
#pragma unroll
            for (int bj = 0; bj < 2; ++bj) {
                const f32x4 l0 = *(const f32x4*)(lbv + col0 + bj * HALF), l1 = *(const f32x4*)(lbv + col0 + bj * HALF + 4);
#pragma unroll
                for (int ai = 0; ai < 2; ++ai)
#pragma unroll
                    for (int m = 0; m < 4; ++m) {
                        unsigned short* rowp = LOGF + (size_t)(row0 + ai * HALF + m * 16) * DM + col0 + bj * HALF;
                        f32x4 v0 = acc[ai][bj][m][0], v1 = acc[ai][bj][m][1], o0, o1;
#pragma unroll
                        for (int j = 0; j < 4; ++j) { o0[j] = flog(l0[j] + (1.0f - l0[j]) * fsigmoid(v0[j])); o1[j] = flog(l1[j] + (1.0f - l1[j]) * fsigmoid(v1[j])); }
                        u32x4 w; w.x = pkh(o0[0], o0[1]); w.y = pkh(o0[2], o0[3]); w.z = pkh(o1[0], o1[1]); w.w = pkh(o1[2], o1[3]);
                        *(u32x4*)rowp = w;
                    }
            }
        } else {
            bf16_t* base = QS + (size_t)(type - (type > 0 ? 1 : 0)) * (size_t)(33u << 19);
            const bool act = type != 2;
#pragma unroll
            for (int ai = 0; ai < 2; ++ai)
#pragma unroll
                for (int m = 0; m < 4; ++m) {
                    bf16_t* rowp = base + (size_t)(row0 + ai * HALF + m * 16) * DM + col0;
#pragma unroll
                    for (int bj = 0; bj < 2; ++bj) {
                        f32x4 v0 = acc[ai][bj][m][0], v1 = acc[ai][bj][m][1];
                        if (act) {
#pragma unroll
                            for (int j = 0; j < 4; ++j) { v0[j] = fsilu(v0[j]); v1[j] = fsilu(v1[j]); }
                        }
                        u32x4 w; w.x = pkbf(v0[0], v0[1]); w.y = pkbf(v0[2], v0[3]); w.z = pkbf(v1[0], v1[1]); w.w = pkbf(v1[2], v1[3]);
                        *(u32x4*)(rowp + bj * HALF) = w;
                    }
                }
        }
    }
};
struct Epi2 {
    static constexpr bool PERM = false, AFTER_DRAIN = false;
    const float* X; float* H1; bf16_t* H1BF; float* rowss;
    __device__ __forceinline__ void operator()(const f32x4 (&acc)[2][2][4][2], const Unit& u, int wr, int wc, int fr, int fq) const {
        const int row0 = u.pm * BM + wr * 64 + fr, col0 = u.pn * BM + wc * 32 + 4 * fq;
#pragma unroll
        for (int ai = 0; ai < 2; ++ai)
#pragma unroll
            for (int m = 0; m < 4; ++m) {
                const int row = row0 + ai * HALF + m * 16; const size_t off = (size_t)row * DM + col0; float ss = 0.f;
#pragma unroll
                for (int bj = 0; bj < 2; ++bj)
#pragma unroll
                    for (int n = 0; n < 2; ++n) {
                        const f32x4 h = *(const f32x4*)(X + off + bj * HALF + n * 16) + acc[ai][bj][m][n];
                        u32x2 w; w.x = pkbf(h[0], h[1]); w.y = pkbf(h[2], h[3]);
                        *(u32x2*)(H1BF + off + bj * HALF + n * 16) = w;
                        ss += (h[0] * h[0] + h[1] * h[1]) + (h[2] * h[2] + h[3] * h[3]);
                    }
                ss += __shfl_xor(ss, 16); ss += __shfl_xor(ss, 32);
                if (fq == 0) atomicAdd(rowss + row, ss);
                asm volatile("" ::: "memory");
            }
    }
};
struct Epi3 {
    static constexpr bool PERM = true, AFTER_DRAIN = false;
    bf16_t* KB; bf16_t* VB; bf16_t* QB2; bf16_t* GZ2; const float* rowss; const float* gk; const float* gq; PG8_LAS float* xs;
    __device__ __forceinline__ void operator()(const f32x4 (&acc)[2][2][4][2], const Unit& u, int wr, int wc, int fr, int fq) const {
        const int type = u.pn >> 3, row0 = u.pm * BM + wr * 64 + fr;
        const int b = row0 >> 12;
        float rs[2][4];
#pragma unroll
        for (int ai = 0; ai < 2; ++ai)
#pragma unroll
            for (int m = 0; m < 4; ++m) rs[ai][m] = __builtin_amdgcn_rsqf(rowss[row0 + ai * HALF + m * 16] * (1.0f / DM) + EPS);
        const bool normed = (type == 0 || type == 2);
        if (normed) {
#pragma unroll
            for (int ai = 0; ai < 2; ++ai)
#pragma unroll
                for (int m = 0; m < 4; ++m)
#pragma unroll
                    for (int bj = 0; bj < 2; ++bj) {
                        const f32x4 v0 = acc[ai][bj][m][0] * rs[ai][m], v1 = acc[ai][bj][m][1] * rs[ai][m];
                        float ss = (v0[0] * v0[0] + v0[1] * v0[1]) + (v0[2] * v0[2] + v0[3] * v0[3]) + (v1[0] * v1[0] + v1[1] * v1[1]) + (v1[2] * v1[2] + v1[3] * v1[3]);
                        ss += __shfl_xor(ss, 16); ss += __shfl_xor(ss, 32);
                        if (fq == 0) xs[((ai * HALF + wr * 64 + m * 16 + fr) * 2 + bj) * 4 + wc] = ss;
                    }
            asm volatile("s_waitcnt lgkmcnt(0)" ::: "memory"); __builtin_amdgcn_s_barrier(); asm volatile("" ::: "memory");
        }
#pragma unroll
        for (int bj = 0; bj < 2; ++bj) {
            const int head = (u.pn & 7) * 2 + bj, bh = b * NH + head;
            f32x4 g0 = {1.f, 1.f, 1.f, 1.f}, g1 = g0;
            if (normed) { const float* gp = (type == 0 ? gk : gq) + head * HD + wc * 32 + 8 * fq; g0 = *(const f32x4*)gp; g1 = *(const f32x4*)(gp + 4); }
#pragma unroll
            for (int ai = 0; ai < 2; ++ai)
#pragma unroll
                for (int m = 0; m < 4; ++m) {
                    const int row = row0 + ai * HALF + m * 16, t = row & (SEQ - 1);
                    float sc = rs[ai][m];
                    if (normed) { const f32x4 p4 = *(const PG8_LAS f32x4*)(xs + ((ai * HALF + wr * 64 + m * 16 + fr) * 2 + bj) * 4);
                        sc *= __builtin_amdgcn_rsqf(((p4[0] + p4[1]) + (p4[2] + p4[3])) * (1.0f / HD) + EPS); }
                    f32x4 v0 = acc[ai][bj][m][0] * sc * g0, v1 = acc[ai][bj][m][1] * sc * g1;
                    bf16_t* dst;
                    if (type == 3) {
#pragma unroll
                        for (int j = 0; j < 4; ++j) { v0[j] = fsilu(v0[j]); v1[j] = fsilu(v1[j]); }
                        dst = GZ2 + (size_t)row * DM + (u.pn & 7) * BM + bj * HALF + wc * 32 + 8 * fq;
                    } else if (type == 2) dst = QB2 + ((size_t)bh * SEQ + t) * HD + wc * 32 + 8 * fq;
                    else dst = (type == 0 ? KB : VB) + ((size_t)bh * SKV + KPAD + t) * HD + wc * 32 + 8 * fq;
                    u32x4 w; w.x = pkbf(v0[0], v0[1]); w.y = pkbf(v0[2], v0[3]); w.z = pkbf(v1[0], v1[1]); w.w = pkbf(v1[2], v1[3]);
                    *(u32x4*)dst = w;
                }
        }
    }
};
struct Epi4 {
    static constexpr bool PERM = false, AFTER_DRAIN = false;
    const bf16_t* H1BF; float* OUT;
    __device__ __forceinline__ void operator()(const f32x4 (&acc)[2][2][4][2], const Unit& u, int wr, int wc, int fr, int fq) const {
        const int row0 = u.pm * BM + wr * 64 + fr, col0 = u.pn * BM + wc * 32 + 4 * fq;
#pragma unroll
        for (int ai = 0; ai < 2; ++ai)
#pragma unroll
            for (int m = 0; m < 4; ++m) {
                const size_t off = (size_t)(row0 + ai * HALF + m * 16) * DM + col0;
#pragma unroll
                for (int bj = 0; bj < 2; ++bj)
#pragma unroll
                    for (int n = 0; n < 2; ++n) {
                        const u32x2 w = *(const u32x2*)(H1BF + off + bj * HALF + n * 16);
                        const f32x4 h = {__uint_as_float(w.x << 16), __uint_as_float(w.x & 0xffff0000u), __uint_as_float(w.y << 16), __uint_as_float(w.y & 0xffff0000u)};
                        *(f32x4*)(OUT + off + bj * HALF + n * 16) = h + acc[ai][bj][m][n];
                    }
                asm volatile("" ::: "memory");
            }
    }
};
template <class Epi, class Sched, bool ALIGN_EPI = false, bool SP2 = false>
__device__ __forceinline__ void gemm_phase(PG8_LAS unsigned char* lds, const Gemm g, const Sched& S, const Epi& E) {
    const int tid = threadIdx.x, wid = __builtin_amdgcn_readfirstlane(tid >> 6), lane = tid & 63, wr = wid >> 2, wc = wid & 3, fr = lane & 15, fq = lane >> 4;
    const int K = g.K, nt = K / BK;
    unsigned voffA[2], voffB[2];
#pragma unroll
    for (int i = 0; i < 2; ++i) { int R, C; stage_rc(tid * 16 + i * 8192, R, C); const int Rb = Epi::PERM ? ((R & ~31) + perm32(R & 31)) : R;
        voffA[i] = (unsigned)(R * K + C) * 2u; voffB[i] = (unsigned)(Rb * K + C) * 2u; }
    const size_t kstep = (size_t)(BK * 2);
    const size_t hstep = (size_t)HALF * K * 2;
    const size_t tstep = 2 * hstep;
    const unsigned ldsw = (unsigned)wid * 1024u;
    const int aoff = lds_byte(wr * 64 + fr, fq * 8), boff = lds_byte(wc * 32 + fr, fq * 8);
#define PG8_SA(b, h) (((b) * 2 + (h)) * HTB)
#define PG8_SB(b, h) ((4 + (b) * 2 + (h)) * HTB)
#define PG8_STAGE(bufoff, gbase, voff) do { _Pragma("unroll") for (int _i = 0; _i < 2; ++_i) \
        __builtin_amdgcn_global_load_lds((const unsigned*)((const char*)(gbase) + (voff)[_i]), (PG8_LAS unsigned*)(lds + (bufoff) + ldsw + _i * 8192), 16, 0, 0); } while (0)
#define PG8_LDA(dst, b, h) do { _Pragma("unroll") for (int m = 0; m < 4; ++m) _Pragma("unroll") for (int k = 0; k < 2; ++k) dst[m][k] = *(const PG8_LAS bf16x8*)(lds + PG8_SA(b, h) + aoff + m * 2048 + k * 1024); } while (0)
#define PG8_LDB(dst, b, h) do { _Pragma("unroll") for (int n = 0; n < 2; ++n) _Pragma("unroll") for (int k = 0; k < 2; ++k) dst[n][k] = *(const PG8_LAS bf16x8*)(lds + PG8_SB(b, h) + boff + n * 2048 + k * 1024); } while (0)
#define PG8_MMA(ai, bj, At, Bt) do { __builtin_amdgcn_s_setprio(1); _Pragma("unroll") for (int m = 0; m < 4; ++m) _Pragma("unroll") for (int n = 0; n < 2; ++n) _Pragma("unroll") for (int k = 0; k < 2; ++k) \
        acc[ai][bj][m][n] = __builtin_amdgcn_mfma_f32_16x16x32_bf16(Bt[n][k], At[m][k], acc[ai][bj][m][n], 0, 0, 0); __builtin_amdgcn_s_setprio(0); } while (0)
#define PG8_WAIT_V(n) asm volatile("s_waitcnt vmcnt(" #n ")" ::: "memory")
#define PG8_WAIT_L(n) asm volatile("s_waitcnt lgkmcnt(" #n ")" ::: "memory")
#define PG8_BAR __builtin_amdgcn_s_barrier()
#define PG8_SCHED __builtin_amdgcn_sched_barrier(0)
    Unit cur, nxt; int ui = 0;
    if (!S.next(0, cur)) return;
    f32x4 acc[2][2][4][2];
#pragma unroll
    for (int a = 0; a < 2; ++a)
#pragma unroll
        for (int b = 0; b < 2; ++b)
#pragma unroll
            for (int m = 0; m < 4; ++m)
#pragma unroll
                for (int n = 0; n < 2; ++n) acc[a][b][m][n] = (f32x4){0.f, 0.f, 0.f, 0.f};
    bf16x8 At[4][2], B0[2][2], B1[2][2];
    const char* cA = (const char*)g.A + (size_t)cur.pm * tstep; const char* cB = (const char*)g.Bt + (size_t)cur.pn * tstep;
    S.a_ready(cur);
    if constexpr (SP2) {
        PG8_STAGE(PG8_SB(0, 0), cB, voffB); PG8_STAGE(PG8_SB(0, 1), cB + hstep, voffB); PG8_STAGE(PG8_SA(0, 0), cA, voffA); PG8_STAGE(PG8_SA(0, 1), cA + hstep, voffA);
        if (wr == 1) PG8_BAR;
        PG8_WAIT_V(2); PG8_BAR;
        PG8_STAGE(PG8_SB(1, 0), cB + kstep, voffB); PG8_STAGE(PG8_SA(1, 0), cA + kstep, voffA); PG8_STAGE(PG8_SB(1, 1), cB + hstep + kstep, voffB);
        PG8_WAIT_V(6); PG8_BAR;
    } else {
        PG8_STAGE(PG8_SB(0, 0), cB, voffB); PG8_STAGE(PG8_SA(0, 0), cA, voffA); PG8_STAGE(PG8_SB(0, 1), cB + hstep, voffB); PG8_STAGE(PG8_SA(0, 1), cA + hstep, voffA);
        if (wr == 1) PG8_BAR;
        PG8_WAIT_V(4); PG8_BAR;
        PG8_STAGE(PG8_SB(1, 0), cB + kstep, voffB); PG8_STAGE(PG8_SA(1, 0), cA + kstep, voffA); PG8_STAGE(PG8_SB(1, 1), cB + hstep + kstep, voffB);
        PG8_WAIT_V(6); PG8_BAR;
    }
    for (;;) {
        const bool has_next = S.next(ui + 1, nxt);
        const char* nA = has_next ? (const char*)g.A + (size_t)nxt.pm * tstep : cA; const char* nB = has_next ? (const char*)g.Bt + (size_t)nxt.pn * tstep : cB;
        for (int t = 0; t < nt; t += 2) {
            const bool last = (t == nt - 2);
            const char* a1 = cA + (size_t)(t + 1) * kstep;
            const char* a2 = last ? nA : cA + (size_t)(t + 2) * kstep; const char* b2 = last ? nB : cB + (size_t)(t + 2) * kstep;
            const char* a3 = a2 + kstep; const char* b3 = b2 + kstep;
            if (last && has_next) S.a_ready(nxt);
            if constexpr (SP2) {
            PG8_LDB(B0, 0, 0); PG8_LDB(B1, 0, 1); PG8_SCHED; PG8_LDA(At, 0, 0); PG8_STAGE(PG8_SA(1, 1), a1 + hstep, voffA);
            PG8_WAIT_V(8); PG8_WAIT_L(0); PG8_BAR; PG8_MMA(0, 0, At, B0); PG8_MMA(0, 1, At, B1); PG8_BAR; PG8_SCHED;
            PG8_LDA(At, 0, 1); PG8_STAGE(PG8_SB(0, 0), b2, voffB); PG8_STAGE(PG8_SB(0, 1), b2 + hstep, voffB); PG8_STAGE(PG8_SA(0, 0), a2, voffA);
            PG8_WAIT_V(8); PG8_WAIT_L(0); PG8_BAR; PG8_MMA(1, 0, At, B0); PG8_MMA(1, 1, At, B1); PG8_BAR; PG8_SCHED;
            PG8_LDB(B0, 1, 0); PG8_LDB(B1, 1, 1); PG8_SCHED; PG8_LDA(At, 1, 0); PG8_STAGE(PG8_SA(0, 1), a2 + hstep, voffA);
            PG8_WAIT_V(8); PG8_WAIT_L(0); PG8_BAR; PG8_MMA(0, 0, At, B0); PG8_MMA(0, 1, At, B1); PG8_BAR; PG8_SCHED;
            PG8_LDA(At, 1, 1); PG8_STAGE(PG8_SB(1, 0), b3, voffB); PG8_STAGE(PG8_SB(1, 1), b3 + hstep, voffB); PG8_STAGE(PG8_SA(1, 0), a3, voffA);
            PG8_WAIT_V(8); PG8_WAIT_L(0); PG8_BAR; PG8_MMA(1, 0, At, B0); PG8_MMA(1, 1, At, B1); PG8_BAR; PG8_SCHED;
            } else {
            PG8_LDB(B0, 0, 0); PG8_SCHED; PG8_LDA(At, 0, 0); PG8_STAGE(PG8_SA(1, 1), a1 + hstep, voffA);
            PG8_WAIT_L(8); PG8_BAR; PG8_WAIT_L(0); PG8_MMA(0, 0, At, B0); PG8_BAR; PG8_SCHED;
            PG8_LDB(B1, 0, 1); PG8_STAGE(PG8_SB(0, 0), b2, voffB);
            PG8_BAR; PG8_WAIT_L(0); PG8_MMA(0, 1, At, B1); PG8_BAR;
            PG8_LDA(At, 0, 1); PG8_STAGE(PG8_SA(0, 0), a2, voffA);
            PG8_BAR; PG8_WAIT_L(0); PG8_MMA(1, 0, At, B0); PG8_BAR; PG8_SCHED;
            PG8_STAGE(PG8_SB(0, 1), b2 + hstep, voffB);
            PG8_WAIT_V(6); PG8_BAR; PG8_MMA(1, 1, At, B1); PG8_BAR;
            PG8_LDB(B0, 1, 0); PG8_SCHED; PG8_LDA(At, 1, 0); PG8_STAGE(PG8_SA(0, 1), a2 + hstep, voffA);
            PG8_WAIT_L(8); PG8_BAR; PG8_WAIT_L(0); PG8_MMA(0, 0, At, B0); PG8_BAR; PG8_SCHED;
            PG8_LDB(B1, 1, 1); PG8_STAGE(PG8_SB(1, 0), b3, voffB);
            PG8_BAR; PG8_WAIT_L(0); PG8_MMA(0, 1, At, B1); PG8_BAR;
            PG8_LDA(At, 1, 1); PG8_STAGE(PG8_SA(1, 0), a3, voffA);
            PG8_BAR; PG8_WAIT_L(0); PG8_MMA(1, 0, At, B0); PG8_BAR; PG8_SCHED;
            PG8_STAGE(PG8_SB(1, 1), b3 + hstep, voffB);
            PG8_WAIT_V(6); PG8_BAR; PG8_MMA(1, 1, At, B1); PG8_BAR;
            }
        }
        if constexpr (ALIGN_EPI) { if (wr == 0) PG8_BAR; }
        if constexpr (!Epi::AFTER_DRAIN) { E(acc, cur, wr, wc, fr, fq); S.done(cur); }
        if (!has_next) break;
#pragma unroll
        for (int a = 0; a < 2; ++a)
#pragma unroll
            for (int b = 0; b < 2; ++b)
#pragma unroll
                for (int m = 0; m < 4; ++m)
#pragma unroll
                    for (int n = 0; n < 2; ++n) acc[a][b][m][n] = (f32x4){0.f, 0.f, 0.f, 0.f};
        cur = nxt; cA = nA; cB = nB; ++ui;
        if constexpr (ALIGN_EPI) { if (wr == 1) PG8_BAR; }
    }
    PG8_WAIT_V(0);
    if constexpr (!ALIGN_EPI) { if (wr == 0) PG8_BAR; }
    PG8_BAR;
    if constexpr (Epi::AFTER_DRAIN) { E.fused(acc, cur, wr, wc, fr, fq, lds, wid, lane); S.done(cur); }
#undef PG8_SA
#undef PG8_SB
#undef PG8_STAGE
#undef PG8_LDA
#undef PG8_LDB
#undef PG8_MMA
#undef PG8_WAIT_V
#undef PG8_WAIT_L
#undef PG8_BAR
#undef PG8_SCHED
}
}
#define XB_LAS __attribute__((address_space(3)))
#define XB_TMO      128
#define XB_XCNT(j)  (256  + 64 * (j))
#define XB_XSUB(j)  (1280 + 64 * (j))
#define XB_XGEN(j)  (2304 + 64 * (j))
#define XB_TOP      3328
#define XB_TOPGEN   3392
#define XCD_BAR_WORDS 3456
#define XB_SPIN_CAP (1u << 18)

__device__ __forceinline__ unsigned xb_ld(unsigned* p)              { return __hip_atomic_load(p, __ATOMIC_RELAXED, __HIP_MEMORY_SCOPE_AGENT); }
__device__ __forceinline__ unsigned xb_add(unsigned* p, unsigned v) { return __hip_atomic_fetch_add(p, v, __ATOMIC_RELAXED, __HIP_MEMORY_SCOPE_AGENT); }
__device__ __forceinline__ unsigned xb_xcc_id() { return (unsigned)__builtin_amdgcn_s_getreg((3 << 11) | 20) & 0xFu; }
#define XB_SPIN(cond, bar) do { unsigned _sp = 0; while (cond) { __builtin_amdgcn_s_sleep(1); \
    if ((++_sp & 255u) == 0u) { if (xb_ld(&(bar)[XB_TMO])) break; if (_sp > XB_SPIN_CAP) { atomicAdd(&(bar)[XB_TMO], 1u); break; } } } } while (0)

struct XcdBarrier {
    unsigned* bar; unsigned x;
    volatile XB_LAS unsigned* st;
};

__device__ __forceinline__ XcdBarrier xcd_barrier_post(unsigned* bar, volatile XB_LAS unsigned* st) {
    XcdBarrier b; b.bar = bar; b.x = xb_xcc_id(); b.st = st;
    if (threadIdx.x == 0) (void)xb_add(&bar[XB_XCNT(b.x)], 1u);
    return b;
}
__device__ __forceinline__ void xcd_barrier_complete(unsigned* bar, unsigned x, unsigned& nloc, unsigned& nx) {
    const unsigned G = gridDim.x * gridDim.y * gridDim.z;
    unsigned sum, cnt, mine, sp = 0u;
    for (;;) {
        sum = 0u; cnt = 0u; mine = 0u;
#pragma unroll
        for (unsigned j = 0; j < 16; ++j) { const unsigned c = xb_ld(&bar[XB_XCNT(j)]); sum += c; cnt += (c > 0u) ? 1u : 0u; mine = (j == x) ? c : mine; }
        if (sum == G) break;
        __builtin_amdgcn_s_sleep(1);
        if ((++sp & 255u) == 0u) { if (xb_ld(&bar[XB_TMO])) break; if (sp > XB_SPIN_CAP) { atomicAdd(&bar[XB_TMO], 1u); break; } }
    }
    nloc = mine > 0u ? mine : 1u; nx = cnt > 0u ? cnt : 1u;
}

__device__ __forceinline__ void xcd_barrier(const XcdBarrier& b) {
    asm volatile("s_waitcnt vmcnt(0)" ::: "memory");
    __syncthreads();
    if (threadIdx.x == 0) {
        unsigned* bar = b.bar;
        __builtin_amdgcn_s_waitcnt(0);
        unsigned nloc = b.st[0], nx = b.st[1];
        if (nloc == 0u) { xcd_barrier_complete(bar, b.x, nloc, nx); b.st[0] = nloc; b.st[1] = nx; }
        const unsigned old = xb_add(&bar[XB_XSUB(b.x)], 1u);
        const unsigned gen = old / nloc;
        if (old + 1u == (gen + 1u) * nloc) {
            __builtin_amdgcn_fence(__ATOMIC_RELEASE, "agent");
            asm volatile("s_waitcnt vmcnt(0)" ::: "memory");
            const unsigned og = xb_add(&bar[XB_TOP], 1u);
            const unsigned tg = og / nx;
            if (og + 1u == (tg + 1u) * nx) xb_add(&bar[XB_TOPGEN], 1u);
            else XB_SPIN(xb_ld(&bar[XB_TOPGEN]) == tg, bar);
            __builtin_amdgcn_fence(__ATOMIC_ACQUIRE, "agent");
            xb_add(&bar[XB_XGEN(b.x)], 1u);
            asm volatile("s_waitcnt vmcnt(0)" ::: "memory");
        } else {
            XB_SPIN(xb_ld(&bar[XB_XGEN(b.x)]) == gen, bar);
            __builtin_amdgcn_fence(__ATOMIC_ACQUIRE, "agent");
            asm volatile("s_waitcnt vmcnt(0)" ::: "memory");
        }
    }
    __syncthreads();
}
struct Ptrs {
    const float *x, *meta, *gamma_lb, *a_norm, *a_w_in, *a_out_norm, *a_w_out, *kv_norm, *kv_w, *fox_b_f, *fox_k_norm, *b_norm, *b_w_in, *b_q_norm, *b_w_out;
    float* out; float* sm;
    bf16_t *WT_AIN, *WT_AOUT, *WT_KVB, *WT_BOUT, *WT_F, *XN0, *QS, *VV, *GZ, *OG;
};

struct P0Item { const float* W; const float* g; bf16_t* WT; int ldw, row_off, k0, n0; };
constexpr int P0_I_AIN = 32 * 128, P0_I_AOUT = 32 * 32, P0_I_KV = 32 * 64, P0_I_BIN = 32 * 64, P0_I_BOUT = 32 * 32;
constexpr int P0_NITEMS = P0_I_AIN + P0_I_AOUT + P0_I_KV + P0_I_BIN + P0_I_BOUT;
__device__ __forceinline__ P0Item p0_decode(const Ptrs& P, int it) {
    P0Item I; int r = it, nblk;
    if (r < P0_I_AIN) { I.W = P.a_w_in; I.ldw = 8192; I.g = P.a_norm; I.WT = P.WT_AIN; I.row_off = 0; nblk = 128; }
    else if ((r -= P0_I_AIN) < P0_I_AOUT) { I.W = P.a_w_out; I.ldw = 2048; I.g = P.a_out_norm; I.WT = P.WT_AOUT; I.row_off = 0; nblk = 32; }
    else if ((r -= P0_I_AOUT) < P0_I_KV) { I.W = P.kv_w; I.ldw = 4112; I.g = P.kv_norm; I.WT = P.WT_KVB; I.row_off = 0; nblk = 64; }
    else if ((r -= P0_I_KV) < P0_I_BIN) { I.W = P.b_w_in; I.ldw = 4096; I.g = P.b_norm; I.WT = P.WT_KVB; I.row_off = 4096; nblk = 64; }
    else { r -= P0_I_BIN; I.W = P.b_w_out; I.ldw = 2048; I.g = nullptr; I.WT = P.WT_BOUT; I.row_off = 0; nblk = 32; }
    I.k0 = 64 * (r / nblk); I.n0 = 64 * (r % nblk);
    return I;
}
__device__ __forceinline__ void p0_item_load(const P0Item& I, int lane, f32x4 (&v)[16], float (&gg)[16]) {
    const int c4 = lane & 15, rr = lane >> 4;
#pragma unroll
    for (int i = 0; i < 16; ++i) { const int k = I.k0 + 4 * i + rr; v[i] = *(const f32x4*)(I.W + (size_t)k * I.ldw + I.n0 + 4 * c4); gg[i] = I.g ? I.g[k] : 1.0f; }
}
__device__ __forceinline__ void p0_item_store(const P0Item& I, LAS float* scr, int lane, const f32x4 (&v)[16], const float (&gg)[16]) {
    const int c4 = lane & 15, rr = lane >> 4;
#pragma unroll
    for (int i = 0; i < 16; ++i) { LAS float* p = scr + (4 * i + rr) * 65 + 4 * c4; p[0] = v[i][0] * gg[i]; p[1] = v[i][1] * gg[i]; p[2] = v[i][2] * gg[i]; p[3] = v[i][3] * gg[i]; }
    asm volatile("s_waitcnt lgkmcnt(0)" ::: "memory");
    const int c = lane & 7, nn = lane >> 3;
#pragma unroll
    for (int j = 0; j < 8; ++j) { const int n = nn + 8 * j; const LAS float* q = scr + (8 * c) * 65 + n;
        u32x4 o; o.x = pkbf(q[0 * 65], q[1 * 65]); o.y = pkbf(q[2 * 65], q[3 * 65]); o.z = pkbf(q[4 * 65], q[5 * 65]); o.w = pkbf(q[6 * 65], q[7 * 65]);
        *(u32x4*)(I.WT + (size_t)(I.row_off + I.n0 + n) * DM + I.k0 + 8 * c) = o; }
    asm volatile("s_waitcnt lgkmcnt(0)" ::: "memory");
}
__device__ __forceinline__ void rms_row_to_bf16(const float* xrow, bf16_t* orow, int lane) {
    const f32x4* xr = (const f32x4*)xrow + lane;
    f32x4 v[8]; float s = 0.f;
#pragma unroll
    for (int j = 0; j < 8; ++j) { v[j] = xr[64 * j]; s += (v[j].x * v[j].x + v[j].y * v[j].y) + (v[j].z * v[j].z + v[j].w * v[j].w); }
    const float rstd = __builtin_amdgcn_rsqf(wave_sum(s) * (1.f / DM) + EPS);
    u32x2* o8 = (u32x2*)orow + lane;
#pragma unroll
    for (int j = 0; j < 8; ++j) { u32x2 w; w.x = pkbf(v[j].x * rstd, v[j].y * rstd); w.y = pkbf(v[j].z * rstd, v[j].w * rstd); o8[64 * j] = w; }
}
__device__ __forceinline__ void p0_prologue(const Ptrs& P, LAS unsigned char* lds, int gw, int NGW, int wave, int lane) {
    LAS float* scr = (LAS float*)(lds + wave * 16640);
    {
        int it = gw; f32x4 va[16]; float ga[16];
        if (it < P0_NITEMS) p0_item_load(p0_decode(P, it), lane, va, ga);
        while (it < P0_NITEMS) {
            const int nx = it + NGW; f32x4 vb[16]; float gb[16];
            if (nx < P0_NITEMS) p0_item_load(p0_decode(P, nx), lane, vb, gb);
            p0_item_store(p0_decode(P, it), scr, lane, va, ga);
#pragma unroll
            for (int i = 0; i < 16; ++i) { va[i] = vb[i]; ga[i] = gb[i]; }
            it = nx;
        }
    }
    for (int idx = gw * 64 + lane; idx < 16 * DM; idx += NGW * 64) { const int k = idx >> 4, n = idx & 15;
        P.WT_F[(size_t)n * DM + k] = (bf16_t)(pkbf(P.kv_w[(size_t)k * 4112 + 4096 + n] * P.kv_norm[k], 0.f) & 0xffffu); }
    for (int m = gw; m < MT; m += NGW) rms_row_to_bf16(m < MR ? P.x + (size_t)m * DM : P.meta + (size_t)(m - MR) * DM, P.XN0 + (size_t)m * DM, lane);
    for (int idx = gw * 64 + lane; idx < DM; idx += NGW * 64) P.sm[SM_LBV + idx] = fsigmoid(P.gamma_lb[idx] - P.gamma_lb[DM + idx]);
    for (int idx = gw * 64 + lane; idx < MT; idx += NGW * 64) P.sm[SM_ROWSS + idx] = 0.f;
}

__device__ __forceinline__ f32x4 skinny_tile(const bf16_t* A, const bf16_t* Bt, int lane) {
    const int r = lane & 15, g = lane >> 4;
    const bf16x8* pa = (const bf16x8*)(A + (size_t)r * DM + 8 * g);
    const bf16x8* pb = (const bf16x8*)(Bt + (size_t)r * DM + 8 * g);
    f32x4 acc = {0.f, 0.f, 0.f, 0.f};
#pragma unroll 16
    for (int k = 0; k < DM / 32; ++k) acc = __builtin_amdgcn_mfma_f32_16x16x32_bf16(pa[4 * k], pb[4 * k], acc, 0, 0, 0);
    return acc;
}
__device__ __forceinline__ f32x4 skinny_tile4(const bf16_t* A, const bf16_t* Bt, int lane, int wave, LAS f32x4* xs) {
    const int r = lane & 15, g = lane >> 4, part = wave & 3;
    const bf16x8* pa = (const bf16x8*)(A + (size_t)r * DM + 8 * g + part * (DM / 4));
    const bf16x8* pb = (const bf16x8*)(Bt + (size_t)r * DM + 8 * g + part * (DM / 4));
    f32x4 acc = {0.f, 0.f, 0.f, 0.f};
#pragma unroll
    for (int k = 0; k < DM / 128; ++k) acc = __builtin_amdgcn_mfma_f32_16x16x32_bf16(pa[4 * k], pb[4 * k], acc, 0, 0, 0);
    xs[wave * 64 + lane] = acc;
    __syncthreads();
    const int w0 = wave & ~3;
    const f32x4 t = (xs[w0 * 64 + lane] + xs[(w0 + 1) * 64 + lane]) + (xs[(w0 + 2) * 64 + lane] + xs[(w0 + 3) * 64 + lane]);
    __syncthreads();
    return t;
}
constexpr int HG_LD128 = 136, HG_LD64 = 72, HG_LDO = 132;
constexpr int HG_QI = 0, HG_KI = HG_QI + 64 * HG_LD128 * 2, HG_QD = HG_KI + 64 * HG_LD128 * 2, HG_KDT = HG_QD + 64 * HG_LD128 * 2,
              HG_VT = HG_KDT + 128 * HG_LD64 * 2, HG_AL = HG_VT + 128 * HG_LD64 * 2, HG_ST = HG_AL + 64 * HG_LD64 * 2, HG_RT = HG_ST + 128 * HG_LD128 * 2,
              HG_DEC = HG_RT + 4 * 128 * 4, HG_END = HG_DEC + 128 * 4;
static_assert(HG_END <= 140000 && 64 * HG_LDO * 4 <= HG_QD, "hgrn LDS map (O tile overlays QI + KI)");

template <int MODE>
__device__ __forceinline__ void hgrn_item(LAS unsigned char* lds, const bf16_t* QS, const unsigned short* LOGF, const unsigned short* LOGFM, const bf16_t* VV, const bf16_t* GZ, bf16_t* OG,
                                          float* SEGS, float* DSEG, int b, int h, int seg) {
    const int tid = threadIdx.x, wid = __builtin_amdgcn_readfirstlane(tid >> 6), lane = tid & 63, r = lane & 15, g = lane >> 4;
    const int d = tid & 127, rq = tid >> 7, t0 = 16 * rq;
    LAS bf16_t* QI = (LAS bf16_t*)(lds + HG_QI); LAS bf16_t* KI = (LAS bf16_t*)(lds + HG_KI); LAS bf16_t* QD = (LAS bf16_t*)(lds + HG_QD);
    LAS bf16_t* KDT = (LAS bf16_t*)(lds + HG_KDT); LAS bf16_t* VT = (LAS bf16_t*)(lds + HG_VT); LAS bf16_t* AL = (LAS bf16_t*)(lds + HG_AL);
    LAS bf16_t* ST = (LAS bf16_t*)(lds + HG_ST); LAS float* RT = (LAS float*)(lds + HG_RT); LAS float* DEC = (LAS float*)(lds + HG_DEC);
    LAS float* OL = (LAS float*)(lds + HG_QI);
    const int item = (b * NH + h) * 8 + seg;
    const int c_begin = seg == 0 ? 0 : 8 * seg + 1, c_end = 8 * seg + 9;
    f32x4 Sacc[8];
#pragma unroll
    for (int dt = 0; dt < 8; ++dt) Sacc[dt] = (f32x4){0.f, 0.f, 0.f, 0.f};
    float dsum = 0.f;
    if (MODE == 1) {
#ifdef HG_NOFOLD
        for (int j = 0; j < 0; ++j) {
#else
        for (int j = 0; j < seg; ++j) {
#endif
            const int itj = (b * NH + h) * 8 + j;
            const float* sj = SEGS + (size_t)itj * 16384; const float* dj = DSEG + itj * 128;
#pragma unroll
            for (int dt = 0; dt < 8; ++dt) {
                const f32x4 l4 = *(const f32x4*)(dj + 16 * dt + 4 * g);
#pragma unroll
                for (int q = 0; q < 4; ++q) Sacc[dt][q] = fexp(l4[q]) * Sacc[dt][q] + sj[(16 * dt + 4 * g + q) * 128 + 16 * wid + r];
            }
        }
#pragma unroll
        for (int dt = 0; dt < 8; ++dt) { u32x2 w; w.x = pkbf(Sacc[dt][0], Sacc[dt][1]); w.y = pkbf(Sacc[dt][2], Sacc[dt][3]);
            *(LAS u32x2*)(ST + (16 * wid + r) * HG_LD128 + 16 * dt + 4 * g) = w; }
    }
    float lf[16]; unsigned q16[16], v16[16];
#define HG_LOAD(cc) do { const int c_ = (cc); const bool vld_ = c_ > 0 || rq == 3; const int rb_ = b * SEQ + (c_ - 1) * 64;                                   \
        const unsigned short* lp = c_ == 0 ? LOGFM + h * HD + d : LOGF + (size_t)(rb_ + t0) * DM + h * HD + d;                                                       \
        const size_t o16 = c_ == 0 ? (size_t)MR * DM + h * HD + d : (size_t)(rb_ + t0) * DM + h * HD + d;                                                   \
        _Pragma("unroll") for (int i = 0; i < 16; ++i) { const float x = h2f(lp[(size_t)i * DM]); const unsigned vv = VV[o16 + (size_t)i * DM];                   \
            lf[i] = vld_ ? x : 0.f; v16[i] = vld_ ? vv : 0u;                                                                                                \
            if (MODE == 1) { const unsigned qq = QS[o16 + (size_t)i * DM]; q16[i] = vld_ ? qq : 0u; } } } while (0)
    for (int c = c_begin; c < c_end; ++c) {
        HG_LOAD(c);
        const int rowbase = c == 0 ? (MR - 48) : b * SEQ + (c - 1) * 64;
        float cs[16];
        float run = 0.f;
#pragma unroll
        for (int i = 0; i < 16; ++i) { run += lf[i]; cs[i] = run; }
        RT[rq * 128 + d] = run;
        __syncthreads();
        const float r0 = RT[d], r1 = RT[128 + d], r2 = RT[256 + d], r3 = RT[384 + d];
        const float off = (rq > 0 ? r0 : 0.f) + (rq > 1 ? r1 : 0.f) + (rq > 2 ? r2 : 0.f);
        const float bmid = r0 + r1, blast = (r0 + r1) + (r2 + r3);
        if (rq == 0) { DEC[d] = fexp(blast); dsum += blast; }
        const float emid = fexp(bmid), elast = fexp(blast - bmid);
        {
            float kdv[16];
#pragma unroll
            for (int i = 0; i < 16; ++i) {
                const float bb = off + cs[i];
                const float kk = 1.0f - fexp(lf[i]);
                const float e1 = fexp(bb - bmid), e2 = fexp(bmid - bb);
                const float ki = kk * e2;
                kdv[i] = ki * elast;
                if (MODE == 1) {
                    const float qi = __uint_as_float(q16[i] << 16) * e1;
                    QI[(t0 + i) * HG_LD128 + d] = (bf16_t)(pkbf(qi, 0.f) & 0xffffu);
                    KI[(t0 + i) * HG_LD128 + d] = (bf16_t)(pkbf(ki, 0.f) & 0xffffu);
                    QD[(t0 + i) * HG_LD128 + d] = (bf16_t)(pkbf(qi * emid, 0.f) & 0xffffu);
                }
            }
            u32x4 w0, w1, x0, x1;
            w0.x = pkbf(kdv[0], kdv[1]); w0.y = pkbf(kdv[2], kdv[3]); w0.z = pkbf(kdv[4], kdv[5]); w0.w = pkbf(kdv[6], kdv[7]);
            w1.x = pkbf(kdv[8], kdv[9]); w1.y = pkbf(kdv[10], kdv[11]); w1.z = pkbf(kdv[12], kdv[13]); w1.w = pkbf(kdv[14], kdv[15]);
            x0.x = v16[0] | (v16[1] << 16); x0.y = v16[2] | (v16[3] << 16); x0.z = v16[4] | (v16[5] << 16); x0.w = v16[6] | (v16[7] << 16);
            x1.x = v16[8] | (v16[9] << 16); x1.y = v16[10] | (v16[11] << 16); x1.z = v16[12] | (v16[13] << 16); x1.w = v16[14] | (v16[15] << 16);
            *(LAS u32x4*)(KDT + d * HG_LD64 + t0) = w0; *(LAS u32x4*)(KDT + d * HG_LD64 + t0 + 8) = w1;
            *(LAS u32x4*)(VT + d * HG_LD64 + t0) = x0; *(LAS u32x4*)(VT + d * HG_LD64 + t0 + 8) = x1;
        }
        __syncthreads();
        const int tF = tid >> 3, e0F = 16 * (tid & 7);
        const bool wr_ok = c > 0 ? true : (tF >= 48 && b == 0);
        const size_t off2 = (size_t)(wr_ok ? rowbase + tF : MR) * DM + h * HD + e0F;
        u32x4 z0 = {0u, 0u, 0u, 0u}, z1 = z0;
        if (MODE == 1) { z0 = *(const u32x4*)(GZ + off2); z1 = *(const u32x4*)(GZ + off2 + 8); }
        if (MODE == 1) {
            const int ti = wid & 3, si0 = 2 * (wid >> 2);
#pragma unroll
            for (int sj = 0; sj < 2; ++sj) {
                const int si = si0 + sj;
                f32x4 a4 = {0.f, 0.f, 0.f, 0.f};
                if (si <= ti) {
#pragma unroll
                    for (int k4 = 0; k4 < 4; ++k4) {
                        const bf16x8 fa = *(const LAS bf16x8*)(KI + (16 * si + r) * HG_LD128 + 32 * k4 + 8 * g);
                        const bf16x8 fb = *(const LAS bf16x8*)(QI + (16 * ti + r) * HG_LD128 + 32 * k4 + 8 * g);
                        a4 = __builtin_amdgcn_mfma_f32_16x16x32_bf16(fa, fb, a4, 0, 0, 0);
                    }
                    if (si == ti) {
#pragma unroll
                        for (int q = 0; q < 4; ++q) if (4 * g + q > r) a4[q] = 0.f;
                    }
                }
                u32x2 w; w.x = pkbf(a4[0], a4[1]); w.y = pkbf(a4[2], a4[3]);
                *(LAS u32x2*)(AL + (16 * ti + r) * HG_LD64 + 16 * si + 4 * g) = w;
            }
            __syncthreads();
        }
        bf16x8 bv[2];
        bv[0] = *(const LAS bf16x8*)(VT + (16 * wid + r) * HG_LD64 + 8 * g);
        bv[1] = *(const LAS bf16x8*)(VT + (16 * wid + r) * HG_LD64 + 32 + 8 * g);
        if (MODE == 1) {
            bf16x8 sf[4];
#pragma unroll
            for (int k4 = 0; k4 < 4; ++k4) sf[k4] = *(const LAS bf16x8*)(ST + (16 * wid + r) * HG_LD128 + 32 * k4 + 8 * g);
#pragma unroll
            for (int ti = 0; ti < 4; ++ti) {
                f32x4 o4 = {0.f, 0.f, 0.f, 0.f};
#pragma unroll
                for (int k4 = 0; k4 < 4; ++k4) {
                    const bf16x8 fa = *(const LAS bf16x8*)(QD + (16 * ti + r) * HG_LD128 + 32 * k4 + 8 * g);
                    o4 = __builtin_amdgcn_mfma_f32_16x16x32_bf16(fa, sf[k4], o4, 0, 0, 0);
                }
#pragma unroll
                for (int ks = 0; ks < 2; ++ks) {
                    if (ks == 1 && ti < 2) continue;
                    const bf16x8 fa = *(const LAS bf16x8*)(AL + (16 * ti + r) * HG_LD64 + 32 * ks + 8 * g);
                    o4 = __builtin_amdgcn_mfma_f32_16x16x32_bf16(fa, bv[ks], o4, 0, 0, 0);
                }
#pragma unroll
                for (int q = 0; q < 4; ++q) OL[(16 * ti + 4 * g + q) * HG_LDO + 16 * wid + r] = o4[q];
            }
        }
#pragma unroll
        for (int dt = 0; dt < 8; ++dt) {
            const f32x4 dc = *(const LAS f32x4*)(DEC + 16 * dt + 4 * g);
            Sacc[dt] = Sacc[dt] * dc;
#pragma unroll
            for (int ks = 0; ks < 2; ++ks) {
                const bf16x8 fa = *(const LAS bf16x8*)(KDT + (16 * dt + r) * HG_LD64 + 32 * ks + 8 * g);
                Sacc[dt] = __builtin_amdgcn_mfma_f32_16x16x32_bf16(fa, bv[ks], Sacc[dt], 0, 0, 0);
            }
        }
        if (MODE == 1) {
#pragma unroll
            for (int dt = 0; dt < 8; ++dt) { u32x2 w; w.x = pkbf(Sacc[dt][0], Sacc[dt][1]); w.y = pkbf(Sacc[dt][2], Sacc[dt][3]);
                *(LAS u32x2*)(ST + (16 * wid + r) * HG_LD128 + 16 * dt + 4 * g) = w; }
            __syncthreads();
            const int t = tF, e0 = e0F;
            f32x4 o[4]; float ss = 0.f;
#pragma unroll
            for (int q = 0; q < 4; ++q) { o[q] = *(const LAS f32x4*)(OL + t * HG_LDO + e0 + 4 * q); ss += (o[q][0] * o[q][0] + o[q][1] * o[q][1]) + (o[q][2] * o[q][2] + o[q][3] * o[q][3]); }
            ss += __shfl_xor(ss, 1); ss += __shfl_xor(ss, 2); ss += __shfl_xor(ss, 4);
            const float rstd = __builtin_amdgcn_rsqf(ss * (1.0f / HD) + EPS);
            if (wr_ok) {
                u32x4 w0, w1;
#define HG_G(zw, a, b_) pkbf((a) * rstd * __uint_as_float((zw) << 16), (b_) * rstd * __uint_as_float((zw) & 0xffff0000u))
                w0.x = HG_G(z0.x, o[0][0], o[0][1]); w0.y = HG_G(z0.y, o[0][2], o[0][3]); w0.z = HG_G(z0.z, o[1][0], o[1][1]); w0.w = HG_G(z0.w, o[1][2], o[1][3]);
                w1.x = HG_G(z1.x, o[2][0], o[2][1]); w1.y = HG_G(z1.y, o[2][2], o[2][3]); w1.z = HG_G(z1.z, o[3][0], o[3][1]); w1.w = HG_G(z1.w, o[3][2], o[3][3]);
#undef HG_G
                *(u32x4*)(OG + off2) = w0; *(u32x4*)(OG + off2 + 8) = w1;
            }
        }
        __syncthreads();
    }
#undef HG_LOAD
    if (MODE == 0) {
        float* sj = SEGS + (size_t)item * 16384;
#pragma unroll
        for (int dt = 0; dt < 8; ++dt)
#pragma unroll
            for (int q = 0; q < 4; ++q) sj[(16 * dt + 4 * g + q) * 128 + 16 * wid + r] = Sacc[dt][q];
        if (rq == 0) DSEG[item * 128 + d] = dsum;
    }
}
__device__ __forceinline__ void p1_meta(const Ptrs& P, LAS unsigned char* lds, int gw, int NGW, int wave, int lane) {
    const int r = lane & 15, g = lane >> 4; LAS f32x4* xs = (LAS f32x4*)lds;
    for (int base = 0; base < 512; base += NGW / 4) {
        const int tl = base + (gw >> 2); const bool ok = tl < 512 && (wave & 3) == 0;
        const f32x4 acc = skinny_tile4(P.XN0 + (size_t)MR * DM, P.WT_AIN + (size_t)(tl < 512 ? tl : 0) * 16 * DM, lane, wave, xs);
        if (!ok) continue;
        const int col = tl * 16 + r, type = col >> 11, c = col & 2047;
#pragma unroll
        for (int q = 0; q < 4; ++q) {
            const int mr = 4 * g + q; const float v = acc[q];
            if (type == 0) P.QS[(size_t)(MR + mr) * DM + c] = (bf16_t)(pkbf(fsilu(v), 0.f) & 0xffffu);
            else if (type == 1) { const float lb = P.sm[SM_LBV + c]; ((unsigned short*)(P.sm + SM_LOGFM))[mr * DM + c] = (unsigned short)(pkh(flog(lb + (1.0f - lb) * fsigmoid(v)), 0.f) & 0xffffu); }
            else if (type == 2) P.VV[(size_t)(MR + mr) * DM + c] = (bf16_t)(pkbf(v, 0.f) & 0xffffu);
            else P.GZ[(size_t)(MR + mr) * DM + c] = (bf16_t)(pkbf(fsilu(v), 0.f) & 0xffffu);
        }
    }
}
__device__ __forceinline__ void p4_meta(const Ptrs& P, bf16_t* H1BF, LAS unsigned char* lds, int gw, int NGW, int wave, int lane) {
    const int r = lane & 15, g = lane >> 4; LAS f32x4* xs = (LAS f32x4*)lds;
    for (int base = 0; base < 128; base += NGW / 4) {
        const int tl = base + (gw >> 2); const bool ok = tl < 128 && (wave & 3) == 0;
        const f32x4 acc = skinny_tile4(P.OG + (size_t)MR * DM, P.WT_AOUT + (size_t)(tl < 128 ? tl : 0) * 16 * DM, lane, wave, xs);
        if (!ok) continue;
        const int col = tl * 16 + r;
#pragma unroll
        for (int q = 0; q < 4; ++q) {
            const int mr = 4 * g + q; const float hv = P.meta[mr * DM + col] + acc[q];
            H1BF[(size_t)(MR + mr) * DM + col] = (bf16_t)(pkbf(hv, 0.f) & 0xffffu);
            float ss = hv * hv; ss += __shfl_xor(ss, 1); ss += __shfl_xor(ss, 2); ss += __shfl_xor(ss, 4); ss += __shfl_xor(ss, 8);
            if (r == 0) atomicAdd(P.sm + SM_ROWSS + MR + mr, ss);
        }
    }
}
__device__ __forceinline__ void p5_side(const Ptrs& P, const bf16_t* H1BF, bf16_t* KB, bf16_t* VB, LAS unsigned char* lds, int gw, int NGW, int wave, int lane) {
    const int r = lane & 15, g = lane >> 4; LAS f32x4* xs = (LAS f32x4*)lds;
    for (int base = 0; base < 256 + 513; base += NGW / 4) {
        const int tl = base + (gw >> 2); const bool inr = tl < 256 + 513, ok = inr && (wave & 3) == 0;
        const bool meta = !inr || tl < 256; const int rt = meta ? 0 : tl - 256;
        const bf16_t* A = meta ? H1BF + (size_t)MR * DM : H1BF + (size_t)rt * 16 * DM;
        const bf16_t* Bt = meta ? P.WT_KVB + (size_t)(inr ? tl : 0) * 16 * DM : P.WT_F;
        const f32x4 acc = skinny_tile4(A, Bt, lane, wave, xs);
        if (!ok) continue;
        if (tl < 256) {
            const int col = tl * 16 + r, isv = col >> 11, c = col & 2047, head = c >> 7, dd = c & 127;
#pragma unroll
            for (int q = 0; q < 4; ++q) {
                const int mr = 4 * g + q;
                const float rs = __builtin_amdgcn_rsqf(P.sm[SM_ROWSS + MR + mr] * (1.0f / DM) + EPS);
                const bf16_t v = (bf16_t)(pkbf(acc[q] * rs, 0.f) & 0xffffu);
                bf16_t* bs = isv ? VB : KB;
                bs[((size_t)(0 * NH + head) * SKV + 48 + mr) * HD + dd] = v;
                bs[((size_t)(1 * NH + head) * SKV + 48 + mr) * HD + dd] = v;
            }
        } else {
            const float bf = P.fox_b_f[r];
#pragma unroll
            for (int q = 0; q < 4; ++q) {
                const int row = rt * 16 + 4 * g + q;
                const float rs = __builtin_amdgcn_rsqf(P.sm[SM_ROWSS + row] * (1.0f / DM) + EPS);
                const float xl = acc[q] * rs + bf;
                P.sm[SM_LOGF2 + row * 16 + r] = fminf(xl, 0.f) - flog(1.0f + fexp(-fabsf(xl)));
            }
        }
    }
    for (int idx = gw * 64 + lane; idx < 32 * 48 * 16; idx += NGW * 64) {
        const int bh = idx / (48 * 16), rem = idx % (48 * 16);
        const u32x4 z = {0u, 0u, 0u, 0u};
        *(u32x4*)(KB + (size_t)bh * SKV * HD + rem * 8) = z; *(u32x4*)(VB + (size_t)bh * SKV * HD + rem * 8) = z;
    }
}
__device__ __forceinline__ void p6_norm_scan(const Ptrs& P, bf16_t* KB, bf16_t* QB2, int gw, int NGW, int lane) {
    const int sub = lane >> 4, l16 = lane & 15;
    constexpr int NKR = 32 * SKV, NQR = 32 * SEQ;
    (void)NKR; (void)NQR; (void)QB2;
    for (int r4 = gw; r4 < 32 * 16 / 4; r4 += NGW) {
        const int rr = r4 * 4 + sub, bh = rr >> 4, mr = rr & 15;
        bf16_t* p = KB + ((size_t)bh * SKV + 48 + mr) * HD; const float* gn = P.fox_k_norm + (bh & 15) * HD;
        const u32x4 w = *(const u32x4*)(p + 8 * l16);
        float v[8];
        v[0] = __uint_as_float(w.x << 16); v[1] = __uint_as_float(w.x & 0xffff0000u); v[2] = __uint_as_float(w.y << 16); v[3] = __uint_as_float(w.y & 0xffff0000u);
        v[4] = __uint_as_float(w.z << 16); v[5] = __uint_as_float(w.z & 0xffff0000u); v[6] = __uint_as_float(w.w << 16); v[7] = __uint_as_float(w.w & 0xffff0000u);
        float ss = 0.f;
#pragma unroll
        for (int j = 0; j < 8; ++j) ss += v[j] * v[j];
        ss += __shfl_xor(ss, 1); ss += __shfl_xor(ss, 2); ss += __shfl_xor(ss, 4); ss += __shfl_xor(ss, 8);
        const float rs = __builtin_amdgcn_rsqf(ss * (1.0f / HD) + EPS);
        const f32x4 g0 = *(const f32x4*)(gn + 8 * l16), g1 = *(const f32x4*)(gn + 8 * l16 + 4);
        u32x4 o; o.x = pkbf(v[0] * rs * g0[0], v[1] * rs * g0[1]); o.y = pkbf(v[2] * rs * g0[2], v[3] * rs * g0[3]);
        o.z = pkbf(v[4] * rs * g1[0], v[5] * rs * g1[1]); o.w = pkbf(v[6] * rs * g1[2], v[7] * rs * g1[3]);
        *(u32x4*)(p + 8 * l16) = o;
    }
    if ((gw & 7) == 0) for (int sidx = gw >> 3; sidx < 32; sidx += NGW >> 3) {
        const int b = sidx >> 4, h = sidx & 15; float* bias = P.sm + SM_BIAS + sidx * SKV;
        if (lane < 48) bias[lane] = -1e30f;
        constexpr int NPOS = NMETA + SEQ, PER = 65;
        float v[PER];
#pragma unroll
        for (int k = 0; k < PER; ++k) {
            const int pos = lane * PER + k, pc = pos < NPOS ? pos : NPOS - 1;
            const int row = pc < NMETA ? MR + pc : b * SEQ + pc - NMETA;
            const float x = P.sm[SM_LOGF2 + row * 16 + h];
            v[k] = pos < NPOS ? x : 0.f;
        }
        float run = 0.f;
#pragma unroll
        for (int k = 0; k < PER; ++k) { run += v[k]; v[k] = run; }
        float tot = run;
#pragma unroll
        for (int o = 1; o < 64; o <<= 1) { const float n = __shfl_up(tot, o); if (lane >= o) tot += n; }
        const float base = tot - run;
#pragma unroll
        for (int k = 0; k < PER; ++k) { const int pos = lane * PER + k; if (pos < NPOS) bias[48 + pos] = -(base + v[k]) * 11.313708498984761f; }
    }
}
namespace attn {
constexpr float SCALE = 0.08838834764831845f;
constexpr float THR = 14.f;
constexpr int NW = 8, QBLK = 32, KVBLK = 64, QB = NW * QBLK, D = 128, OST = 2048;
constexpr int SHM_V = KVBLK * D * 2, SHM_K = KVBLK * D * 2;
constexpr int OFF_WS = 2 * SHM_V + 2 * SHM_K, OFF_BIAS = OFF_WS + NW * 64 * 4, LDS_BYTES = OFF_BIAS + SKV * 4;
constexpr unsigned WBIG = 1u << 30;

#define KSWZ(row, colB) ((row) * 256 + ((colB) ^ (((row) & 7) << 4)))
#define SBAR() __builtin_amdgcn_sched_barrier(0)
__device__ __forceinline__ int v_st(int k, int c) { const int kk = (k & ~0xC) | ((k & 4) << 1) | ((k & 8) >> 1); return ((kk >> 3) * 4 + (c >> 5)) * 512 + ((kk & 7) * 32 + (c & 31)) * 2; }
__device__ __forceinline__ int v_rd_base(int lane) { return ((lane & 3) << 3) | (((lane >> 2) & 3) << 6) | (((lane >> 4) & 1) << 5) | (((lane >> 5) & 1) << 8); }
constexpr int v_rd_off(int d0, int ks, int half) { return d0 * 512 + ks * 4096 + half * 2048; }
__device__ __forceinline__ int crow(int r, int hi) { return (r & 3) + 8 * (r >> 2) + 4 * hi; }
__device__ __forceinline__ void mask_tile(f32x16& p0, f32x16& p1, int dq, unsigned W) {
    const float NEG = -__builtin_inff();
#pragma unroll
    for (int r = 0; r < 16; ++r) {
        const int c = (r & 3) + 8 * (r >> 2);
        if ((unsigned)(dq - c) >= W) p0[r] = NEG;
        if ((unsigned)(dq - c - 32) >= W) p1[r] = NEG;
    }
}
__device__ __forceinline__ void partialSM(f32x16& p0, f32x16& p1, float& m_reg, float& mn, float& alpha) {
    float pmax = p0[0]; for (int r = 1; r < 16; ++r) pmax = fmaxf(pmax, p0[r]); for (int r = 0; r < 16; ++r) pmax = fmaxf(pmax, p1[r]);
    { auto rr = __builtin_amdgcn_permlane32_swap(__float_as_uint(pmax), __float_as_uint(pmax), false, false);
      pmax = fmaxf(__uint_as_float(rr[0]), __uint_as_float(rr[1])); }
    constexpr float C2 = 1.4426950408889634f * SCALE;
    if (__builtin_expect(__all((pmax - m_reg) * SCALE <= THR), 1)) { mn = m_reg; alpha = 1.f; }
    else { mn = fmaxf(m_reg, pmax); alpha = __builtin_amdgcn_exp2f((m_reg - mn) * C2); m_reg = mn; }
    const float mnL = -mn * C2;
    for (int r = 0; r < 16; ++r) p0[r] = fmaf(p0[r], C2, mnL); for (int r = 0; r < 16; ++r) p1[r] = fmaf(p1[r], C2, mnL);
    for (int r = 0; r < 16; ++r) p0[r] = __builtin_amdgcn_exp2f(p0[r]);
}
__device__ __forceinline__ void finishSM(f32x16& p0, f32x16& p1, float alpha, float& l_reg, bf16x8& pa0, bf16x8& pa1, bf16x8& pa2, bf16x8& pa3) {
    for (int r = 0; r < 16; ++r) p1[r] = __builtin_amdgcn_exp2f(p1[r]);
    float ps = 0; for (int r = 0; r < 16; ++r) ps += p0[r]; for (int r = 0; r < 16; ++r) ps += p1[r];
    { auto rr = __builtin_amdgcn_permlane32_swap(__float_as_uint(ps), __float_as_uint(ps), false, false);
      ps = __uint_as_float(rr[0]) + __uint_as_float(rr[1]); }
    l_reg = l_reg * alpha + ps;
#define PK4(P, B_, OUT) do { unsigned a0 = pkbf(P[B_+0], P[B_+1]), a1 = pkbf(P[B_+2], P[B_+3]);                          \
        unsigned b0 = pkbf(P[B_+4], P[B_+5]), b1 = pkbf(P[B_+6], P[B_+7]);                                             \
        auto r0 = __builtin_amdgcn_permlane32_swap(a0, b0, false, false); auto r1 = __builtin_amdgcn_permlane32_swap(a1, b1, false, false); \
        u32x4 w = {r0[0], r1[0], r0[1], r1[1]}; OUT = *reinterpret_cast<bf16x8*>(&w); } while (0)
    PK4(p0, 0, pa0); PK4(p0, 8, pa1); PK4(p1, 0, pa2); PK4(p1, 8, pa3);
#undef PK4
}
template <int KB>
__device__ __forceinline__ void qkt(f32x16& p0, f32x16& p1, const char* K_lds, const float* bl, int r32, int hi, const bf16x8* qr) {
    {
        const f32x4 a0 = *(const f32x4*)(bl), a1 = *(const f32x4*)(bl + 8), a2 = *(const f32x4*)(bl + 16), a3 = *(const f32x4*)(bl + 24);
        const f32x4 c0 = *(const f32x4*)(bl + 32), c1 = *(const f32x4*)(bl + 40), c2 = *(const f32x4*)(bl + 48), c3 = *(const f32x4*)(bl + 56);
        p0 = (f32x16){a0[0], a0[1], a0[2], a0[3], a1[0], a1[1], a1[2], a1[3], a2[0], a2[1], a2[2], a2[3], a3[0], a3[1], a3[2], a3[3]};
        p1 = (f32x16){c0[0], c0[1], c0[2], c0[3], c1[0], c1[1], c1[2], c1[3], c2[0], c2[1], c2[2], c2[3], c3[0], c3[1], c3[2], c3[3]};
    }
    const char* kb[4];
#pragma unroll
    for (int dd = 0; dd < 4; ++dd) kb[dd] = K_lds + KB * SHM_K + KSWZ(r32, (dd * 16 + hi * 8) * 2);
#pragma unroll
    for (int d0 = 0; d0 < 8; ++d0) { const char* a = kb[d0 & 3] + (d0 >> 2) * 128;
        bf16x8 b0 = *reinterpret_cast<const bf16x8*>(a);
        bf16x8 b1 = *reinterpret_cast<const bf16x8*>(a + 32 * 256);
        p0 = __builtin_amdgcn_mfma_f32_32x32x16_bf16(b0, qr[d0], p0, 0, 0, 0);
        p1 = __builtin_amdgcn_mfma_f32_32x32x16_bf16(b1, qr[d0], p1, 0, 0, 0); }
}
template <int VB>
__device__ __forceinline__ void pv_tile(f32x16* o, int vb0, bf16x8 pa0, bf16x8 pa1, bf16x8 pa2, bf16x8 pa3) {
#define TRRD(dst, off) asm volatile("ds_read_b64_tr_b16 %0, %1 offset:%2" : "=&v"(dst) : "v"(vb0), "i"(off) : "memory")
#define PV_D0(d0) do { s16x4 l0, l1, l2, l3, h0, h1, h2, h3; constexpr int b_ = VB * SHM_V + v_rd_off(d0, 0, 0); \
        TRRD(l0, b_); TRRD(h0, b_ + 2048); TRRD(l1, b_ + 4096); TRRD(h1, b_ + 6144); TRRD(l2, b_ + 8192); TRRD(h2, b_ + 10240); TRRD(l3, b_ + 12288); TRRD(h3, b_ + 14336); \
        asm volatile("s_waitcnt lgkmcnt(0)" ::: "memory"); SBAR();   \
        o[d0] = __builtin_amdgcn_mfma_f32_32x32x16_bf16(pa0, (bf16x8){l0[0], l0[1], l0[2], l0[3], h0[0], h0[1], h0[2], h0[3]}, o[d0], 0, 0, 0);   \
        o[d0] = __builtin_amdgcn_mfma_f32_32x32x16_bf16(pa1, (bf16x8){l1[0], l1[1], l1[2], l1[3], h1[0], h1[1], h1[2], h1[3]}, o[d0], 0, 0, 0);   \
        o[d0] = __builtin_amdgcn_mfma_f32_32x32x16_bf16(pa2, (bf16x8){l2[0], l2[1], l2[2], l2[3], h2[0], h2[1], h2[2], h2[3]}, o[d0], 0, 0, 0);   \
        o[d0] = __builtin_amdgcn_mfma_f32_32x32x16_bf16(pa3, (bf16x8){l3[0], l3[1], l3[2], l3[3], h3[0], h3[1], h3[2], h3[3]}, o[d0], 0, 0, 0); } while (0)
    PV_D0(0); PV_D0(1); PV_D0(2); PV_D0(3);
#undef PV_D0
#undef TRRD
}

struct BlockRef { const bf16_t* Q; const bf16_t* K; const bf16_t* V; bf16_t* O; const bf16_t* GZ; const float* BIAS; int P0; };
struct Seam { bf16x8 qr[8]; bf16x8 st_v0, st_v1, st_k0, st_k1; };
#define ROW(p, k0, rr) ((p) + (size_t)((k0) + (rr)) * D + sc)
#define VMW() asm volatile("s_waitcnt vmcnt(0)" ::: "memory")
#define VMWN(n) asm volatile("s_waitcnt vmcnt(%0)" :: "i"(n) : "memory")
#define LD8(p) (*reinterpret_cast<const bf16x8*>(p))
#define SLOAD_H(Kp, Vp, k0) do { S.st_v0 = LD8(ROW(Vp, k0, sr)); S.st_v1 = LD8(ROW(Vp, k0, 32 + sr));              \
                         S.st_k0 = LD8(ROW(Kp, k0, sr)); S.st_k1 = LD8(ROW(Kp, k0, 32 + sr)); } while (0)
#define SWRITE_HK(bf) do { *(bf16x8*)(K_lds + (bf) * SHM_K + kws) = S.st_k0; *(bf16x8*)(K_lds + (bf) * SHM_K + kws + 32 * 256) = S.st_k1; } while (0)
#define SWRITE_HV(bf) do { *(bf16x8*)(V_lds + (bf) * SHM_V + vst0) = S.st_v0; *(bf16x8*)(V_lds + (bf) * SHM_V + vst1) = S.st_v1; } while (0)
#define SWRITE_H(bf) do { SWRITE_HV(bf); SWRITE_HK(bf); } while (0)
__device__ __forceinline__ void causal_prime(const BlockRef& cur, char* lds, Seam& S) {
    const int tid = threadIdx.x, wid = __builtin_amdgcn_readfirstlane(tid >> 6), lane = tid & 63, r32 = lane & 31, hi = lane >> 5;
    const int sr = tid >> 4, sc = (tid & 15) * 8, kws = KSWZ(sr, sc * 2); char* K_lds = lds + 2 * SHM_V;
    for (int d0 = 0; d0 < 8; ++d0) S.qr[d0] = LD8(cur.Q + (size_t)(wid * QBLK + r32) * D + d0 * 16 + hi * 8);
    SLOAD_H(cur.K, cur.V, 0); VMW(); SWRITE_HK(0);
    __syncthreads();
}
__device__ __forceinline__ void causal_block(const BlockRef& cur, char* lds, Seam& S) {
    const int tid = threadIdx.x, wid = __builtin_amdgcn_readfirstlane(tid >> 6), lane = tid & 63, r32 = lane & 31, hi = lane >> 5;
    const int NT = (cur.P0 + QB - 1) / KVBLK + 1;
    const int qlo = cur.P0 + wid * QBLK, qm = qlo + r32 - 4 * hi;
    char* V_lds = lds; char* K_lds = lds + 2 * SHM_V;
    float* ws = (float*)(lds + OFF_WS) + wid * 64; float* li_l = ws, * al_l = ws + 32;
    float* bias_l = (float*)(lds + OFF_BIAS);
    for (int i = tid * 4; i < cur.P0 + QB; i += NW * 64 * 4) *(f32x4*)(bias_l + i) = *(const f32x4*)(cur.BIAS + i);
    __syncthreads();
    float m_reg = -1e30f, l_reg = 0; f32x16 o[4] = {};
    const int sr = tid >> 4, sc = (tid & 15) * 8, vst0 = v_st(sr, sc), vst1 = v_st(32 + sr, sc), kws = KSWZ(sr, sc * 2);
    const int vb0 = (int)(uintptr_t)V_lds + v_rd_base(lane);
    const bf16_t* Kh = cur.K; const bf16_t* Vh = cur.V;
#define RESC(a) do { if (__any((a) < 1.f)) { if (hi == 0) al_l[r32] = (a); asm volatile("s_waitcnt lgkmcnt(0)" ::: "memory");              \
                     for (int d_ = 0; d_ < 4; ++d_) for (int r = 0; r < 16; ++r) o[d_][r] *= al_l[crow(r, hi)]; } } while (0)
#define KBASE(t) ((t) * KVBLK)
#define MASKT(P0_, P1_, t) do { const int kb_ = KBASE(t); if (kb_ + KVBLK - 1 > qlo) mask_tile(P0_, P1_, qm - kb_, WBIG); } while (0)
    constexpr int NQL = 8;
#define SEAM_K0() do { VMWN(NQL); SWRITE_HK(0); SBAR(); } while (0)
    f32x16 pA0, pA1, pB0, pB1; float mnA, mnB, alA, alB; bf16x8 pa0, pa1, pa2, pa3;
    SWRITE_HV(0); SBAR();
    if (NT > 1) { SLOAD_H(Kh, Vh, KBASE(1)); }
    SBAR(); qkt<0>(pA0, pA1, K_lds, bias_l + 4 * hi + KBASE(0), r32, hi, S.qr);
    MASKT(pA0, pA1, 0); partialSM(pA0, pA1, m_reg, mnA, alA);
    if (NT > 1) { VMW(); SWRITE_H(1); }
    __syncthreads();
#define HALF_STEP(PX0, PX1, mnX, alX, PY0, PY1, alY, t, KB, VB, SB) do {                                                      \
        SBAR(); qkt<KB>(PX0, PX1, K_lds, bias_l + 4 * hi + KBASE(t), r32, hi, S.qr);                                             \
        finishSM(PY0, PY1, alY, l_reg, pa0, pa1, pa2, pa3); SBAR();                                                           \
        if ((t) + 1 < NT) { SLOAD_H(Kh, Vh, KBASE((t) + 1)); SBAR(); }                                               \
        pv_tile<VB>(o, vb0, pa0, pa1, pa2, pa3); MASKT(PX0, PX1, (t)); partialSM(PX0, PX1, m_reg, mnX, alX);                                        \
        __syncthreads();                                                                                                      \
        if ((t) + 1 < NT) { VMW(); SWRITE_H(SB); }                                                                          \
        RESC(alX); __syncthreads(); } while (0)
    for (int t = 1; t + 1 < NT; t += 2) {
        HALF_STEP(pB0, pB1, mnB, alB, pA0, pA1, alA, t, 1, 0, 0);
        HALF_STEP(pA0, pA1, mnA, alA, pB0, pB1, alB, t + 1, 0, 1, 1);
    }
    const bool even = (NT & 1) == 0;
    if (even) { SBAR(); qkt<1>(pB0, pB1, K_lds, bias_l + 4 * hi + KBASE(NT - 1), r32, hi, S.qr); SBAR(); }
    SBAR();
    finishSM(pA0, pA1, alA, l_reg, pa0, pa1, pa2, pa3); SBAR();
    pv_tile<0>(o, vb0, pa0, pa1, pa2, pa3);
    if (even) { MASKT(pB0, pB1, NT - 1); partialSM(pB0, pB1, m_reg, mnB, alB); __syncthreads(); RESC(alB);
        finishSM(pB0, pB1, alB, l_reg, pa0, pa1, pa2, pa3); SBAR(); pv_tile<1>(o, vb0, pa0, pa1, pa2, pa3); }
    SBAR();
    if (hi == 0) li_l[r32] = l_reg; asm volatile("s_waitcnt lgkmcnt(0)" ::: "memory");
    float rli[16];
#pragma unroll
    for (int r = 0; r < 16; ++r) rli[r] = __builtin_amdgcn_rcpf(li_l[crow(r, hi)]);
    int eoff = 4 * hi * OST + r32;
    asm volatile("" : "+v"(eoff));
    bf16_t* Ow = cur.O + (size_t)(wid * QBLK) * OST + eoff; const bf16_t* Gw = cur.GZ + (size_t)(wid * QBLK) * OST + eoff;
    unsigned gzv[16][4];
#pragma unroll
    for (int r = 0; r < 16; ++r) { const int ro = ((r & 3) + 8 * (r >> 2)) * OST;
#pragma unroll
        for (int d0 = 0; d0 < 4; ++d0) gzv[r][d0] = Gw[ro + d0 * 32]; }
#pragma unroll
    for (int r = 0; r < 16; ++r) { const int ro = ((r & 3) + 8 * (r >> 2)) * OST;
#pragma unroll
        for (int d0 = 0; d0 < 4; ++d0) { const float v = o[d0][r] * rli[r] * __uint_as_float(gzv[r][d0] << 16);
            const float vn = __shfl_xor(v, 1);
            if ((r32 & 1) == 0) *(unsigned*)(Ow + ro + d0 * 32) = pkbf(v, vn); } }
    __syncthreads();
#undef RESC
#undef KBASE
#undef MASKT
#undef SEAM_K0
#undef HALF_STEP
}
#undef ROW
#undef VMW
#undef VMWN
#undef LD8
#undef SLOAD_H
#undef SWRITE_HK
#undef SWRITE_HV
#undef SWRITE_H

struct Tensors { const bf16_t* Q; const bf16_t* K; const bf16_t* V; bf16_t* O; const bf16_t* GZ; const float* BIAS; };
__device__ __forceinline__ BlockRef make_ref(const Tensors& T, int L, int pass) {
    const int xcd = L & 7, k = L >> 3, bh = xcd * 4 + (k >> 3), x = k & 7, qb = pass ? 15 - x : x, b = bh >> 4, h = bh & 15;
    BlockRef r;
    r.Q = T.Q + ((size_t)bh * SEQ + (size_t)qb * QB) * D; r.K = T.K + (size_t)bh * SKV * D; r.V = T.V + (size_t)bh * SKV * D;
    r.O = T.O + ((size_t)(b * SEQ + qb * QB)) * OST + h * D; r.GZ = T.GZ + ((size_t)(b * SEQ + qb * QB)) * OST + h * D;
    r.BIAS = T.BIAS + bh * SKV; r.P0 = KPAD + qb * QB;
    return r;
}
__device__ __forceinline__ void attn_phase(char* lds, const Tensors& T) {
    const int total = 256, stride = gridDim.x;
    int L = blockIdx.x; if (L >= total) return;
    Seam S;
    for (; L < total; L += stride)
        for (int pass = 0; pass < 2; ++pass) {
            const BlockRef cur = make_ref(T, L, pass);
            causal_prime(cur, lds, S);
            causal_block(cur, lds, S);
        }
}
#undef KSWZ
#undef SBAR
}
constexpr int NWAVES = 8, LDS_BYTES = 147456;
static_assert(pg8::STAGE_BYTES + 8192 <= LDS_BYTES - 256 && pg8::STAGE_BYTES <= LDS_BYTES && HG_END <= LDS_BYTES && attn::LDS_BYTES <= LDS_BYTES, "LDS budget");
constexpr int N_PHASES = 9;
constexpr size_t WS_BAR = 1376256;
constexpr int LDS_MISC = LDS_BYTES - 256;
static_assert(WS_BAR >= (size_t)SM_END * 4 && WS_BAR % 256 == 0 && WS_BAR + 3 * XCD_BAR_WORDS * 4 <= 2 * MiB && HG_END <= LDS_MISC, "barrier words");
struct Args { const float* in[15]; float* out; unsigned char* ws; int ph_lo, ph_hi, li, pad; };

__global__ void __launch_bounds__(NWAVES * 64, 2) yoco_fwd(Args args) {
    extern __shared__ __attribute__((aligned(16))) unsigned char lds_raw[];
    LAS unsigned char* lds = (LAS unsigned char*)lds_raw;
    const int tid = threadIdx.x, lane = tid & 63, wave = __builtin_amdgcn_readfirstlane(tid >> 6);
    const int G = gridDim.x, gw = blockIdx.x * NWAVES + wave, NGW = G * NWAVES;
    unsigned char* ws = args.ws;
    Ptrs P;
    P.x = args.in[0]; P.meta = args.in[1]; P.gamma_lb = args.in[2]; P.a_norm = args.in[3]; P.a_w_in = args.in[4]; P.a_out_norm = args.in[5]; P.a_w_out = args.in[6];
    P.kv_norm = args.in[7]; P.kv_w = args.in[8]; P.fox_b_f = args.in[9]; P.fox_k_norm = args.in[10]; P.b_norm = args.in[11]; P.b_w_in = args.in[12]; P.b_q_norm = args.in[13]; P.b_w_out = args.in[14];
    P.out = args.out; P.sm = (float*)(ws + WS_SMALL);
    P.WT_AIN = (bf16_t*)(ws + WS_WT_AIN); P.WT_AOUT = (bf16_t*)(ws + WS_WT_AOUT); P.WT_KVB = (bf16_t*)(ws + WS_WT_KVB); P.WT_BOUT = (bf16_t*)(ws + WS_WT_BOUT); P.WT_F = (bf16_t*)(ws + WS_WT_F);
    P.XN0 = (bf16_t*)(ws + WS_XN0); P.QS = (bf16_t*)(ws + WS_QS); P.VV = (bf16_t*)(ws + WS_VV); P.GZ = (bf16_t*)(ws + WS_GZ); P.OG = (bf16_t*)(ws + WS_OG);
    bf16_t* H1BF = (bf16_t*)(ws + WS_XN0); bf16_t* KB = (bf16_t*)(ws + WS_QS); bf16_t* VB = (bf16_t*)(ws + WS_VV); bf16_t* QB2 = (bf16_t*)(ws + WS_GZ); bf16_t* GZ2 = (bf16_t*)(ws + WS_OG);
    float* SEGS = (float*)(ws + WS_WT_AIN); bf16_t* OG2 = (bf16_t*)(ws + WS_WT_AIN);
    unsigned short* LOGF = (unsigned short*)args.out;
    const int lo = args.ph_lo, hi = args.ph_hi;
    volatile LAS unsigned* MISC = (volatile LAS unsigned*)(lds + LDS_MISC);
    if (tid < 2) MISC[tid] = 0u;
    __syncthreads();
    const XcdBarrier bar = xcd_barrier_post((unsigned*)(ws + WS_BAR) + args.li * XCD_BAR_WORDS, MISC);
#ifndef PH_MASK
#ifdef DBG_STOP
#define PH_MASK ((2 << DBG_STOP) - 1)
#else
#define PH_MASK 0x1ff
#endif
#endif
#define IN(k) (((PH_MASK >> (k)) & 1) && lo <= (k) && (k) < hi)
#define SEAM(k) do { if (IN(k) && IN((k) + 1)) xcd_barrier(bar); } while (0)

#ifndef PH_DUP
#define PH_DUP -1
#endif
#define GSYNC() xcd_barrier(bar)
#if PH_DUP < 0
#define REP(k)
#define REP_END
#else
#define REP(k) for (int rep_ = 0; rep_ < (PH_DUP == (k) ? 2 : 1); ++rep_) { if (PH_DUP == (k) && rep_ == 1) GSYNC();
#define REP_END }
#endif
#ifdef EXTRA_SYNCS
    for (int es = 0; es < EXTRA_SYNCS; ++es) GSYNC();
#endif
    REP(0)
    if (IN(0)) { p0_prologue(P, lds, gw, NGW, wave, lane); }
    REP_END
    SEAM(0);
    REP(1)
    if (IN(1)) {
        pg8::Gemm g{P.XN0, P.WT_AIN, MR, 8192, DM}; pg8::StaticOrder S; S.init(MR, 8192, G, (int)blockIdx.x);
        pg8::Epi1 E{P.QS, LOGF, P.VV, P.GZ, P.sm + SM_LBV};
        pg8::gemm_phase<pg8::Epi1, pg8::StaticOrder, true, true>(lds, g, S, E);
        p1_meta(P, lds, gw, NGW, wave, lane);
    }
    REP_END
    SEAM(1);
    REP(2)
    if (IN(2)) {
        for (int it = blockIdx.x; it < 32 * 7; it += G) { const int bh = it / 7, seg = it % 7;
            hgrn_item<0>(lds, P.QS, LOGF, (const unsigned short*)(P.sm + SM_LOGFM), P.VV, P.GZ, P.OG, SEGS, P.sm + SM_DSEG, bh >> 4, bh & 15, seg); }
    }
    REP_END
    SEAM(2);
    REP(3)
    if (IN(3)) {
        for (int it = blockIdx.x; it < 256; it += G) { const int bh = it >> 3, seg = it & 7;
            hgrn_item<1>(lds, P.QS, LOGF, (const unsigned short*)(P.sm + SM_LOGFM), P.VV, P.GZ, P.OG, SEGS, P.sm + SM_DSEG, bh >> 4, bh & 15, seg); }
    }
    REP_END
    SEAM(3);
    if (IN(4)) {
        pg8::Gemm g{P.OG, P.WT_AOUT, MR, DM, DM}; pg8::StaticOrder S; S.init(MR, DM, G, (int)blockIdx.x);
        pg8::Epi2 E{P.x, P.out, H1BF, P.sm + SM_ROWSS};
        pg8::gemm_phase<pg8::Epi2, pg8::StaticOrder, true, true>(lds, g, S, E);
        p4_meta(P, H1BF, lds, gw, NGW, wave, lane);
    }
    SEAM(4);
    REP(5)
    if (IN(5)) {
        pg8::Gemm g{H1BF, P.WT_KVB, MR, 8192, DM}; pg8::StaticOrder S; S.init(MR, 8192, G, (int)blockIdx.x);
        pg8::Epi3 E{KB, VB, QB2, GZ2, P.sm + SM_ROWSS, P.fox_k_norm, P.b_q_norm, (LAS float*)(lds + pg8::STAGE_BYTES)};
        pg8::gemm_phase<pg8::Epi3, pg8::StaticOrder, true, true>(lds, g, S, E);
        p5_side(P, H1BF, KB, VB, lds, gw, NGW, wave, lane);
    }
    REP_END
    SEAM(5);
    if (IN(6)) { p6_norm_scan(P, KB, QB2, gw, NGW, lane); }
    SEAM(6);
    REP(7)
    if (IN(7)) {
        const attn::Tensors T{QB2, KB, VB, OG2, GZ2, P.sm + SM_BIAS};
        attn::attn_phase((char*)lds_raw, T);
    }
    REP_END
    SEAM(7);
    if (IN(8)) {
        pg8::Gemm g{OG2, P.WT_BOUT, MR, DM, DM}; pg8::StaticOrder S; S.init(MR, DM, G, (int)blockIdx.x);
        pg8::Epi4 E{H1BF, P.out};
        pg8::gemm_phase<pg8::Epi4, pg8::StaticOrder, true, true>(lds, g, S, E);
    }
#ifdef DBG_STOP
    { xcd_barrier(bar);
      const size_t n = (size_t)MR * DM;
      for (size_t i = (size_t)blockIdx.x * 512 + tid; i < n; i += (size_t)G * 512) {
          float v = 0.f;
          if (DBG_STOP == 1) v = bf2f(P.QS[i]) + bf2f(P.VV[i]) + bf2f(P.GZ[i]);
          if (DBG_STOP == 2) v = (i < (size_t)224 * 16384 ? SEGS[(i / (7 * 16384)) * (8 * 16384) + (i % (7 * 16384))] : 0.f) + (i < 32768 ? P.sm[SM_LOGFM + i] : 0.f) + (i < 16 * DM ? bf2f(P.QS[(size_t)MR * DM + i]) + bf2f(P.VV[(size_t)MR * DM + i]) + bf2f(P.GZ[(size_t)MR * DM + i]) : 0.f);
          if (DBG_STOP == 3) v = bf2f(P.OG[i]);
          if (DBG_STOP == 4) v = args.out[i] + bf2f(H1BF[i]);
          if (DBG_STOP == 5 || DBG_STOP == 6) v = bf2f(KB[i]) + bf2f(VB[i]) + bf2f(QB2[i]) + bf2f(GZ2[i]) + (i < 32 * SKV ? P.sm[SM_BIAS + i] * 1e-3f : 0.f);
          if (DBG_STOP == 7) v = bf2f(OG2[i]);
          args.out[i] = v;
      } }
#endif
#undef IN
#undef SEAM
}

#ifndef MK_PER_PHASE
#define MK_PER_PHASE 0
#endif
extern "C" void kernel_launch(void* const* d_in, const int* in_sizes, int n_in, void* d_out, int out_size, void* d_ws, size_t ws_size, hipStream_t stream) {
    static int grid = 0;
    if (grid == 0) {
        if (n_in != 15 || out_size != MR * DM || ws_size < WS_END) { fprintf(stderr, "kernel_launch: unexpected shapes (n_in %d, out %d, ws %zu)\n", n_in, out_size, ws_size); grid = -1; return; }
        int dev = 0, cus = 0, per_cu = 0;
        (void)hipGetDevice(&dev); (void)hipDeviceGetAttribute(&cus, hipDeviceAttributeMultiprocessorCount, dev);
        if (hipFuncSetAttribute((const void*)yoco_fwd, hipFuncAttributeMaxDynamicSharedMemorySize, LDS_BYTES) != hipSuccess) { fprintf(stderr, "kernel_launch: hipFuncSetAttribute failed\n"); grid = -1; return; }
        if (hipOccupancyMaxActiveBlocksPerMultiprocessor(&per_cu, (const void*)yoco_fwd, NWAVES * 64, LDS_BYTES) != hipSuccess || per_cu < 1) { fprintf(stderr, "kernel_launch: occupancy query says %d blocks per CU\n", per_cu); per_cu = 1; }
        (void)hipGetLastError();
        grid = cus > 0 ? cus : 256;
    }
    if (grid < 0) return;
    if (hipMemsetAsync((char*)d_ws + WS_BAR, 0, 3 * XCD_BAR_WORDS * 4, stream) != hipSuccess) { fprintf(stderr, "kernel_launch: hipMemsetAsync failed\n"); return; }
    Args a{};
    for (int i = 0; i < 15; ++i) a.in[i] = (const float*)d_in[i];
    a.out = (float*)d_out; a.ws = (unsigned char*)d_ws;
#if defined(DUP_PHASE)
    {
        const int cuts[4][2] = {{0, DUP_PHASE + 1}, {DUP_PHASE, DUP_PHASE + 1}, {DUP_PHASE + 1, N_PHASES}, {0, 0}};
        for (int li = 0; li < 3; ++li) { if (cuts[li][0] >= cuts[li][1]) continue; a.ph_lo = cuts[li][0]; a.ph_hi = cuts[li][1]; a.li = li; void* kargs[] = {&a};
            hipError_t e = hipLaunchCooperativeKernel((const void*)yoco_fwd, dim3(grid), dim3(NWAVES * 64), kargs, LDS_BYTES, stream);
            if (e != hipSuccess) { fprintf(stderr, "kernel_launch: launch %d failed: %s\n", li, hipGetErrorString(e)); break; } }
    }
#elif MK_PER_PHASE
    for (int p = 0; p < N_PHASES; ++p) { a.ph_lo = p; a.ph_hi = p + 1; void* kargs[] = {&a};
        hipError_t e = hipLaunchCooperativeKernel((const void*)yoco_fwd, dim3(grid), dim3(NWAVES * 64), kargs, LDS_BYTES, stream);
        if (e != hipSuccess) { fprintf(stderr, "kernel_launch: launch of phase %d failed: %s\n", p, hipGetErrorString(e)); break; } }
#else
    a.ph_lo = 0; a.ph_hi = N_PHASES; void* kargs[] = {&a};
    hipError_t e = hipLaunchCooperativeKernel((const void*)yoco_fwd, dim3(grid), dim3(NWAVES * 64), kargs, LDS_BYTES, stream);
    if (e != hipSuccess) fprintf(stderr, "kernel_launch: cooperative launch failed: %s (grid %d)\n", hipGetErrorString(e), grid);
#endif
}
```

```cpp
#include <hip/hip_runtime.h>
#include <hip/hip_cooperative_groups.h>
#include <cstdio>
#include <cstdint>
namespace cg = cooperative_groups;

constexpr int NB = 2, SEQ = 4096, DM = 2048, NH = 16, HD = 128, NMETA = 16;
constexpr int MR = NB * SEQ;
constexpr int MT = MR + NMETA;
constexpr int KPAD = 64;
constexpr int SKV = SEQ + KPAD;
constexpr float EPS = 1e-6f;

constexpr size_t MiB = 1u << 20;
constexpr size_t WS_SMALL = 0;
constexpr size_t WS_WT_AIN = 2 * MiB;
constexpr size_t WS_WT_AOUT = 34 * MiB;
constexpr size_t WS_WT_KVB = 42 * MiB;
constexpr size_t WS_WT_BOUT = 74 * MiB;
constexpr size_t WS_WT_F = 82 * MiB;
constexpr size_t WS_XN0 = 83 * MiB;
constexpr size_t WS_QS = 116 * MiB;
constexpr size_t WS_VV = 149 * MiB;
constexpr size_t WS_GZ = 182 * MiB;
constexpr size_t WS_OG = 215 * MiB;
constexpr size_t WS_END = 248 * MiB;
static_assert(WS_VV - WS_QS == 33 * MiB && WS_GZ - WS_VV == 33 * MiB, "Epi1 selects QS | VV | GZ by stride");
constexpr int SM_ROWSS = 0;
constexpr int SM_LBV = 8448;
constexpr int SM_LOGFM = 10496;
constexpr int SM_LOGF2 = 43264;
constexpr int SM_BIAS = 174592;
constexpr int SM_DSEG = 307712;
constexpr int SM_END = 340480;
static_assert(SM_LBV >= SM_ROWSS + MT && SM_LOGFM >= SM_LBV + 2048 && SM_LOGF2 >= SM_LOGFM + 16 * 2048 && SM_BIAS >= SM_LOGF2 + MT * 16 && SM_DSEG >= SM_BIAS + 32 * SKV && SM_END >= SM_DSEG + 256 * 128 && SM_END * 4 <= 2 * (int)MiB, "small map");

#define LAS __attribute__((address_space(3)))
typedef unsigned short bf16_t;
typedef short bf16x8 __attribute__((ext_vector_type(8)));
typedef short s16x4 __attribute__((ext_vector_type(4)));
typedef float f32x4 __attribute__((ext_vector_type(4)));
typedef float f32x16 __attribute__((ext_vector_type(16)));
typedef unsigned u32x4 __attribute__((ext_vector_type(4)));
typedef unsigned u32x2 __attribute__((ext_vector_type(2)));

__device__ __forceinline__ float bf2f(bf16_t v) { return __uint_as_float(((unsigned)v) << 16); }
typedef __bf16 bf16x2_t __attribute__((ext_vector_type(2)));
typedef float f32x2_t __attribute__((ext_vector_type(2)));
__device__ __forceinline__ unsigned pkbf(float lo, float hi) { f32x2_t v = {lo, hi}; bf16x2_t b = __builtin_convertvector(v, bf16x2_t); return __builtin_bit_cast(unsigned, b); }
typedef _Float16 f16x2_t __attribute__((ext_vector_type(2)));
__device__ __forceinline__ unsigned pkh(float lo, float hi) { f32x2_t v = {lo, hi}; f16x2_t b = __builtin_convertvector(v, f16x2_t); return __builtin_bit_cast(unsigned, b); }
__device__ __forceinline__ float h2f(unsigned v) { return (float)__builtin_bit_cast(_Float16, (unsigned short)v); }
__device__ __forceinline__ float fexp(float x) { return __builtin_amdgcn_exp2f(x * 1.4426950408889634f); }
__device__ __forceinline__ float fsigmoid(float x) { return __builtin_amdgcn_rcpf(1.0f + fexp(-x)); }
__device__ __forceinline__ float fsilu(float x) { return x * fsigmoid(x); }
__device__ __forceinline__ float flog(float x) { return __builtin_amdgcn_logf(x) * 0.6931471805599453f; }
__device__ __forceinline__ float wave_sum(float v) {
#pragma unroll
    for (int o = 1; o < 64; o <<= 1) v += __shfl_xor(v, o);
    return v;
}
namespace pg8 {
#define PG8_LAS __attribute__((address_space(3)))
typedef unsigned short bf16_t;
typedef short bf16x8 __attribute__((ext_vector_type(8)));
typedef float f32x4 __attribute__((ext_vector_type(4)));
typedef unsigned u32x4 __attribute__((ext_vector_type(4)));
constexpr int BM = 256, BK = 64, HALF = 128, HTB = HALF * BK * 2  , STAGE_BYTES = 8 * HTB, NXCD = 8, WGM = 4;

__host__ __device__ __forceinline__ int lds_byte(int r, int c) { const int st = (r >> 4) * 2 + (c >> 5), rr = r & 15, cc = c & 31, ob = rr * 64 + cc * 2; return st * 1024 + (ob ^ (((ob >> 9) & 1) << 5)); }
__host__ __device__ __forceinline__ void stage_rc(int b, int& R, int& C) { const int st = b / 1024, sb = b % 1024, swz = sb ^ (((sb >> 9) & 1) << 5); R = (st >> 1) * 16 + swz / 64; C = (st & 1) * 32 + (swz % 64) / 2; }
__host__ __device__ __forceinline__ int perm32(int rho) { const int n = rho >> 4, i = rho & 15; return 8 * (i >> 2) + 4 * n + (i & 3); }

struct Unit { int pm, pn; };
struct Gemm { const bf16_t* A; const bf16_t* Bt; int M, N, K; };

struct StaticOrder {
    int nM, nN, nwg, G, c;
    __host__ __device__ void init(int M, int N, int G_, int c_) { nM = M / BM; nN = N / BM; nwg = nM * nN; G = G_; c = c_; }
    __host__ __device__ bool next(int i, Unit& u) const {
        const long L = (long)i * G + c; if (L >= nwg) return false;
        int wgid = (int)L; { const int q = nwg / NXCD, r = nwg % NXCD, xcd = wgid % NXCD, off = wgid / NXCD; wgid = (xcd < r ? xcd * (q + 1) : r * (q + 1) + (xcd - r) * q) + off; }
        const int nig = WGM * nN, gid = wgid / nig, fm = gid * WGM, gsz = (nM - fm) < WGM ? (nM - fm) : WGM;
        u.pm = fm + ((wgid % nig) % gsz); u.pn = (wgid % nig) / gsz; return true;
    }
    __device__ __forceinline__ void a_ready(const Unit&) const {}
    __device__ __forceinline__ void done(const Unit&) const {}
};
__device__ __forceinline__ unsigned cvt_pk_bf16(float lo, float hi) { unsigned r; asm volatile("v_cvt_pk_bf16_f32 %0, %1, %2" : "=v"(r) : "v"(lo), "v"(hi)); return r; }
struct Epi1 {
    static constexpr bool PERM = true, AFTER_DRAIN = false;
    bf16_t* QS; unsigned short* LOGF; bf16_t* VV; bf16_t* GZ; const float* lbv;
    __device__ __forceinline__ void operator()(const f32x4 (&acc)[2][2][4][2], const Unit& u, int wr, int wc, int fr, int fq) const {
        const int type = u.pn >> 3, colt = (u.pn & 7) * BM;
        const int row0 = u.pm * BM + wr * 64 + fr, col0 = colt + wc * 32 + 8 * fq;
        if (type == 1) {
#pragma unroll
            for (int bj = 0; bj < 2; ++bj) {
                const f32x4 l0 = *(const f32x4*)(lbv + col0 + bj * HALF), l1 = *(const f32x4*)(lbv + col0 + bj * HALF + 4);
#pragma unroll
                for (int ai = 0; ai < 2; ++ai)
#pragma unroll
                    for (int m = 0; m < 4; ++m) {
                        unsigned short* rowp = LOGF + (size_t)(row0 + ai * HALF + m * 16) * DM + col0 + bj * HALF;
                        f32x4 v0 = acc[ai][bj][m][0], v1 = acc[ai][bj][m][1], o0, o1;
#pragma unroll
                        for (int j = 0; j < 4; ++j) { o0[j] = flog(l0[j] + (1.0f - l0[j]) * fsigmoid(v0[j])); o1[j] = flog(l1[j] + (1.0f - l1[j]) * fsigmoid(v1[j])); }
                        u32x4 w; w.x = pkh(o0[0], o0[1]); w.y = pkh(o0[2], o0[3]); w.z = pkh(o1[0], o1[1]); w.w = pkh(o1[2], o1[3]);
                        *(u32x4*)rowp = w;
                    }
            }
        } else {
            bf16_t* base = QS + (size_t)(type - (type > 0 ? 1 : 0)) * (size_t)(33u << 19);
            const bool act = type != 2;
#pragma unroll
            for (int ai = 0; ai < 2; ++ai)
#pragma unroll
                for (int m = 0; m < 4; ++m) {
                    bf16_t* rowp = base + (size_t)(row0 + ai * HALF + m * 16) * DM + col0;
#pragma unroll
                    for (int bj = 0; bj < 2; ++bj) {
                        f32x4 v0 = acc[ai][bj][m][0], v1 = acc[ai][bj][m][1];
                        if (act) {
#pragma unroll
                            for (int j = 0; j < 4; ++j) { v0[j] = fsilu(v0[j]); v1[j] = fsilu(v1[j]); }
                        }
                        u32x4 w; w.x = pkbf(v0[0], v0[1]); w.y = pkbf(v0[2], v0[3]); w.z = pkbf(v1[0], v1[1]); w.w = pkbf(v1[2], v1[3]);
                        *(u32x4*)(rowp + bj * HALF) = w;
                    }
                }
        }
    }
};
struct Epi2 {
    static constexpr bool PERM = false, AFTER_DRAIN = false;
    const float* X; float* H1; bf16_t* H1BF; float* rowss;
    __device__ __forceinline__ void operator()(const f32x4 (&acc)[2][2][4][2], const Unit& u, int wr, int wc, int fr, int fq) const {
        const int row0 = u.pm * BM + wr * 64 + fr, col0 = u.pn * BM + wc * 32 + 4 * fq;
#pragma unroll
        for (int ai = 0; ai < 2; ++ai)
#pragma unroll
            for (int m = 0; m < 4; ++m) {
                const int row = row0 + ai * HALF + m * 16; const size_t off = (size_t)row * DM + col0; float ss = 0.f;
#pragma unroll
                for (int bj = 0; bj < 2; ++bj)
#pragma unroll
                    for (int n = 0; n < 2; ++n) {
                        const f32x4 h = *(const f32x4*)(X + off + bj * HALF + n * 16) + acc[ai][bj][m][n];
                        u32x2 w; w.x = pkbf(h[0], h[1]); w.y = pkbf(h[2], h[3]);
                        *(u32x2*)(H1BF + off + bj * HALF + n * 16) = w;
                        ss += (h[0] * h[0] + h[1] * h[1]) + (h[2] * h[2] + h[3] * h[3]);
                    }
                ss += __shfl_xor(ss, 16); ss += __shfl_xor(ss, 32);
                if (fq == 0) atomicAdd(rowss + row, ss);
                asm volatile("" ::: "memory");
            }
    }
};
struct Epi3 {
    static constexpr bool PERM = true, AFTER_DRAIN = false;
    bf16_t* KB; bf16_t* VB; bf16_t* QB2; bf16_t* GZ2; const float* rowss; const float* gk; const float* gq; PG8_LAS float* xs;
    __device__ __forceinline__ void operator()(const f32x4 (&acc)[2][2][4][2], const Unit& u, int wr, int wc, int fr, int fq) const {
        const int type = u.pn >> 3, row0 = u.pm * BM + wr * 64 + fr;
        const int b = row0 >> 12;
        float rs[2][4];
#pragma unroll
        for (int ai = 0; ai < 2; ++ai)
#pragma unroll
            for (int m = 0; m < 4; ++m) rs[ai][m] = __builtin_amdgcn_rsqf(rowss[row0 + ai * HALF + m * 16] * (1.0f / DM) + EPS);
        const bool normed = (type == 0 || type == 2);
        if (normed) {
#pragma unroll
            for (int ai = 0; ai < 2; ++ai)
#pragma unroll
                for (int m = 0; m < 4; ++m)
#pragma unroll
                    for (int bj = 0; bj < 2; ++bj) {
                        const f32x4 v0 = acc[ai][bj][m][0] * rs[ai][m], v1 = acc[ai][bj][m][1] * rs[ai][m];
                        float ss = (v0[0] * v0[0] + v0[1] * v0[1]) + (v0[2] * v0[2] + v0[3] * v0[3]) + (v1[0] * v1[0] + v1[1] * v1[1]) + (v1[2] * v1[2] + v1[3] * v1[3]);
                        ss += __shfl_xor(ss, 16); ss += __shfl_xor(ss, 32);
                        if (fq == 0) xs[((ai * HALF + wr * 64 + m * 16 + fr) * 2 + bj) * 4 + wc] = ss;
                    }
            asm volatile("s_waitcnt lgkmcnt(0)" ::: "memory"); __builtin_amdgcn_s_barrier(); asm volatile("" ::: "memory");
        }
#pragma unroll
        for (int bj = 0; bj < 2; ++bj) {
            const int head = (u.pn & 7) * 2 + bj, bh = b * NH + head;
            f32x4 g0 = {1.f, 1.f, 1.f, 1.f}, g1 = g0;
            if (normed) { const float* gp = (type == 0 ? gk : gq) + head * HD + wc * 32 + 8 * fq; g0 = *(const f32x4*)gp; g1 = *(const f32x4*)(gp + 4); }
#pragma unroll
            for (int ai = 0; ai < 2; ++ai)
#pragma unroll
                for (int m = 0; m < 4; ++m) {
                    const int row = row0 + ai * HALF + m * 16, t = row & (SEQ - 1);
                    float sc = rs[ai][m];
                    if (normed) { const f32x4 p4 = *(const PG8_LAS f32x4*)(xs + ((ai * HALF + wr * 64 + m * 16 + fr) * 2 + bj) * 4);
                        sc *= __builtin_amdgcn_rsqf(((p4[0] + p4[1]) + (p4[2] + p4[3])) * (1.0f / HD) + EPS); }
                    f32x4 v0 = acc[ai][bj][m][0] * sc * g0, v1 = acc[ai][bj][m][1] * sc * g1;
                    bf16_t* dst;
                    if (type == 3) {
#pragma unroll
                        for (int j = 0; j < 4; ++j) { v0[j] = fsilu(v0[j]); v1[j] = fsilu(v1[j]); }
                        dst = GZ2 + (size_t)row * DM + (u.pn & 7) * BM + bj * HALF + wc * 32 + 8 * fq;
                    } else if (type == 2) dst = QB2 + ((size_t)bh * SEQ + t) * HD + wc * 32 + 8 * fq;
                    else dst = (type == 0 ? KB : VB) + ((size_t)bh * SKV + KPAD + t) * HD + wc * 32 + 8 * fq;
                    u32x4 w; w.x = pkbf(v0[0], v0[1]); w.y = pkbf(v0[2], v0[3]); w.z = pkbf(v1[0], v1[1]); w.w = pkbf(v1[2], v1[3]);
                    *(u32x4*)dst = w;
                }
        }
    }
};
struct Epi4 {
    static constexpr bool PERM = false, AFTER_DRAIN = false;
    const bf16_t* H1BF; float* OUT;
    __device__ __forceinline__ void operator()(const f32x4 (&acc)[2][2][4][2], const Unit& u, int wr, int wc, int fr, int fq) const {
        const int row0 = u.pm * BM + wr * 64 + fr, col0 = u.pn * BM + wc * 32 + 4 * fq;
#pragma unroll
        for (int ai = 0; ai < 2; ++ai)
#pragma unroll
            for (int m = 0; m < 4; ++m) {
                const size_t off = (size_t)(row0 + ai * HALF + m * 16) * DM + col0;
#pragma unroll
                for (int bj = 0; bj < 2; ++bj)
#pragma unroll
                    for (int n = 0; n < 2; ++n) {
                        const u32x2 w = *(const u32x2*)(H1BF + off + bj * HALF + n * 16);
                        const f32x4 h = {__uint_as_float(w.x << 16), __uint_as_float(w.x & 0xffff0000u), __uint_as_float(w.y << 16), __uint_as_float(w.y & 0xffff0000u)};
                        *(f32x4*)(OUT + off + bj * HALF + n * 16) = h + acc[ai][bj][m][n];
                    }
                asm volatile("" ::: "memory");
            }
    }
};
template <class Epi, class Sched, bool ALIGN_EPI = false, bool SP2 = false>
__device__ __forceinline__ void gemm_phase(PG8_LAS unsigned char* lds, const Gemm g, const Sched& S, const Epi& E) {
    const int tid = threadIdx.x, wid = __builtin_amdgcn_readfirstlane(tid >> 6), lane = tid & 63, wr = wid >> 2, wc = wid & 3, fr = lane & 15, fq = lane >> 4;
    const int K = g.K, nt = K / BK;
    unsigned voffA[2], voffB[2];
#pragma unroll
    for (int i = 0; i < 2; ++i) { int R, C; stage_rc(tid * 16 + i * 8192, R, C); const int Rb = Epi::PERM ? ((R & ~31) + perm32(R & 31)) : R;
        voffA[i] = (unsigned)(R * K + C) * 2u; voffB[i] = (unsigned)(Rb * K + C) * 2u; }
    const size_t kstep = (size_t)(BK * 2);
    const size_t hstep = (size_t)HALF * K * 2;
    const size_t tstep = 2 * hstep;
    const unsigned ldsw = (unsigned)wid * 1024u;
    const int aoff = lds_byte(wr * 64 + fr, fq * 8), boff = lds_byte(wc * 32 + fr, fq * 8);
#define PG8_SA(b, h) (((b) * 2 + (h)) * HTB)
#define PG8_SB(b, h) ((4 + (b) * 2 + (h)) * HTB)
#define PG8_STAGE(bufoff, gbase, voff) do { _Pragma("unroll") for (int _i = 0; _i < 2; ++_i) \
        __builtin_amdgcn_global_load_lds((const unsigned*)((const char*)(gbase) + (voff)[_i]), (PG8_LAS unsigned*)(lds + (bufoff) + ldsw + _i * 8192), 16, 0, 0); } while (0)
#define PG8_LDA(dst, b, h) do { _Pragma("unroll") for (int m = 0; m < 4; ++m) _Pragma("unroll") for (int k = 0; k < 2; ++k) dst[m][k] = *(const PG8_LAS bf16x8*)(lds + PG8_SA(b, h) + aoff + m * 2048 + k * 1024); } while (0)
#define PG8_LDB(dst, b, h) do { _Pragma("unroll") for (int n = 0; n < 2; ++n) _Pragma("unroll") for (int k = 0; k < 2; ++k) dst[n][k] = *(const PG8_LAS bf16x8*)(lds + PG8_SB(b, h) + boff + n * 2048 + k * 1024); } while (0)
#define PG8_MMA(ai, bj, At, Bt) do { __builtin_amdgcn_s_setprio(1); _Pragma("unroll") for (int m = 0; m < 4; ++m) _Pragma("unroll") for (int n = 0; n < 2; ++n) _Pragma("unroll") for (int k = 0; k < 2; ++k) \
        acc[ai][bj][m][n] = __builtin_amdgcn_mfma_f32_16x16x32_bf16(Bt[n][k], At[m][k], acc[ai][bj][m][n], 0, 0, 0); __builtin_amdgcn_s_setprio(0); } while (0)
#define PG8_WAIT_V(n) asm volatile("s_waitcnt vmcnt(" #n ")" ::: "memory")
#define PG8_WAIT_L(n) asm volatile("s_waitcnt lgkmcnt(" #n ")" ::: "memory")
#define PG8_BAR __builtin_amdgcn_s_barrier()
#define PG8_SCHED __builtin_amdgcn_sched_barrier(0)
    Unit cur, nxt; int ui = 0;
    if (!S.next(0, cur)) return;
    f32x4 acc[2][2][4][2];
#pragma unroll
    for (int a = 0; a < 2; ++a)
#pragma unroll
        for (int b = 0; b < 2; ++b)
#pragma unroll
            for (int m = 0; m < 4; ++m)
#pragma unroll
                for (int n = 0; n < 2; ++n) acc[a][b][m][n] = (f32x4){0.f, 0.f, 0.f, 0.f};
    bf16x8 At[4][2], B0[2][2], B1[2][2];
    const char* cA = (const char*)g.A + (size_t)cur.pm * tstep; const char* cB = (const char*)g.Bt + (size_t)cur.pn * tstep;
    S.a_ready(cur);
    if constexpr (SP2) {
        PG8_STAGE(PG8_SB(0, 0), cB, voffB); PG8_STAGE(PG8_SB(0, 1), cB + hstep, voffB); PG8_STAGE(PG8_SA(0, 0), cA, voffA); PG8_STAGE(PG8_SA(0, 1), cA + hstep, voffA);
        if (wr == 1) PG8_BAR;
        PG8_WAIT_V(2); PG8_BAR;
        PG8_STAGE(PG8_SB(1, 0), cB + kstep, voffB); PG8_STAGE(PG8_SA(1, 0), cA + kstep, voffA); PG8_STAGE(PG8_SB(1, 1), cB + hstep + kstep, voffB);
        PG8_WAIT_V(6); PG8_BAR;
    } else {
        PG8_STAGE(PG8_SB(0, 0), cB, voffB); PG8_STAGE(PG8_SA(0, 0), cA, voffA); PG8_STAGE(PG8_SB(0, 1), cB + hstep, voffB); PG8_STAGE(PG8_SA(0, 1), cA + hstep, voffA);
        if (wr == 1) PG8_BAR;
        PG8_WAIT_V(4); PG8_BAR;
        PG8_STAGE(PG8_SB(1, 0), cB + kstep, voffB); PG8_STAGE(PG8_SA(1, 0), cA + kstep, voffA); PG8_STAGE(PG8_SB(1, 1), cB + hstep + kstep, voffB);
        PG8_WAIT_V(6); PG8_BAR;
    }
    for (;;) {
        const bool has_next = S.next(ui + 1, nxt);
        const char* nA = has_next ? (const char*)g.A + (size_t)nxt.pm * tstep : cA; const char* nB = has_next ? (const char*)g.Bt + (size_t)nxt.pn * tstep : cB;
        for (int t = 0; t < nt; t += 2) {
            const bool last = (t == nt - 2);
            const char* a1 = cA + (size_t)(t + 1) * kstep;
            const char* a2 = last ? nA : cA + (size_t)(t + 2) * kstep; const char* b2 = last ? nB : cB + (size_t)(t + 2) * kstep;
            const char* a3 = a2 + kstep; const char* b3 = b2 + kstep;
            if (last && has_next) S.a_ready(nxt);
            if constexpr (SP2) {
            PG8_LDB(B0, 0, 0); PG8_LDB(B1, 0, 1); PG8_SCHED; PG8_LDA(At, 0, 0); PG8_STAGE(PG8_SA(1, 1), a1 + hstep, voffA);
            PG8_WAIT_V(8); PG8_WAIT_L(0); PG8_BAR; PG8_MMA(0, 0, At, B0); PG8_MMA(0, 1, At, B1); PG8_BAR; PG8_SCHED;
            PG8_LDA(At, 0, 1); PG8_STAGE(PG8_SB(0, 0), b2, voffB); PG8_STAGE(PG8_SB(0, 1), b2 + hstep, voffB); PG8_STAGE(PG8_SA(0, 0), a2, voffA);
            PG8_WAIT_V(8); PG8_WAIT_L(0); PG8_BAR; PG8_MMA(1, 0, At, B0); PG8_MMA(1, 1, At, B1); PG8_BAR; PG8_SCHED;
            PG8_LDB(B0, 1, 0); PG8_LDB(B1, 1, 1); PG8_SCHED; PG8_LDA(At, 1, 0); PG8_STAGE(PG8_SA(0, 1), a2 + hstep, voffA);
            PG8_WAIT_V(8); PG8_WAIT_L(0); PG8_BAR; PG8_MMA(0, 0, At, B0); PG8_MMA(0, 1, At, B1); PG8_BAR; PG8_SCHED;
            PG8_LDA(At, 1, 1); PG8_STAGE(PG8_SB(1, 0), b3, voffB); PG8_STAGE(PG8_SB(1, 1), b3 + hstep, voffB); PG8_STAGE(PG8_SA(1, 0), a3, voffA);
            PG8_WAIT_V(8); PG8_WAIT_L(0); PG8_BAR; PG8_MMA(1, 0, At, B0); PG8_MMA(1, 1, At, B1); PG8_BAR; PG8_SCHED;
            } else {
            PG8_LDB(B0, 0, 0); PG8_SCHED; PG8_LDA(At, 0, 0); PG8_STAGE(PG8_SA(1, 1), a1 + hstep, voffA);
            PG8_WAIT_L(8); PG8_BAR; PG8_WAIT_L(0); PG8_MMA(0, 0, At, B0); PG8_BAR; PG8_SCHED;
            PG8_LDB(B1, 0, 1); PG8_STAGE(PG8_SB(0, 0), b2, voffB);
            PG8_BAR; PG8_WAIT_L(0); PG8_MMA(0, 1, At, B1); PG8_BAR;
            PG8_LDA(At, 0, 1); PG8_STAGE(PG8_SA(0, 0), a2, voffA);
            PG8_BAR; PG8_WAIT_L(0); PG8_MMA(1, 0, At, B0); PG8_BAR; PG8_SCHED;
            PG8_STAGE(PG8_SB(0, 1), b2 + hstep, voffB);
            PG8_WAIT_V(6); PG8_BAR; PG8_MMA(1, 1, At, B1); PG8_BAR;
            PG8_LDB(B0, 1, 0); PG8_SCHED; PG8_LDA(At, 1, 0); PG8_STAGE(PG8_SA(0, 1), a2 + hstep, voffA);
            PG8_WAIT_L(8); PG8_BAR; PG8_WAIT_L(0); PG8_MMA(0, 0, At, B0); PG8_BAR; PG8_SCHED;
            PG8_LDB(B1, 1, 1); PG8_STAGE(PG8_SB(1, 0), b3, voffB);
            PG8_BAR; PG8_WAIT_L(0); PG8_MMA(0, 1, At, B1); PG8_BAR;
            PG8_LDA(At, 1, 1); PG8_STAGE(PG8_SA(1, 0), a3, voffA);
            PG8_BAR; PG8_WAIT_L(0); PG8_MMA(1, 0, At, B0); PG8_BAR; PG8_SCHED;
            PG8_STAGE(PG8_SB(1, 1), b3 + hstep, voffB);
            PG8_WAIT_V(6); PG8_BAR; PG8_MMA(1, 1, At, B1); PG8_BAR;
            }
        }
        if constexpr (ALIGN_EPI) { if (wr == 0) PG8_BAR; }
        if constexpr (!Epi::AFTER_DRAIN) { E(acc, cur, wr, wc, fr, fq); S.done(cur); }
        if (!has_next) break;
#pragma unroll
        for (int a = 0; a < 2; ++a)
#pragma unroll
            for (int b = 0; b < 2; ++b)
#pragma unroll
                for (int m = 0; m < 4; ++m)
#pragma unroll
                    for (int n = 0; n < 2; ++n) acc[a][b][m][n] = (f32x4){0.f, 0.f, 0.f, 0.f};
        cur = nxt; cA = nA; cB = nB; ++ui;
        if constexpr (ALIGN_EPI) { if (wr == 1) PG8_BAR; }
    }
    PG8_WAIT_V(0);
    if constexpr (!ALIGN_EPI) { if (wr == 0) PG8_BAR; }
    PG8_BAR;
    if constexpr (Epi::AFTER_DRAIN) { E.fused(acc, cur, wr, wc, fr, fq, lds, wid, lane); S.done(cur); }
#undef PG8_SA
#undef PG8_SB
#undef PG8_STAGE
#undef PG8_LDA
#undef PG8_LDB
#undef PG8_MMA
#undef PG8_WAIT_V
#undef PG8_WAIT_L
#undef PG8_BAR
#undef PG8_SCHED
}
}
#define XB_LAS __attribute__((address_space(3)))
#define XB_TMO      128
#define XB_XCNT(j)  (256  + 64 * (j))
#define XB_XSUB(j)  (1280 + 64 * (j))
#define XB_XGEN(j)  (2304 + 64 * (j))
#define XB_TOP      3328
#define XB_TOPGEN   3392
#define XCD_BAR_WORDS 3456
#define XB_SPIN_CAP (1u << 18)

__device__ __forceinline__ unsigned xb_ld(unsigned* p)              { return __hip_atomic_load(p, __ATOMIC_RELAXED, __HIP_MEMORY_SCOPE_AGENT); }
__device__ __forceinline__ unsigned xb_add(unsigned* p, unsigned v) { return __hip_atomic_fetch_add(p, v, __ATOMIC_RELAXED, __HIP_MEMORY_SCOPE_AGENT); }
__device__ __forceinline__ unsigned xb_xcc_id() { return (unsigned)__builtin_amdgcn_s_getreg((3 << 11) | 20) & 0xFu; }
#define XB_SPIN(cond, bar) do { unsigned _sp = 0; while (cond) { __builtin_amdgcn_s_sleep(1); \
    if ((++_sp & 255u) == 0u) { if (xb_ld(&(bar)[XB_TMO])) break; if (_sp > XB_SPIN_CAP) { atomicAdd(&(bar)[XB_TMO], 1u); break; } } } } while (0)

struct XcdBarrier {
    unsigned* bar; unsigned x;
    volatile XB_LAS unsigned* st;
};

__device__ __forceinline__ XcdBarrier xcd_barrier_post(unsigned* bar, volatile XB_LAS unsigned* st) {
    XcdBarrier b; b.bar = bar; b.x = xb_xcc_id(); b.st = st;
    if (threadIdx.x == 0) (void)xb_add(&bar[XB_XCNT(b.x)], 1u);
    return b;
}
__device__ __forceinline__ void xcd_barrier_complete(unsigned* bar, unsigned x, unsigned& nloc, unsigned& nx) {
    const unsigned G = gridDim.x * gridDim.y * gridDim.z;
    unsigned sum, cnt, mine, sp = 0u;
    for (;;) {
        sum = 0u; cnt = 0u; mine = 0u;
#pragma unroll
        for (unsigned j = 0; j < 16; ++j) { const unsigned c = xb_ld(&bar[XB_XCNT(j)]); sum += c; cnt += (c > 0u) ? 1u : 0u; mine = (j == x) ? c : mine; }
        if (sum == G) break;
        __builtin_amdgcn_s_sleep(1);
        if ((++sp & 255u) == 0u) { if (xb_ld(&bar[XB_TMO])) break; if (sp > XB_SPIN_CAP) { atomicAdd(&bar[XB_TMO], 1u); break; } }
    }
    nloc = mine > 0u ? mine : 1u; nx = cnt > 0u ? cnt : 1u;
}

__device__ __forceinline__ void xcd_barrier(const XcdBarrier& b) {
    asm volatile("s_waitcnt vmcnt(0)" ::: "memory");
    __syncthreads();
    if (threadIdx.x == 0) {
        unsigned* bar = b.bar;
        __builtin_amdgcn_s_waitcnt(0);
        unsigned nloc = b.st[0], nx = b.st[1];
        if (nloc == 0u) { xcd_barrier_complete(bar, b.x, nloc, nx); b.st[0] = nloc; b.st[1] = nx; }
        const unsigned old = xb_add(&bar[XB_XSUB(b.x)], 1u);
        const unsigned gen = old / nloc;
        if (old + 1u == (gen + 1u) * nloc) {
            __builtin_amdgcn_fence(__ATOMIC_RELEASE, "agent");
            asm volatile("s_waitcnt vmcnt(0)" ::: "memory");
            const unsigned og = xb_add(&bar[XB_TOP], 1u);
            const unsigned tg = og / nx;
            if (og + 1u == (tg + 1u) * nx) xb_add(&bar[XB_TOPGEN], 1u);
            else XB_SPIN(xb_ld(&bar[XB_TOPGEN]) == tg, bar);
            __builtin_amdgcn_fence(__ATOMIC_ACQUIRE, "agent");
            xb_add(&bar[XB_XGEN(b.x)], 1u);
            asm volatile("s_waitcnt vmcnt(0)" ::: "memory");
        } else {
            XB_SPIN(xb_ld(&bar[XB_XGEN(b.x)]) == gen, bar);
            __builtin_amdgcn_fence(__ATOMIC_ACQUIRE, "agent");
            asm volatile("s_waitcnt vmcnt(0)" ::: "memory");
        }
    }
    __syncthreads();
}
struct Ptrs {
    const float *x, *meta, *gamma_lb, *a_norm, *a_w_in, *a_out_norm, *a_w_out, *kv_norm, *kv_w, *fox_b_f, *fox_k_norm, *b_norm, *b_w_in, *b_q_norm, *b_w_out;
    float* out; float* sm;
    bf16_t *WT_AIN, *WT_AOUT, *WT_KVB, *WT_BOUT, *WT_F, *XN0, *QS, *VV, *GZ, *OG;
};

struct P0Item { const float* W; const float* g; bf16_t* WT; int ldw, row_off, k0, n0; };
constexpr int P0_I_AIN = 32 * 128, P0_I_AOUT = 32 * 32, P0_I_KV = 32 * 64, P0_I_BIN = 32 * 64, P0_I_BOUT = 32 * 32;
constexpr int P0_NITEMS = P0_I_AIN + P0_I_AOUT + P0_I_KV + P0_I_BIN + P0_I_BOUT;
__device__ __forceinline__ P0Item p0_decode(const Ptrs& P, int it) {
    P0Item I; int r = it, nblk;
    if (r < P0_I_AIN) { I.W = P.a_w_in; I.ldw = 8192; I.g = P.a_norm; I.WT = P.WT_AIN; I.row_off = 0; nblk = 128; }
    else if ((r -= P0_I_AIN) < P0_I_AOUT) { I.W = P.a_w_out; I.ldw = 2048; I.g = P.a_out_norm; I.WT = P.WT_AOUT; I.row_off = 0; nblk = 32; }
    else if ((r -= P0_I_AOUT) < P0_I_KV) { I.W = P.kv_w; I.ldw = 4112; I.g = P.kv_norm; I.WT = P.WT_KVB; I.row_off = 0; nblk = 64; }
    else if ((r -= P0_I_KV) < P0_I_BIN) { I.W = P.b_w_in; I.ldw = 4096; I.g = P.b_norm; I.WT = P.WT_KVB; I.row_off = 4096; nblk = 64; }
    else { r -= P0_I_BIN; I.W = P.b_w_out; I.ldw = 2048; I.g = nullptr; I.WT = P.WT_BOUT; I.row_off = 0; nblk = 32; }
    I.k0 = 64 * (r / nblk); I.n0 = 64 * (r % nblk);
    return I;
}
__device__ __forceinline__ void p0_item_load(const P0Item& I, int lane, f32x4 (&v)[16], float (&gg)[16]) {
    const int c4 = lane & 15, rr = lane >> 4;
#pragma unroll
    for (int i = 0; i < 16; ++i) { const int k = I.k0 + 4 * i + rr; v[i] = *(const f32x4*)(I.W + (size_t)k * I.ldw + I.n0 + 4 * c4); gg[i] = I.g ? I.g[k] : 1.0f; }
}
__device__ __forceinline__ void p0_item_store(const P0Item& I, LAS float* scr, int lane, const f32x4 (&v)[16], const float (&gg)[16]) {
    const int c4 = lane & 15, rr = lane >> 4;
#pragma unroll
    for (int i = 0; i < 16; ++i) { LAS float* p = scr + (4 * i + rr) * 65 + 4 * c4; p[0] = v[i][0] * gg[i]; p[1] = v[i][1] * gg[i]; p[2] = v[i][2] * gg[i]; p[3] = v[i][3] * gg[i]; }
    asm volatile("s_waitcnt lgkmcnt(0)" ::: "memory");
    const int c = lane & 7, nn = lane >> 3;
#pragma unroll
    for (int j = 0; j < 8; ++j) { const int n = nn + 8 * j; const LAS float* q = scr + (8 * c) * 65 + n;
        u32x4 o; o.x = pkbf(q[0 * 65], q[1 * 65]); o.y = pkbf(q[2 * 65], q[3 * 65]); o.z = pkbf(q[4 * 65], q[5 * 65]); o.w = pkbf(q[6 * 65], q[7 * 65]);
        *(u32x4*)(I.WT + (size_t)(I.row_off + I.n0 + n) * DM + I.k0 + 8 * c) = o; }
    asm volatile("s_waitcnt lgkmcnt(0)" ::: "memory");
}
__device__ __forceinline__ void rms_row_to_bf16(const float* xrow, bf16_t* orow, int lane) {
    const f32x4* xr = (const f32x4*)xrow + lane;
    f32x4 v[8]; float s = 0.f;
#pragma unroll
    for (int j = 0; j < 8; ++j) { v[j] = xr[64 * j]; s += (v[j].x * v[j].x + v[j].y * v[j].y) + (v[j].z * v[j].z + v[j].w * v[j].w); }
    const float rstd = __builtin_amdgcn_rsqf(wave_sum(s) * (1.f / DM) + EPS);
    u32x2* o8 = (u32x2*)orow + lane;
#pragma unroll
    for (int j = 0; j < 8; ++j) { u32x2 w; w.x = pkbf(v[j].x * rstd, v[j].y * rstd); w.y = pkbf(v[j].z * rstd, v[j].w * rstd); o8[64 * j] = w; }
}
__device__ __forceinline__ void p0_prologue(const Ptrs& P, LAS unsigned char* lds, int gw, int NGW, int wave, int lane) {
    LAS float* scr = (LAS float*)(lds + wave * 16640);
    {
        int it = gw; f32x4 va[16]; float ga[16];
        if (it < P0_NITEMS) p0_item_load(p0_decode(P, it), lane, va, ga);
        while (it < P0_NITEMS) {
            const int nx = it + NGW; f32x4 vb[16]; float gb[16];
            if (nx < P0_NITEMS) p0_item_load(p0_decode(P, nx), lane, vb, gb);
            p0_item_store(p0_decode(P, it), scr, lane, va, ga);
#pragma unroll
            for (int i = 0; i < 16; ++i) { va[i] = vb[i]; ga[i] = gb[i]; }
            it = nx;
        }
    }
    for (int idx = gw * 64 + lane; idx < 16 * DM; idx += NGW * 64) { const int k = idx >> 4, n = idx & 15;
        P.WT_F[(size_t)n * DM + k] = (bf16_t)(pkbf(P.kv_w[(size_t)k * 4112 + 4096 + n] * P.kv_norm[k], 0.f) & 0xffffu); }
    for (int m = gw; m < MT; m += NGW) rms_row_to_bf16(m < MR ? P.x + (size_t)m * DM : P.meta + (size_t)(m - MR) * DM, P.XN0 + (size_t)m * DM, lane);
    for (int idx = gw * 64 + lane; idx < DM; idx += NGW * 64) P.sm[SM_LBV + idx] = fsigmoid(P.gamma_lb[idx] - P.gamma_lb[DM + idx]);
    for (int idx = gw * 64 + lane; idx < MT; idx += NGW * 64) P.sm[SM_ROWSS + idx] = 0.f;
}

__device__ __forceinline__ f32x4 skinny_tile(const bf16_t* A, const bf16_t* Bt, int lane) {
    const int r = lane & 15, g = lane >> 4;
    const bf16x8* pa = (const bf16x8*)(A + (size_t)r * DM + 8 * g);
    const bf16x8* pb = (const bf16x8*)(Bt + (size_t)r * DM + 8 * g);
    f32x4 acc = {0.f, 0.f, 0.f, 0.f};
#pragma unroll 16
    for (int k = 0; k < DM / 32; ++k) acc = __builtin_amdgcn_mfma_f32_16x16x32_bf16(pa[4 * k], pb[4 * k], acc, 0, 0, 0);
    return acc;
}
__device__ __forceinline__ f32x4 skinny_tile4(const bf16_t* A, const bf16_t* Bt, int lane, int wave, LAS f32x4* xs) {
    const int r = lane & 15, g = lane >> 4, part = wave & 3;
    const bf16x8* pa = (const bf16x8*)(A + (size_t)r * DM + 8 * g + part * (DM / 4));
    const bf16x8* pb = (const bf16x8*)(Bt + (size_t)r * DM + 8 * g + part * (DM / 4));
    f32x4 acc = {0.f, 0.f, 0.f, 0.f};
#pragma unroll
    for (int k = 0; k < DM / 128; ++k) acc = __builtin_amdgcn_mfma_f32_16x16x32_bf16(pa[4 * k], pb[4 * k], acc, 0, 0, 0);
    xs[wave * 64 + lane] = acc;
    __syncthreads();
    const int w0 = wave & ~3;
    const f32x4 t = (xs[w0 * 64 + lane] + xs[(w0 + 1) * 64 + lane]) + (xs[(w0 + 2) * 64 + lane] + xs[(w0 + 3) * 64 + lane]);
    __syncthreads();
    return t;
}
constexpr int HG_LD128 = 136, HG_LD64 = 72, HG_LDO = 132;
constexpr int HG_QI = 0, HG_KI = HG_QI + 64 * HG_LD128 * 2, HG_QD = HG_KI + 64 * HG_LD128 * 2, HG_KDT = HG_QD + 64 * HG_LD128 * 2,
              HG_VT = HG_KDT + 128 * HG_LD64 * 2, HG_AL = HG_VT + 128 * HG_LD64 * 2, HG_ST = HG_AL + 64 * HG_LD64 * 2, HG_RT = HG_ST + 128 * HG_LD128 * 2,
              HG_DEC = HG_RT + 4 * 128 * 4, HG_END = HG_DEC + 128 * 4;
static_assert(HG_END <= 140000 && 64 * HG_LDO * 4 <= HG_QD, "hgrn LDS map (O tile overlays QI + KI)");

template <int MODE>
__device__ __forceinline__ void hgrn_item(LAS unsigned char* lds, const bf16_t* QS, const unsigned short* LOGF, const unsigned short* LOGFM, const bf16_t* VV, const bf16_t* GZ, bf16_t* OG,
                                          float* SEGS, float* DSEG, int b, int h, int seg) {
    const int tid = threadIdx.x, wid = __builtin_amdgcn_readfirstlane(tid >> 6), lane = tid & 63, r = lane & 15, g = lane >> 4;
    const int d = tid & 127, rq = tid >> 7, t0 = 16 * rq;
    LAS bf16_t* QI = (LAS bf16_t*)(lds + HG_QI); LAS bf16_t* KI = (LAS bf16_t*)(lds + HG_KI); LAS bf16_t* QD = (LAS bf16_t*)(lds + HG_QD);
    LAS bf16_t* KDT = (LAS bf16_t*)(lds + HG_KDT); LAS bf16_t* VT = (LAS bf16_t*)(lds + HG_VT); LAS bf16_t* AL = (LAS bf16_t*)(lds + HG_AL);
    LAS bf16_t* ST = (LAS bf16_t*)(lds + HG_ST); LAS float* RT = (LAS float*)(lds + HG_RT); LAS float* DEC = (LAS float*)(lds + HG_DEC);
    LAS float* OL = (LAS float*)(lds + HG_QI);
    const int item = (b * NH + h) * 8 + seg;
    const int c_begin = seg == 0 ? 0 : 8 * seg + 1, c_end = 8 * seg + 9;
    f32x4 Sacc[8];
#pragma unroll
    for (int dt = 0; dt < 8; ++dt) Sacc[dt] = (f32x4){0.f, 0.f, 0.f, 0.f};
    float dsum = 0.f;
    if (MODE == 1) {
#ifdef HG_NOFOLD
        for (int j = 0; j < 0; ++j) {
#else
        for (int j = 0; j < seg; ++j) {
#endif
            const int itj = (b * NH + h) * 8 + j;
            const float* sj = SEGS + (size_t)itj * 16384; const float* dj = DSEG + itj * 128;
#pragma unroll
            for (int dt = 0; dt < 8; ++dt) {
                const f32x4 l4 = *(const f32x4*)(dj + 16 * dt + 4 * g);
#pragma unroll
                for (int q = 0; q < 4; ++q) Sacc[dt][q] = fexp(l4[q]) * Sacc[dt][q] + sj[(16 * dt + 4 * g + q) * 128 + 16 * wid + r];
            }
        }
#pragma unroll
        for (int dt = 0; dt < 8; ++dt) { u32x2 w; w.x = pkbf(Sacc[dt][0], Sacc[dt][1]); w.y = pkbf(Sacc[dt][2], Sacc[dt][3]);
            *(LAS u32x2*)(ST + (16 * wid + r) * HG_LD128 + 16 * dt + 4 * g) = w; }
    }
    float lf[16]; unsigned q16[16], v16[16];
#define HG_LOAD(cc) do { const int c_ = (cc); const bool vld_ = c_ > 0 || rq == 3; const int rb_ = b * SEQ + (c_ - 1) * 64;                                   \
        const unsigned short* lp = c_ == 0 ? LOGFM + h * HD + d : LOGF + (size_t)(rb_ + t0) * DM + h * HD + d;                                                       \
        const size_t o16 = c_ == 0 ? (size_t)MR * DM + h * HD + d : (size_t)(rb_ + t0) * DM + h * HD + d;                                                   \
        _Pragma("unroll") for (int i = 0; i < 16; ++i) { const float x = h2f(lp[(size_t)i * DM]); const unsigned vv = VV[o16 + (size_t)i * DM];                   \
            lf[i] = vld_ ? x : 0.f; v16[i] = vld_ ? vv : 0u;                                                                                                \
            if (MODE == 1) { const unsigned qq = QS[o16 + (size_t)i * DM]; q16[i] = vld_ ? qq : 0u; } } } while (0)
    for (int c = c_begin; c < c_end; ++c) {
        HG_LOAD(c);
        const int rowbase = c == 0 ? (MR - 48) : b * SEQ + (c - 1) * 64;
        float cs[16];
        float run = 0.f;
#pragma unroll
        for (int i = 0; i < 16; ++i) { run += lf[i]; cs[i] = run; }
        RT[rq * 128 + d] = run;
        __syncthreads();
        const float r0 = RT[d], r1 = RT[128 + d], r2 = RT[256 + d], r3 = RT[384 + d];
        const float off = (rq > 0 ? r0 : 0.f) + (rq > 1 ? r1 : 0.f) + (rq > 2 ? r2 : 0.f);
        const float bmid = r0 + r1, blast = (r0 + r1) + (r2 + r3);
        if (rq == 0) { DEC[d] = fexp(blast); dsum += blast; }
        const float emid = fexp(bmid), elast = fexp(blast - bmid);
        {
            float kdv[16];
#pragma unroll
            for (int i = 0; i < 16; ++i) {
                const float bb = off + cs[i];
                const float kk = 1.0f - fexp(lf[i]);
                const float e1 = fexp(bb - bmid), e2 = fexp(bmid - bb);
                const float ki = kk * e2;
                kdv[i] = ki * elast;
                if (MODE == 1) {
                    const float qi = __uint_as_float(q16[i] << 16) * e1;
                    QI[(t0 + i) * HG_LD128 + d] = (bf16_t)(pkbf(qi, 0.f) & 0xffffu);
                    KI[(t0 + i) * HG_LD128 + d] = (bf16_t)(pkbf(ki, 0.f) & 0xffffu);
                    QD[(t0 + i) * HG_LD128 + d] = (bf16_t)(pkbf(qi * emid, 0.f) & 0xffffu);
                }
            }
            u32x4 w0, w1, x0, x1;
            w0.x = pkbf(kdv[0], kdv[1]); w0.y = pkbf(kdv[2], kdv[3]); w0.z = pkbf(kdv[4], kdv[5]); w0.w = pkbf(kdv[6], kdv[7]);
            w1.x = pkbf(kdv[8], kdv[9]); w1.y = pkbf(kdv[10], kdv[11]); w1.z = pkbf(kdv[12], kdv[13]); w1.w = pkbf(kdv[14], kdv[15]);
            x0.x = v16[0] | (v16[1] << 16); x0.y = v16[2] | (v16[3] << 16); x0.z = v16[4] | (v16[5] << 16); x0.w = v16[6] | (v16[7] << 16);
            x1.x = v16[8] | (v16[9] << 16); x1.y = v16[10] | (v16[11] << 16); x1.z = v16[12] | (v16[13] << 16); x1.w = v16[14] | (v16[15] << 16);
            *(LAS u32x4*)(KDT + d * HG_LD64 + t0) = w0; *(LAS u32x4*)(KDT + d * HG_LD64 + t0 + 8) = w1;
            *(LAS u32x4*)(VT + d * HG_LD64 + t0) = x0; *(LAS u32x4*)(VT + d * HG_LD64 + t0 + 8) = x1;
        }
        __syncthreads();
        const int tF = tid >> 3, e0F = 16 * (tid & 7);
        const bool wr_ok = c > 0 ? true : (tF >= 48 && b == 0);
        const size_t off2 = (size_t)(wr_ok ? rowbase + tF : MR) * DM + h * HD + e0F;
        u32x4 z0 = {0u, 0u, 0u, 0u}, z1 = z0;
        if (MODE == 1) { z0 = *(const u32x4*)(GZ + off2); z1 = *(const u32x4*)(GZ + off2 + 8); }
        if (MODE == 1) {
            const int ti = wid & 3, si0 = 2 * (wid >> 2);
#pragma unroll
            for (int sj = 0; sj < 2; ++sj) {
                const int si = si0 + sj;
                f32x4 a4 = {0.f, 0.f, 0.f, 0.f};
                if (si <= ti) {
#pragma unroll
                    for (int k4 = 0; k4 < 4; ++k4) {
                        const bf16x8 fa = *(const LAS bf16x8*)(KI + (16 * si + r) * HG_LD128 + 32 * k4 + 8 * g);
                        const bf16x8 fb = *(const LAS bf16x8*)(QI + (16 * ti + r) * HG_LD128 + 32 * k4 + 8 * g);
                        a4 = __builtin_amdgcn_mfma_f32_16x16x32_bf16(fa, fb, a4, 0, 0, 0);
                    }
                    if (si == ti) {
#pragma unroll
                        for (int q = 0; q < 4; ++q) if (4 * g + q > r) a4[q] = 0.f;
                    }
                }
                u32x2 w; w.x = pkbf(a4[0], a4[1]); w.y = pkbf(a4[2], a4[3]);
                *(LAS u32x2*)(AL + (16 * ti + r) * HG_LD64 + 16 * si + 4 * g) = w;
            }
            __syncthreads();
        }
        bf16x8 bv[2];
        bv[0] = *(const LAS bf16x8*)(VT + (16 * wid + r) * HG_LD64 + 8 * g);
        bv[1] = *(const LAS bf16x8*)(VT + (16 * wid + r) * HG_LD64 + 32 + 8 * g);
        if (MODE == 1) {
            bf16x8 sf[4];
#pragma unroll
            for (int k4 = 0; k4 < 4; ++k4) sf[k4] = *(const LAS bf16x8*)(ST + (16 * wid + r) * HG_LD128 + 32 * k4 + 8 * g);
#pragma unroll
            for (int ti = 0; ti < 4; ++ti) {
                f32x4 o4 = {0.f, 0.f, 0.f, 0.f};
#pragma unroll
                for (int k4 = 0; k4 < 4; ++k4) {
                    const bf16x8 fa = *(const LAS bf16x8*)(QD + (16 * ti + r) * HG_LD128 + 32 * k4 + 8 * g);
                    o4 = __builtin_amdgcn_mfma_f32_16x16x32_bf16(fa, sf[k4], o4, 0, 0, 0);
                }
#pragma unroll
                for (int ks = 0; ks < 2; ++ks) {
                    if (ks == 1 && ti < 2) continue;
                    const bf16x8 fa = *(const LAS bf16x8*)(AL + (16 * ti + r) * HG_LD64 + 32 * ks + 8 * g);
                    o4 = __builtin_amdgcn_mfma_f32_16x16x32_bf16(fa, bv[ks], o4, 0, 0, 0);
                }
#pragma unroll
                for (int q = 0; q < 4; ++q) OL[(16 * ti + 4 * g + q) * HG_LDO + 16 * wid + r] = o4[q];
            }
        }
#pragma unroll
        for (int dt = 0; dt < 8; ++dt) {
            const f32x4 dc = *(const LAS f32x4*)(DEC + 16 * dt + 4 * g);
            Sacc[dt] = Sacc[dt] * dc;
#pragma unroll
            for (int ks = 0; ks < 2; ++ks) {
                const bf16x8 fa = *(const LAS bf16x8*)(KDT + (16 * dt + r) * HG_LD64 + 32 * ks + 8 * g);
                Sacc[dt] = __builtin_amdgcn_mfma_f32_16x16x32_bf16(fa, bv[ks], Sacc[dt], 0, 0, 0);
            }
        }
        if (MODE == 1) {
#pragma unroll
            for (int dt = 0; dt < 8; ++dt) { u32x2 w; w.x = pkbf(Sacc[dt][0], Sacc[dt][1]); w.y = pkbf(Sacc[dt][2], Sacc[dt][3]);
                *(LAS u32x2*)(ST + (16 * wid + r) * HG_LD128 + 16 * dt + 4 * g) = w; }
            __syncthreads();
            const int t = tF, e0 = e0F;
            f32x4 o[4]; float ss = 0.f;
#pragma unroll
            for (int q = 0; q < 4; ++q) { o[q] = *(const LAS f32x4*)(OL + t * HG_LDO + e0 + 4 * q); ss += (o[q][0] * o[q][0] + o[q][1] * o[q][1]) + (o[q][2] * o[q][2] + o[q][3] * o[q][3]); }
            ss += __shfl_xor(ss, 1); ss += __shfl_xor(ss, 2); ss += __shfl_xor(ss, 4);
            const float rstd = __builtin_amdgcn_rsqf(ss * (1.0f / HD) + EPS);
            if (wr_ok) {
                u32x4 w0, w1;
#define HG_G(zw, a, b_) pkbf((a) * rstd * __uint_as_float((zw) << 16), (b_) * rstd * __uint_as_float((zw) & 0xffff0000u))
                w0.x = HG_G(z0.x, o[0][0], o[0][1]); w0.y = HG_G(z0.y, o[0][2], o[0][3]); w0.z = HG_G(z0.z, o[1][0], o[1][1]); w0.w = HG_G(z0.w, o[1][2], o[1][3]);
                w1.x = HG_G(z1.x, o[2][0], o[2][1]); w1.y = HG_G(z1.y, o[2][2], o[2][3]); w1.z = HG_G(z1.z, o[3][0], o[3][1]); w1.w = HG_G(z1.w, o[3][2], o[3][3]);
#undef HG_G
                *(u32x4*)(OG + off2) = w0; *(u32x4*)(OG + off2 + 8) = w1;
            }
        }
        __syncthreads();
    }
#undef HG_LOAD
    if (MODE == 0) {
        float* sj = SEGS + (size_t)item * 16384;
#pragma unroll
        for (int dt = 0; dt < 8; ++dt)
#pragma unroll
            for (int q = 0; q < 4; ++q) sj[(16 * dt + 4 * g + q) * 128 + 16 * wid + r] = Sacc[dt][q];
        if (rq == 0) DSEG[item * 128 + d] = dsum;
    }
}
__device__ __forceinline__ void p1_meta(const Ptrs& P, LAS unsigned char* lds, int gw, int NGW, int wave, int lane) {
    const int r = lane & 15, g = lane >> 4; LAS f32x4* xs = (LAS f32x4*)lds;
    for (int base = 0; base < 512; base += NGW / 4) {
        const int tl = base + (gw >> 2); const bool ok = tl < 512 && (wave & 3) == 0;
        const f32x4 acc = skinny_tile4(P.XN0 + (size_t)MR * DM, P.WT_AIN + (size_t)(tl < 512 ? tl : 0) * 16 * DM, lane, wave, xs);
        if (!ok) continue;
        const int col = tl * 16 + r, type = col >> 11, c = col & 2047;
#pragma unroll
        for (int q = 0; q < 4; ++q) {
            const int mr = 4 * g + q; const float v = acc[q];
            if (type == 0) P.QS[(size_t)(MR + mr) * DM + c] = (bf16_t)(pkbf(fsilu(v), 0.f) & 0xffffu);
            else if (type == 1) { const float lb = P.sm[SM_LBV + c]; ((unsigned short*)(P.sm + SM_LOGFM))[mr * DM + c] = (unsigned short)(pkh(flog(lb + (1.0f - lb) * fsigmoid(v)), 0.f) & 0xffffu); }
            else if (type == 2) P.VV[(size_t)(MR + mr) * DM + c] = (bf16_t)(pkbf(v, 0.f) & 0xffffu);
            else P.GZ[(size_t)(MR + mr) * DM + c] = (bf16_t)(pkbf(fsilu(v), 0.f) & 0xffffu);
        }
    }
}
__device__ __forceinline__ void p4_meta(const Ptrs& P, bf16_t* H1BF, LAS unsigned char* lds, int gw, int NGW, int wave, int lane) {
    const int r = lane & 15, g = lane >> 4; LAS f32x4* xs = (LAS f32x4*)lds;
    for (int base = 0; base < 128; base += NGW / 4) {
        const int tl = base + (gw >> 2); const bool ok = tl < 128 && (wave & 3) == 0;
        const f32x4 acc = skinny_tile4(P.OG + (size_t)MR * DM, P.WT_AOUT + (size_t)(tl < 128 ? tl : 0) * 16 * DM, lane, wave, xs);
        if (!ok) continue;
        const int col = tl * 16 + r;
#pragma unroll
        for (int q = 0; q < 4; ++q) {
            const int mr = 4 * g + q; const float hv = P.meta[mr * DM + col] + acc[q];
            H1BF[(size_t)(MR + mr) * DM + col] = (bf16_t)(pkbf(hv, 0.f) & 0xffffu);
            float ss = hv * hv; ss += __shfl_xor(ss, 1); ss += __shfl_xor(ss, 2); ss += __shfl_xor(ss, 4); ss += __shfl_xor(ss, 8);
            if (r == 0) atomicAdd(P.sm + SM_ROWSS + MR + mr, ss);
        }
    }
}
__device__ __forceinline__ void p5_side(const Ptrs& P, const bf16_t* H1BF, bf16_t* KB, bf16_t* VB, LAS unsigned char* lds, int gw, int NGW, int wave, int lane) {
    const int r = lane & 15, g = lane >> 4; LAS f32x4* xs = (LAS f32x4*)lds;
    for (int base = 0; base < 256 + 513; base += NGW / 4) {
        const int tl = base + (gw >> 2); const bool inr = tl < 256 + 513, ok = inr && (wave & 3) == 0;
        const bool meta = !inr || tl < 256; const int rt = meta ? 0 : tl - 256;
        const bf16_t* A = meta ? H1BF + (size_t)MR * DM : H1BF + (size_t)rt * 16 * DM;
        const bf16_t* Bt = meta ? P.WT_KVB + (size_t)(inr ? tl : 0) * 16 * DM : P.WT_F;
        const f32x4 acc = skinny_tile4(A, Bt, lane, wave, xs);
        if (!ok) continue;
        if (tl < 256) {
            const int col = tl * 16 + r, isv = col >> 11, c = col & 2047, head = c >> 7, dd = c & 127;
#pragma unroll
            for (int q = 0; q < 4; ++q) {
                const int mr = 4 * g + q;
                const float rs = __builtin_amdgcn_rsqf(P.sm[SM_ROWSS + MR + mr] * (1.0f / DM) + EPS);
                const bf16_t v = (bf16_t)(pkbf(acc[q] * rs, 0.f) & 0xffffu);
                bf16_t* bs = isv ? VB : KB;
                bs[((size_t)(0 * NH + head) * SKV + 48 + mr) * HD + dd] = v;
                bs[((size_t)(1 * NH + head) * SKV + 48 + mr) * HD + dd] = v;
            }
        } else {
            const float bf = P.fox_b_f[r];
#pragma unroll
            for (int q = 0; q < 4; ++q) {
                const int row = rt * 16 + 4 * g + q;
                const float rs = __builtin_amdgcn_rsqf(P.sm[SM_ROWSS + row] * (1.0f / DM) + EPS);
                const float xl = acc[q] * rs + bf;
                P.sm[SM_LOGF2 + row * 16 + r] = fminf(xl, 0.f) - flog(1.0f + fexp(-fabsf(xl)));
            }
        }
    }
    for (int idx = gw * 64 + lane; idx < 32 * 48 * 16; idx += NGW * 64) {
        const int bh = idx / (48 * 16), rem = idx % (48 * 16);
        const u32x4 z = {0u, 0u, 0u, 0u};
        *(u32x4*)(KB + (size_t)bh * SKV * HD + rem * 8) = z; *(u32x4*)(VB + (size_t)bh * SKV * HD + rem * 8) = z;
    }
}
__device__ __forceinline__ void p6_norm_scan(const Ptrs& P, bf16_t* KB, bf16_t* QB2, int gw, int NGW, int lane) {
    const int sub = lane >> 4, l16 = lane & 15;
    constexpr int NKR = 32 * SKV, NQR = 32 * SEQ;
    (void)NKR; (void)NQR; (void)QB2;
    for (int r4 = gw; r4 < 32 * 16 / 4; r4 += NGW) {
        const int rr = r4 * 4 + sub, bh = rr >> 4, mr = rr & 15;
        bf16_t* p = KB + ((size_t)bh * SKV + 48 + mr) * HD; const float* gn = P.fox_k_norm + (bh & 15) * HD;
        const u32x4 w = *(const u32x4*)(p + 8 * l16);
        float v[8];
        v[0] = __uint_as_float(w.x << 16); v[1] = __uint_as_float(w.x & 0xffff0000u); v[2] = __uint_as_float(w.y << 16); v[3] = __uint_as_float(w.y & 0xffff0000u);
        v[4] = __uint_as_float(w.z << 16); v[5] = __uint_as_float(w.z & 0xffff0000u); v[6] = __uint_as_float(w.w << 16); v[7] = __uint_as_float(w.w & 0xffff0000u);
        float ss = 0.f;
#pragma unroll
        for (int j = 0; j < 8; ++j) ss += v[j] * v[j];
        ss += __shfl_xor(ss, 1); ss += __shfl_xor(ss, 2); ss += __shfl_xor(ss, 4); ss += __shfl_xor(ss, 8);
        const float rs = __builtin_amdgcn_rsqf(ss * (1.0f / HD) + EPS);
        const f32x4 g0 = *(const f32x4*)(gn + 8 * l16), g1 = *(const f32x4*)(gn + 8 * l16 + 4);
        u32x4 o; o.x = pkbf(v[0] * rs * g0[0], v[1] * rs * g0[1]); o.y = pkbf(v[2] * rs * g0[2], v[3] * rs * g0[3]);
        o.z = pkbf(v[4] * rs * g1[0], v[5] * rs * g1[1]); o.w = pkbf(v[6] * rs * g1[2], v[7] * rs * g1[3]);
        *(u32x4*)(p + 8 * l16) = o;
    }
    if ((gw & 7) == 0) for (int sidx = gw >> 3; sidx < 32; sidx += NGW >> 3) {
        const int b = sidx >> 4, h = sidx & 15; float* bias = P.sm + SM_BIAS + sidx * SKV;
        if (lane < 48) bias[lane] = -1e30f;
        constexpr int NPOS = NMETA + SEQ, PER = 65;
        float v[PER];
#pragma unroll
        for (int k = 0; k < PER; ++k) {
            const int pos = lane * PER + k, pc = pos < NPOS ? pos : NPOS - 1;
            const int row = pc < NMETA ? MR + pc : b * SEQ + pc - NMETA;
            const float x = P.sm[SM_LOGF2 + row * 16 + h];
            v[k] = pos < NPOS ? x : 0.f;
        }
        float run = 0.f;
#pragma unroll
        for (int k = 0; k < PER; ++k) { run += v[k]; v[k] = run; }
        float tot = run;
#pragma unroll
        for (int o = 1; o < 64; o <<= 1) { const float n = __shfl_up(tot, o); if (lane >= o) tot += n; }
        const float base = tot - run;
#pragma unroll
        for (int k = 0; k < PER; ++k) { const int pos = lane * PER + k; if (pos < NPOS) bias[48 + pos] = -(base + v[k]) * 11.313708498984761f; }
    }
}
namespace attn {
constexpr float SCALE = 0.08838834764831845f;
constexpr float THR = 14.f;
constexpr int NW = 8, QBLK = 32, KVBLK = 64, QB = NW * QBLK, D = 128, OST = 2048;
constexpr int SHM_V = KVBLK * D * 2, SHM_K = KVBLK * D * 2;
constexpr int OFF_WS = 2 * SHM_V + 2 * SHM_K, OFF_BIAS = OFF_WS + NW * 64 * 4, LDS_BYTES = OFF_BIAS + SKV * 4;
constexpr unsigned WBIG = 1u << 30;

#define KSWZ(row, colB) ((row) * 256 + ((colB) ^ (((row) & 7) << 4)))
#define SBAR() __builtin_amdgcn_sched_barrier(0)
__device__ __forceinline__ int v_st(int k, int c) { const int kk = (k & ~0xC) | ((k & 4) << 1) | ((k & 8) >> 1); return ((kk >> 3) * 4 + (c >> 5)) * 512 + ((kk & 7) * 32 + (c & 31)) * 2; }
__device__ __forceinline__ int v_rd_base(int lane) { return ((lane & 3) << 3) | (((lane >> 2) & 3) << 6) | (((lane >> 4) & 1) << 5) | (((lane >> 5) & 1) << 8); }
constexpr int v_rd_off(int d0, int ks, int half) { return d0 * 512 + ks * 4096 + half * 2048; }
__device__ __forceinline__ int crow(int r, int hi) { return (r & 3) + 8 * (r >> 2) + 4 * hi; }
__device__ __forceinline__ void mask_tile(f32x16& p0, f32x16& p1, int dq, unsigned W) {
    const float NEG = -__builtin_inff();
#pragma unroll
    for (int r = 0; r < 16; ++r) {
        const int c = (r & 3) + 8 * (r >> 2);
        if ((unsigned)(dq - c) >= W) p0[r] = NEG;
        if ((unsigned)(dq - c - 32) >= W) p1[r] = NEG;
    }
}
__device__ __forceinline__ void partialSM(f32x16& p0, f32x16& p1, float& m_reg, float& mn, float& alpha) {
    float pmax = p0[0]; for (int r = 1; r < 16; ++r) pmax = fmaxf(pmax, p0[r]); for (int r = 0; r < 16; ++r) pmax = fmaxf(pmax, p1[r]);
    { auto rr = __builtin_amdgcn_permlane32_swap(__float_as_uint(pmax), __float_as_uint(pmax), false, false);
      pmax = fmaxf(__uint_as_float(rr[0]), __uint_as_float(rr[1])); }
    constexpr float C2 = 1.4426950408889634f * SCALE;
    if (__builtin_expect(__all((pmax - m_reg) * SCALE <= THR), 1)) { mn = m_reg; alpha = 1.f; }
    else { mn = fmaxf(m_reg, pmax); alpha = __builtin_amdgcn_exp2f((m_reg - mn) * C2); m_reg = mn; }
    const float mnL = -mn * C2;
    for (int r = 0; r < 16; ++r) p0[r] = fmaf(p0[r], C2, mnL); for (int r = 0; r < 16; ++r) p1[r] = fmaf(p1[r], C2, mnL);
    for (int r = 0; r < 16; ++r) p0[r] = __builtin_amdgcn_exp2f(p0[r]);
}
__device__ __forceinline__ void finishSM(f32x16& p0, f32x16& p1, float alpha, float& l_reg, bf16x8& pa0, bf16x8& pa1, bf16x8& pa2, bf16x8& pa3) {
    for (int r = 0; r < 16; ++r) p1[r] = __builtin_amdgcn_exp2f(p1[r]);
    float ps = 0; for (int r = 0; r < 16; ++r) ps += p0[r]; for (int r = 0; r < 16; ++r) ps += p1[r];
    { auto rr = __builtin_amdgcn_permlane32_swap(__float_as_uint(ps), __float_as_uint(ps), false, false);
      ps = __uint_as_float(rr[0]) + __uint_as_float(rr[1]); }
    l_reg = l_reg * alpha + ps;
#define PK4(P, B_, OUT) do { unsigned a0 = pkbf(P[B_+0], P[B_+1]), a1 = pkbf(P[B_+2], P[B_+3]);                          \
        unsigned b0 = pkbf(P[B_+4], P[B_+5]), b1 = pkbf(P[B_+6], P[B_+7]);                                             \
        auto r0 = __builtin_amdgcn_permlane32_swap(a0, b0, false, false); auto r1 = __builtin_amdgcn_permlane32_swap(a1, b1, false, false); \
        u32x4 w = {r0[0], r1[0], r0[1], r1[1]}; OUT = *reinterpret_cast<bf16x8*>(&w); } while (0)
    PK4(p0, 0, pa0); PK4(p0, 8, pa1); PK4(p1, 0, pa2); PK4(p1, 8, pa3);
#undef PK4
}
template <int KB>
__device__ __forceinline__ void qkt(f32x16& p0, f32x16& p1, const char* K_lds, const float* bl, int r32, int hi, const bf16x8* qr) {
    {
        const f32x4 a0 = *(const f32x4*)(bl), a1 = *(const f32x4*)(bl + 8), a2 = *(const f32x4*)(bl + 16), a3 = *(const f32x4*)(bl + 24);
        const f32x4 c0 = *(const f32x4*)(bl + 32), c1 = *(const f32x4*)(bl + 40), c2 = *(const f32x4*)(bl + 48), c3 = *(const f32x4*)(bl + 56);
        p0 = (f32x16){a0[0], a0[1], a0[2], a0[3], a1[0], a1[1], a1[2], a1[3], a2[0], a2[1], a2[2], a2[3], a3[0], a3[1], a3[2], a3[3]};
        p1 = (f32x16){c0[0], c0[1], c0[2], c0[3], c1[0], c1[1], c1[2], c1[3], c2[0], c2[1], c2[2], c2[3], c3[0], c3[1], c3[2], c3[3]};
    }
    const char* kb[4];
#pragma unroll
    for (int dd = 0; dd < 4; ++dd) kb[dd] = K_lds + KB * SHM_K + KSWZ(r32, (dd * 16 + hi * 8) * 2);
#pragma unroll
    for (int d0 = 0; d0 < 8; ++d0) { const char* a = kb[d0 & 3] + (d0 >> 2) * 128;
        bf16x8 b0 = *reinterpret_cast<const bf16x8*>(a);
        bf16x8 b1 = *reinterpret_cast<const bf16x8*>(a + 32 * 256);
        p0 = __builtin_amdgcn_mfma_f32_32x32x16_bf16(b0, qr[d0], p0, 0, 0, 0);
        p1 = __builtin_amdgcn_mfma_f32_32x32x16_bf16(b1, qr[d0], p1, 0, 0, 0); }
}
template <int VB>
__device__ __forceinline__ void pv_tile(f32x16* o, int vb0, bf16x8 pa0, bf16x8 pa1, bf16x8 pa2, bf16x8 pa3) {
#define TRRD(dst, off) asm volatile("ds_read_b64_tr_b16 %0, %1 offset:%2" : "=&v"(dst) : "v"(vb0), "i"(off) : "memory")
#define PV_D0(d0) do { s16x4 l0, l1, l2, l3, h0, h1, h2, h3; constexpr int b_ = VB * SHM_V + v_rd_off(d0, 0, 0); \
        TRRD(l0, b_); TRRD(h0, b_ + 2048); TRRD(l1, b_ + 4096); TRRD(h1, b_ + 6144); TRRD(l2, b_ + 8192); TRRD(h2, b_ + 10240); TRRD(l3, b_ + 12288); TRRD(h3, b_ + 14336); \
        asm volatile("s_waitcnt lgkmcnt(0)" ::: "memory"); SBAR();   \
        o[d0] = __builtin_amdgcn_mfma_f32_32x32x16_bf16(pa0, (bf16x8){l0[0], l0[1], l0[2], l0[3], h0[0], h0[1], h0[2], h0[3]}, o[d0], 0, 0, 0);   \
        o[d0] = __builtin_amdgcn_mfma_f32_32x32x16_bf16(pa1, (bf16x8){l1[0], l1[1], l1[2], l1[3], h1[0], h1[1], h1[2], h1[3]}, o[d0], 0, 0, 0);   \
        o[d0] = __builtin_amdgcn_mfma_f32_32x32x16_bf16(pa2, (bf16x8){l2[0], l2[1], l2[2], l2[3], h2[0], h2[1], h2[2], h2[3]}, o[d0], 0, 0, 0);   \
        o[d0] = __builtin_amdgcn_mfma_f32_32x32x16_bf16(pa3, (bf16x8){l3[0], l3[1], l3[2], l3[3], h3[0], h3[1], h3[2], h3[3]}, o[d0], 0, 0, 0); } while (0)
    PV_D0(0); PV_D0(1); PV_D0(2); PV_D0(3);
#undef PV_D0
#undef TRRD
}

struct BlockRef { const bf16_t* Q; const bf16_t* K; const bf16_t* V; bf16_t* O; const bf16_t* GZ; const float* BIAS; int P0; };
struct Seam { bf16x8 qr[8]; bf16x8 st_v0, st_v1, st_k0, st_k1; };
#define ROW(p, k0, rr) ((p) + (size_t)((k0) + (rr)) * D + sc)
#define VMW() asm volatile("s_waitcnt vmcnt(0)" ::: "memory")
#define VMWN(n) asm volatile("s_waitcnt vmcnt(%0)" :: "i"(n) : "memory")
#define LD8(p) (*reinterpret_cast<const bf16x8*>(p))
#define SLOAD_H(Kp, Vp, k0) do { S.st_v0 = LD8(ROW(Vp, k0, sr)); S.st_v1 = LD8(ROW(Vp, k0, 32 + sr));              \
                         S.st_k0 = LD8(ROW(Kp, k0, sr)); S.st_k1 = LD8(ROW(Kp, k0, 32 + sr)); } while (0)
#define SWRITE_HK(bf) do { *(bf16x8*)(K_lds + (bf) * SHM_K + kws) = S.st_k0; *(bf16x8*)(K_lds + (bf) * SHM_K + kws + 32 * 256) = S.st_k1; } while (0)
#define SWRITE_HV(bf) do { *(bf16x8*)(V_lds + (bf) * SHM_V + vst0) = S.st_v0; *(bf16x8*)(V_lds + (bf) * SHM_V + vst1) = S.st_v1; } while (0)
#define SWRITE_H(bf) do { SWRITE_HV(bf); SWRITE_HK(bf); } while (0)
__device__ __forceinline__ void causal_prime(const BlockRef& cur, char* lds, Seam& S) {
    const int tid = threadIdx.x, wid = __builtin_amdgcn_readfirstlane(tid >> 6), lane = tid & 63, r32 = lane & 31, hi = lane >> 5;
    const int sr = tid >> 4, sc = (tid & 15) * 8, kws = KSWZ(sr, sc * 2); char* K_lds = lds + 2 * SHM_V;
    for (int d0 = 0; d0 < 8; ++d0) S.qr[d0] = LD8(cur.Q + (size_t)(wid * QBLK + r32) * D + d0 * 16 + hi * 8);
    SLOAD_H(cur.K, cur.V, 0); VMW(); SWRITE_HK(0);
    __syncthreads();
}
__device__ __forceinline__ void causal_block(const BlockRef& cur, char* lds, Seam& S) {
    const int tid = threadIdx.x, wid = __builtin_amdgcn_readfirstlane(tid >> 6), lane = tid & 63, r32 = lane & 31, hi = lane >> 5;
    const int NT = (cur.P0 + QB - 1) / KVBLK + 1;
    const int qlo = cur.P0 + wid * QBLK, qm = qlo + r32 - 4 * hi;
    char* V_lds = lds; char* K_lds = lds + 2 * SHM_V;
    float* ws = (float*)(lds + OFF_WS) + wid * 64; float* li_l = ws, * al_l = ws + 32;
    float* bias_l = (float*)(lds + OFF_BIAS);
    for (int i = tid * 4; i < cur.P0 + QB; i += NW * 64 * 4) *(f32x4*)(bias_l + i) = *(const f32x4*)(cur.BIAS + i);
    __syncthreads();
    float m_reg = -1e30f, l_reg = 0; f32x16 o[4] = {};
    const int sr = tid >> 4, sc = (tid & 15) * 8, vst0 = v_st(sr, sc), vst1 = v_st(32 + sr, sc), kws = KSWZ(sr, sc * 2);
    const int vb0 = (int)(uintptr_t)V_lds + v_rd_base(lane);
    const bf16_t* Kh = cur.K; const bf16_t* Vh = cur.V;
#define RESC(a) do { if (__any((a) < 1.f)) { if (hi == 0) al_l[r32] = (a); asm volatile("s_waitcnt lgkmcnt(0)" ::: "memory");              \
                     for (int d_ = 0; d_ < 4; ++d_) for (int r = 0; r < 16; ++r) o[d_][r] *= al_l[crow(r, hi)]; } } while (0)
#define KBASE(t) ((t) * KVBLK)
#define MASKT(P0_, P1_, t) do { const int kb_ = KBASE(t); if (kb_ + KVBLK - 1 > qlo) mask_tile(P0_, P1_, qm - kb_, WBIG); } while (0)
    constexpr int NQL = 8;
#define SEAM_K0() do { VMWN(NQL); SWRITE_HK(0); SBAR(); } while (0)
    f32x16 pA0, pA1, pB0, pB1; float mnA, mnB, alA, alB; bf16x8 pa0, pa1, pa2, pa3;
    SWRITE_HV(0); SBAR();
    if (NT > 1) { SLOAD_H(Kh, Vh, KBASE(1)); }
    SBAR(); qkt<0>(pA0, pA1, K_lds, bias_l + 4 * hi + KBASE(0), r32, hi, S.qr);
    MASKT(pA0, pA1, 0); partialSM(pA0, pA1, m_reg, mnA, alA);
    if (NT > 1) { VMW(); SWRITE_H(1); }
    __syncthreads();
#define HALF_STEP(PX0, PX1, mnX, alX, PY0, PY1, alY, t, KB, VB, SB) do {                                                      \
        SBAR(); qkt<KB>(PX0, PX1, K_lds, bias_l + 4 * hi + KBASE(t), r32, hi, S.qr);                                             \
        finishSM(PY0, PY1, alY, l_reg, pa0, pa1, pa2, pa3); SBAR();                                                           \
        if ((t) + 1 < NT) { SLOAD_H(Kh, Vh, KBASE((t) + 1)); SBAR(); }                                               \
        pv_tile<VB>(o, vb0, pa0, pa1, pa2, pa3); MASKT(PX0, PX1, (t)); partialSM(PX0, PX1, m_reg, mnX, alX);                                        \
        __syncthreads();                                                                                                      \
        if ((t) + 1 < NT) { VMW(); SWRITE_H(SB); }                                                                          \
        RESC(alX); __syncthreads(); } while (0)
    for (int t = 1; t + 1 < NT; t += 2) {
        HALF_STEP(pB0, pB1, mnB, alB, pA0, pA1, alA, t, 1, 0, 0);
        HALF_STEP(pA0, pA1, mnA, alA, pB0, pB1, alB, t + 1, 0, 1, 1);
    }
    const bool even = (NT & 1) == 0;
    if (even) { SBAR(); qkt<1>(pB0, pB1, K_lds, bias_l + 4 * hi + KBASE(NT - 1), r32, hi, S.qr); SBAR(); }
    SBAR();
    finishSM(pA0, pA1, alA, l_reg, pa0, pa1, pa2, pa3); SBAR();
    pv_tile<0>(o, vb0, pa0, pa1, pa2, pa3);
    if (even) { MASKT(pB0, pB1, NT - 1); partialSM(pB0, pB1, m_reg, mnB, alB); __syncthreads(); RESC(alB);
        finishSM(pB0, pB1, alB, l_reg, pa0, pa1, pa2, pa3); SBAR(); pv_tile<1>(o, vb0, pa0, pa1, pa2, pa3); }
    SBAR();
    if (hi == 0) li_l[r32] = l_reg; asm volatile("s_waitcnt lgkmcnt(0)" ::: "memory");
    float rli[16];
#pragma unroll
    for (int r = 0; r < 16; ++r) rli[r] = __builtin_amdgcn_rcpf(li_l[crow(r, hi)]);
    int eoff = 4 * hi * OST + r32;
    asm volatile("" : "+v"(eoff));
    bf16_t* Ow = cur.O + (size_t)(wid * QBLK) * OST + eoff; const bf16_t* Gw = cur.GZ + (size_t)(wid * QBLK) * OST + eoff;
    unsigned gzv[16][4];
#pragma unroll
    for (int r = 0; r < 16; ++r) { const int ro = ((r & 3) + 8 * (r >> 2)) * OST;
#pragma unroll
        for (int d0 = 0; d0 < 4; ++d0) gzv[r][d0] = Gw[ro + d0 * 32]; }
#pragma unroll
    for (int r = 0; r < 16; ++r) { const int ro = ((r & 3) + 8 * (r >> 2)) * OST;
#pragma unroll
        for (int d0 = 0; d0 < 4; ++d0) { const float v = o[d0][r] * rli[r] * __uint_as_float(gzv[r][d0] << 16);
            const float vn = __shfl_xor(v, 1);
            if ((r32 & 1) == 0) *(unsigned*)(Ow + ro + d0 * 32) = pkbf(v, vn); } }
    __syncthreads();
#undef RESC
#undef KBASE
#undef MASKT
#undef SEAM_K0
#undef HALF_STEP
}
#undef ROW
#undef VMW
#undef VMWN
#undef LD8
#undef SLOAD_H
#undef SWRITE_HK
#undef SWRITE_HV
#undef SWRITE_H

struct Tensors { const bf16_t* Q; const bf16_t* K; const bf16_t* V; bf16_t* O; const bf16_t* GZ; const float* BIAS; };
__device__ __forceinline__ BlockRef make_ref(const Tensors& T, int L, int pass) {
    const int xcd = L & 7, k = L >> 3, bh = xcd * 4 + (k >> 3), x = k & 7, qb = pass ? 15 - x : x, b = bh >> 4, h = bh & 15;
    BlockRef r;
    r.Q = T.Q + ((size_t)bh * SEQ + (size_t)qb * QB) * D; r.K = T.K + (size_t)bh * SKV * D; r.V = T.V + (size_t)bh * SKV * D;
    r.O = T.O + ((size_t)(b * SEQ + qb * QB)) * OST + h * D; r.GZ = T.GZ + ((size_t)(b * SEQ + qb * QB)) * OST + h * D;
    r.BIAS = T.BIAS + bh * SKV; r.P0 = KPAD + qb * QB;
    return r;
}
__device__ __forceinline__ void attn_phase(char* lds, const Tensors& T) {
    const int total = 256, stride = gridDim.x;
    int L = blockIdx.x; if (L >= total) return;
    Seam S;
    for (; L < total; L += stride)
        for (int pass = 0; pass < 2; ++pass) {
            const BlockRef cur = make_ref(T, L, pass);
            causal_prime(cur, lds, S);
            causal_block(cur, lds, S);
        }
}
#undef KSWZ
#undef SBAR
}
constexpr int NWAVES = 8, LDS_BYTES = 147456;
static_assert(pg8::STAGE_BYTES + 8192 <= LDS_BYTES - 256 && pg8::STAGE_BYTES <= LDS_BYTES && HG_END <= LDS_BYTES && attn::LDS_BYTES <= LDS_BYTES, "LDS budget");
constexpr int N_PHASES = 9;
constexpr size_t WS_BAR = 1376256;
constexpr int LDS_MISC = LDS_BYTES - 256;
static_assert(WS_BAR >= (size_t)SM_END * 4 && WS_BAR % 256 == 0 && WS_BAR + 3 * XCD_BAR_WORDS * 4 <= 2 * MiB && HG_END <= LDS_MISC, "barrier words");
struct Args { const float* in[15]; float* out; unsigned char* ws; int ph_lo, ph_hi, li, pad; };

__global__ void __launch_bounds__(NWAVES * 64, 2) yoco_fwd(Args args) {
    extern __shared__ __attribute__((aligned(16))) unsigned char lds_raw[];
    LAS unsigned char* lds = (LAS unsigned char*)lds_raw;
    const int tid = threadIdx.x, lane = tid & 63, wave = __builtin_amdgcn_readfirstlane(tid >> 6);
    const int G = gridDim.x, gw = blockIdx.x * NWAVES + wave, NGW = G * NWAVES;
    unsigned char* ws = args.ws;
    Ptrs P;
    P.x = args.in[0]; P.meta = args.in[1]; P.gamma_lb = args.in[2]; P.a_norm = args.in[3]; P.a_w_in = args.in[4]; P.a_out_norm = args.in[5]; P.a_w_out = args.in[6];
    P.kv_norm = args.in[7]; P.kv_w = args.in[8]; P.fox_b_f = args.in[9]; P.fox_k_norm = args.in[10]; P.b_norm = args.in[11]; P.b_w_in = args.in[12]; P.b_q_norm = args.in[13]; P.b_w_out = args.in[14];
    P.out = args.out; P.sm = (float*)(ws + WS_SMALL);
    P.WT_AIN = (bf16_t*)(ws + WS_WT_AIN); P.WT_AOUT = (bf16_t*)(ws + WS_WT_AOUT); P.WT_KVB = (bf16_t*)(ws + WS_WT_KVB); P.WT_BOUT = (bf16_t*)(ws + WS_WT_BOUT); P.WT_F = (bf16_t*)(ws + WS_WT_F);
    P.XN0 = (bf16_t*)(ws + WS_XN0); P.QS = (bf16_t*)(ws + WS_QS); P.VV = (bf16_t*)(ws + WS_VV); P.GZ = (bf16_t*)(ws + WS_GZ); P.OG = (bf16_t*)(ws + WS_OG);
    bf16_t* H1BF = (bf16_t*)(ws + WS_XN0); bf16_t* KB = (bf16_t*)(ws + WS_QS); bf16_t* VB = (bf16_t*)(ws + WS_VV); bf16_t* QB2 = (bf16_t*)(ws + WS_GZ); bf16_t* GZ2 = (bf16_t*)(ws + WS_OG);
    float* SEGS = (float*)(ws + WS_WT_AIN); bf16_t* OG2 = (bf16_t*)(ws + WS_WT_AIN);
    unsigned short* LOGF = (unsigned short*)args.out;
    const int lo = args.ph_lo, hi = args.ph_hi;
    volatile LAS unsigned* MISC = (volatile LAS unsigned*)(lds + LDS_MISC);
    if (tid < 2) MISC[tid] = 0u;
    __syncthreads();
    const XcdBarrier bar = xcd_barrier_post((unsigned*)(ws + WS_BAR) + args.li * XCD_BAR_WORDS, MISC);
#ifndef PH_MASK
#ifdef DBG_STOP
#define PH_MASK ((2 << DBG_STOP) - 1)
#else
#define PH_MASK 0x1ff
#endif
#endif
#define IN(k) (((PH_MASK >> (k)) & 1) && lo <= (k) && (k) < hi)
#define SEAM(k) do { if (IN(k) && IN((k) + 1)) xcd_barrier(bar); } while (0)

#ifndef PH_DUP
#define PH_DUP -1
#endif
#define GSYNC() xcd_barrier(bar)
#if PH_DUP < 0
#define REP(k)
#define REP_END
#else
#define REP(k) for (int rep_ = 0; rep_ < (PH_DUP == (k) ? 2 : 1); ++rep_) { if (PH_DUP == (k) && rep_ == 1) GSYNC();
#define REP_END }
#endif
#ifdef EXTRA_SYNCS
    for (int es = 0; es < EXTRA_SYNCS; ++es) GSYNC();
#endif
    REP(0)
    if (IN(0)) { p0_prologue(P, lds, gw, NGW, wave, lane); }
    REP_END
    SEAM(0);
    REP(1)
    if (IN(1)) {
        pg8::Gemm g{P.XN0, P.WT_AIN, MR, 8192, DM}; pg8::StaticOrder S; S.init(MR, 8192, G, (int)blockIdx.x);
        pg8::Epi1 E{P.QS, LOGF, P.VV, P.GZ, P.sm + SM_LBV};
        pg8::gemm_phase<pg8::Epi1, pg8::StaticOrder, true, true>(lds, g, S, E);
        p1_meta(P, lds, gw, NGW, wave, lane);
    }
    REP_END
    SEAM(1);
    REP(2)
    if (IN(2)) {
        for (int it = blockIdx.x; it < 32 * 7; it += G) { const int bh = it / 7, seg = it % 7;
            hgrn_item<0>(lds, P.QS, LOGF, (const unsigned short*)(P.sm + SM_LOGFM), P.VV, P.GZ, P.OG, SEGS, P.sm + SM_DSEG, bh >> 4, bh & 15, seg); }
    }
    REP_END
    SEAM(2);
    REP(3)
    if (IN(3)) {
        for (int it = blockIdx.x; it < 256; it += G) { const int bh = it >> 3, seg = it & 7;
            hgrn_item<1>(lds, P.QS, LOGF, (const unsigned short*)(P.sm + SM_LOGFM), P.VV, P.GZ, P.OG, SEGS, P.sm + SM_DSEG, bh >> 4, bh & 15, seg); }
    }
    REP_END
    SEAM(3);
    if (IN(4)) {
        pg8::Gemm g{P.OG, P.WT_AOUT, MR, DM, DM}; pg8::StaticOrder S; S.init(MR, DM, G, (int)blockIdx.x);
        pg8::Epi2 E{P.x, P.out, H1BF, P.sm + SM_ROWSS};
        pg8::gemm_phase<pg8::Epi2, pg8::StaticOrder, true, true>(lds, g, S, E);
        p4_meta(P, H1BF, lds, gw, NGW, wave, lane);
    }
    SEAM(4);
    REP(5)
    if (IN(5)) {
        pg8::Gemm g{H1BF, P.WT_KVB, MR, 8192, DM}; pg8::StaticOrder S; S.init(MR, 8192, G, (int)blockIdx.x);
        pg8::Epi3 E{KB, VB, QB2, GZ2, P.sm + SM_ROWSS, P.fox_k_norm, P.b_q_norm, (LAS float*)(lds + pg8::STAGE_BYTES)};
        pg8::gemm_phase<pg8::Epi3, pg8::StaticOrder, true, true>(lds, g, S, E);
        p5_side(P, H1BF, KB, VB, lds, gw, NGW, wave, lane);
    }
    REP_END
    SEAM(5);
    if (IN(6)) { p6_norm_scan(P, KB, QB2, gw, NGW, lane); }
    SEAM(6);
    REP(7)
    if (IN(7)) {
        const attn::Tensors T{QB2, KB, VB, OG2, GZ2, P.sm + SM_BIAS};
        attn::attn_phase((char*)lds_raw, T);
    }
    REP_END
    SEAM(7);
    if (IN(8)) {
        pg8::Gemm g{OG2, P.WT_BOUT, MR, DM, DM}; pg8::StaticOrder S; S.init(MR, DM, G, (int)blockIdx.x);
        pg8::Epi4 E{H1BF, P.out};
        pg8::gemm_phase<pg8::Epi4, pg8::StaticOrder, true, true>(lds, g, S, E);
    }
#ifdef DBG_STOP
    { xcd_barrier(bar);
      const size_t n = (size_t)MR * DM;
      for (size_t i = (size_t)blockIdx.x * 512 + tid; i < n; i += (size_t)G * 512) {
          float v = 0.f;
          if (DBG_STOP == 1) v = bf2f(P.QS[i]) + bf2f(P.VV[i]) + bf2f(P.GZ[i]);
          if (DBG_STOP == 2) v = (i < (size_t)224 * 16384 ? SEGS[(i / (7 * 16384)) * (8 * 16384) + (i % (7 * 16384))] : 0.f) + (i < 32768 ? P.sm[SM_LOGFM + i] : 0.f) + (i < 16 * DM ? bf2f(P.QS[(size_t)MR * DM + i]) + bf2f(P.VV[(size_t)MR * DM + i]) + bf2f(P.GZ[(size_t)MR * DM + i]) : 0.f);
          if (DBG_STOP == 3) v = bf2f(P.OG[i]);
          if (DBG_STOP == 4) v = args.out[i] + bf2f(H1BF[i]);
          if (DBG_STOP == 5 || DBG_STOP == 6) v = bf2f(KB[i]) + bf2f(VB[i]) + bf2f(QB2[i]) + bf2f(GZ2[i]) + (i < 32 * SKV ? P.sm[SM_BIAS + i] * 1e-3f : 0.f);
          if (DBG_STOP == 7) v = bf2f(OG2[i]);
          args.out[i] = v;
      } }
#endif
#undef IN
#undef SEAM
}

#ifndef MK_PER_PHASE
#define MK_PER_PHASE 0
#endif
extern "C" void kernel_launch(void* const* d_in, const int* in_sizes, int n_in, void* d_out, int out_size, void* d_ws, size_t ws_size, hipStream_t stream) {
    static int grid = 0;
    if (grid == 0) {
        if (n_in != 15 || out_size != MR * DM || ws_size < WS_END) { fprintf(stderr, "kernel_launch: unexpected shapes (n_in %d, out %d, ws %zu)\n", n_in, out_size, ws_size); grid = -1; return; }
        int dev = 0, cus = 0, per_cu = 0;
        (void)hipGetDevice(&dev); (void)hipDeviceGetAttribute(&cus, hipDeviceAttributeMultiprocessorCount, dev);
        if (hipFuncSetAttribute((const void*)yoco_fwd, hipFuncAttributeMaxDynamicSharedMemorySize, LDS_BYTES) != hipSuccess) { fprintf(stderr, "kernel_launch: hipFuncSetAttribute failed\n"); grid = -1; return; }
        if (hipOccupancyMaxActiveBlocksPerMultiprocessor(&per_cu, (const void*)yoco_fwd, NWAVES * 64, LDS_BYTES) != hipSuccess || per_cu < 1) { fprintf(stderr, "kernel_launch: occupancy query says %d blocks per CU\n", per_cu); per_cu = 1; }
        (void)hipGetLastError();
        grid = cus > 0 ? cus : 256;
    }
    if (grid < 0) return;
    if (hipMemsetAsync((char*)d_ws + WS_BAR, 0, 3 * XCD_BAR_WORDS * 4, stream) != hipSuccess) { fprintf(stderr, "kernel_launch: hipMemsetAsync failed\n"); return; }
    Args a{};
    for (int i = 0; i < 15; ++i) a.in[i] = (const float*)d_in[i];
    a.out = (float*)d_out; a.ws = (unsigned char*)d_ws;
#if defined(DUP_PHASE)
    {
        const int cuts[4][2] = {{0, DUP_PHASE + 1}, {DUP_PHASE, DUP_PHASE + 1}, {DUP_PHASE + 1, N_PHASES}, {0, 0}};
        for (int li = 0; li < 3; ++li) { if (cuts[li][0] >= cuts[li][1]) continue; a.ph_lo = cuts[li][0]; a.ph_hi = cuts[li][1]; a.li = li; void* kargs[] = {&a};
            hipError_t e = hipLaunchCooperativeKernel((const void*)yoco_fwd, dim3(grid), dim3(NWAVES * 64), kargs, LDS_BYTES, stream);
            if (e != hipSuccess) { fprintf(stderr, "kernel_launch: launch %d failed: %s\n", li, hipGetErrorString(e)); break; } }
    }
#elif MK_PER_PHASE
    for (int p = 0; p < N_PHASES; ++p) { a.ph_lo = p; a.ph_hi = p + 1; void* kargs[] = {&a};
        hipError_t e = hipLaunchCooperativeKernel((const void*)yoco_fwd, dim3(grid), dim3(NWAVES * 64), kargs, LDS_BYTES, stream);
        if (e != hipSuccess) { fprintf(stderr, "kernel_launch: launch of phase %d failed: %s\n", p, hipGetErrorString(e)); break; } }
#else
    a.ph_lo = 0; a.ph_hi = N_PHASES; void* kargs[] = {&a};
    hipError_t e = hipLaunchCooperativeKernel((const void*)yoco_fwd, dim3(grid), dim3(NWAVES * 64), kargs, LDS_BYTES, stream);
    if (e != hipSuccess) fprintf(stderr, "kernel_launch: cooperative launch failed: %s (grid %d)\n", hipGetErrorString(e), grid);
#endif
}
```

```cpp
#include <hip/hip_runtime.h>
#include <hip/hip_cooperative_groups.h>
#include <cstdio>
#include <cstdint>
namespace cg = cooperative_groups;

constexpr int NB = 2, SEQ = 4096, DM = 2048, NH = 16, HD = 128, NMETA = 16;
constexpr int MR = NB * SEQ;
constexpr int MT = MR + NMETA;
constexpr int KPAD = 64;
constexpr int SKV = SEQ + KPAD;
constexpr float EPS = 1e-6f;

constexpr size_t MiB = 1u << 20;
constexpr size_t WS_SMALL = 0;
constexpr size_t WS_WT_AIN = 2 * MiB;
constexpr size_t WS_WT_AOUT = 34 * MiB;
constexpr size_t WS_WT_KVB = 42 * MiB;
constexpr size_t WS_WT_BOUT = 74 * MiB;
constexpr size_t WS_WT_F = 82 * MiB;
constexpr size_t WS_XN0 = 83 * MiB;
constexpr size_t WS_QS = 116 * MiB;
constexpr size_t WS_VV = 149 * MiB;
constexpr size_t WS_GZ = 182 * MiB;
constexpr size_t WS_OG = 215 * MiB;
constexpr size_t WS_END = 248 * MiB;
static_assert(WS_VV - WS_QS == 33 * MiB && WS_GZ - WS_VV == 33 * MiB, "Epi1 selects QS | VV | GZ by stride");
constexpr int SM_ROWSS = 0;
constexpr int SM_LBV = 8448;
constexpr int SM_LOGFM = 10496;
constexpr int SM_LOGF2 = 43264;
constexpr int SM_BIAS = 174592;
constexpr int SM_DSEG = 307712;
constexpr int SM_END = 340480;
static_assert(SM_LBV >= SM_ROWSS + MT && SM_LOGFM >= SM_LBV + 2048 && SM_LOGF2 >= SM_LOGFM + 16 * 2048 && SM_BIAS >= SM_LOGF2 + MT * 16 && SM_DSEG >= SM_BIAS + 32 * SKV && SM_END >= SM_DSEG + 256 * 128 && SM_END * 4 <= 2 * (int)MiB, "small map");

#define LAS __attribute__((address_space(3)))
typedef unsigned short bf16_t;
typedef short bf16x8 __attribute__((ext_vector_type(8)));
typedef short s16x4 __attribute__((ext_vector_type(4)));
typedef float f32x4 __attribute__((ext_vector_type(4)));
typedef float f32x16 __attribute__((ext_vector_type(16)));
typedef unsigned u32x4 __attribute__((ext_vector_type(4)));
typedef unsigned u32x2 __attribute__((ext_vector_type(2)));

__device__ __forceinline__ float bf2f(bf16_t v) { return __uint_as_float(((unsigned)v) << 16); }
typedef __bf16 bf16x2_t __attribute__((ext_vector_type(2)));
typedef float f32x2_t __attribute__((ext_vector_type(2)));
__device__ __forceinline__ unsigned pkbf(float lo, float hi) { f32x2_t v = {lo, hi}; bf16x2_t b = __builtin_convertvector(v, bf16x2_t); return __builtin_bit_cast(unsigned, b); }
typedef _Float16 f16x2_t __attribute__((ext_vector_type(2)));
__device__ __forceinline__ unsigned pkh(float lo, float hi) { f32x2_t v = {lo, hi}; f16x2_t b = __builtin_convertvector(v, f16x2_t); return __builtin_bit_cast(unsigned, b); }
__device__ __forceinline__ float h2f(unsigned v) { return (float)__builtin_bit_cast(_Float16, (unsigned short)v); }
__device__ __forceinline__ float fexp(float x) { return __builtin_amdgcn_exp2f(x * 1.4426950408889634f); }
__device__ __forceinline__ float fsigmoid(float x) { return __builtin_amdgcn_rcpf(1.0f + fexp(-x)); }
__device__ __forceinline__ float fsilu(float x) { return x * fsigmoid(x); }
__device__ __forceinline__ float flog(float x) { return __builtin_amdgcn_logf(x) * 0.6931471805599453f; }
__device__ __forceinline__ float wave_sum(float v) {
#pragma unroll
    for (int o = 1; o < 64; o <<= 1) v += __shfl_xor(v, o);
    return v;
}
namespace pg8 {
#define PG8_LAS __attribute__((address_space(3)))
typedef unsigned short bf16_t;
typedef short bf16x8 __attribute__((ext_vector_type(8)));
typedef float f32x4 __attribute__((ext_vector_type(4)));
typedef unsigned u32x4 __attribute__((ext_vector_type(4)));
constexpr int BM = 256, BK = 64, HALF = 128, HTB = HALF * BK * 2  , STAGE_BYTES = 8 * HTB, NXCD = 8, WGM = 4;

__host__ __device__ __forceinline__ int lds_byte(int r, int c) { const int st = (r >> 4) * 2 + (c >> 5), rr = r & 15, cc = c & 31, ob = rr * 64 + cc * 2; return st * 1024 + (ob ^ (((ob >> 9) & 1) << 5)); }
__host__ __device__ __forceinline__ void stage_rc(int b, int& R, int& C) { const int st = b / 1024, sb = b % 1024, swz = sb ^ (((sb >> 9) & 1) << 5); R = (st >> 1) * 16 + swz / 64; C = (st & 1) * 32 + (swz % 64) / 2; }
__host__ __device__ __forceinline__ int perm32(int rho) { const int n = rho >> 4, i = rho & 15; return 8 * (i >> 2) + 4 * n + (i & 3); }

struct Unit { int pm, pn; };
struct Gemm { const bf16_t* A; const bf16_t* Bt; int M, N, K; };

struct StaticOrder {
    int nM, nN, nwg, G, c;
    __host__ __device__ void init(int M, int N, int G_, int c_) { nM = M / BM; nN = N / BM; nwg = nM * nN; G = G_; c = c_; }
    __host__ __device__ bool next(int i, Unit& u) const {
        const long L = (long)i * G + c; if (L >= nwg) return false;
        int wgid = (int)L; { const int q = nwg / NXCD, r = nwg % NXCD, xcd = wgid % NXCD, off = wgid / NXCD; wgid = (xcd < r ? xcd * (q + 1) : r * (q + 1) + (xcd - r) * q) + off; }
        const int nig = WGM * nN, gid = wgid / nig, fm = gid * WGM, gsz = (nM - fm) < WGM ? (nM - fm) : WGM;
        u.pm = fm + ((wgid % nig) % gsz); u.pn = (wgid % nig) / gsz; return true;
    }
    __device__ __forceinline__ void a_ready(const Unit&) const {}
    __device__ __forceinline__ void done(const Unit&) const {}
};
__device__ __forceinline__ unsigned cvt_pk_bf16(float lo, float hi) { unsigned r; asm volatile("v_cvt_pk_bf16_f32 %0, %1, %2" : "=v"(r) : "v"(lo), "v"(hi)); return r; }
struct Epi1 {
    static constexpr bool PERM = true, AFTER_DRAIN = false;
    bf16_t* QS; unsigned short* LOGF; bf16_t* VV; bf16_t* GZ; const float* lbv;
    __device__ __forceinline__ void operator()(const f32x4 (&acc)[2][2][4][2], const Unit& u, int wr, int wc, int fr, int fq) const {
        const int type = u.pn >> 3, colt = (u.pn & 7) * BM;
        const int row0 = u.pm * BM + wr * 64 + fr, col0 = colt + wc * 32 + 8 * fq;
        if (type == 1) {
#pragma unroll
            for (int bj = 0; bj < 2; ++bj) {
                const f32x4 l0 = *(const f32x4*)(lbv + col0 + bj * HALF), l1 = *(const f32x4*)(lbv + col0 + bj * HALF + 4);
#pragma unroll
                for (int ai = 0; ai < 2; ++ai)
#pragma unroll
                    for (int m = 0; m < 4; ++m) {
                        unsigned short* rowp = LOGF + (size_t)(row0 + ai * HALF + m * 16) * DM + col0 + bj * HALF;
                        f32x4 v0 = acc[ai][bj][m][0], v1 = acc[ai][bj][m][1], o0, o1;
#pragma unroll
                        for (int j = 0; j < 4; ++j) { o0[j] = flog(l0[j] + (1.0f - l0[j]) * fsigmoid(v0[j])); o1[j] = flog(l1[j] + (1.0f - l1[j]) * fsigmoid(v1[j])); }
                        u32x4 w; w.x = pkh(o0[0], o0[1]); w.y = pkh(o0[2], o0[3]); w.z = pkh(o1[0], o1[1]); w.w = pkh(o1[2], o1[3]);
                        *(u32x4*)rowp = w;
                    }
            }
        } else {
            bf16_t* base = QS + (size_t)(type - (type > 0 ? 1 : 0)) * (size_t)(33u << 19);
            const bool act = type != 2;
#pragma unroll
            for (int ai = 0; ai < 2; ++ai)
#pragma unroll
                for (int m = 0; m < 4; ++m) {
                    bf16_t* rowp = base + (size_t)(row0 + ai * HALF + m * 16) * DM + col0;
#pragma unroll
                    for (int bj = 0; bj < 2; ++bj) {
                        f32x4 v0 = acc[ai][bj][m][0], v1 = acc[ai][bj][m][1];
                        if (act) {
#pragma unroll
                            for (int j = 0; j < 4; ++j) { v0[j] = fsilu(v0[j]); v1[j] = fsilu(v1[j]); }
                        }
                        u32x4 w; w.x = pkbf(v0[0], v0[1]); w.y = pkbf(v0[2], v0[3]); w.z = pkbf(v1[0], v1[1]); w.w = pkbf(v1[2], v1[3]);
                        *(u32x4*)(rowp + bj * HALF) = w;
                    }
                }
        }
    }
};
struct Epi2 {
    static constexpr bool PERM = false, AFTER_DRAIN = false;
    const float* X; float* H1; bf16_t* H1BF; float* rowss;
    __device__ __forceinline__ void operator()(const f32x4 (&acc)[2][2][4][2], const Unit& u, int wr, int wc, int fr, int fq) const {
        const int row0 = u.pm * BM + wr * 64 + fr, col0 = u.pn * BM + wc * 32 + 4 * fq;
#pragma unroll
        for (int ai = 0; ai < 2; ++ai)
#pragma unroll
            for (int m = 0; m < 4; ++m) {
                const int row = row0 + ai * HALF + m * 16; const size_t off = (size_t)row * DM + col0; float ss = 0.f;
#pragma unroll
                for (int bj = 0; bj < 2; ++bj)
#pragma unroll
                    for (int n = 0; n < 2; ++n) {
                        const f32x4 h = *(const f32x4*)(X + off + bj * HALF + n * 16) + acc[ai][bj][m][n];
                        u32x2 w; w.x = pkbf(h[0], h[1]); w.y = pkbf(h[2], h[3]);
                        *(u32x2*)(H1BF + off + bj * HALF + n * 16) = w;
                        ss += (h[0] * h[0] + h[1] * h[1]) + (h[2] * h[2] + h[3] * h[3]);
                    }
                ss += __shfl_xor(ss, 16); ss += __shfl_xor(ss, 32);
                if (fq == 0) atomicAdd(rowss + row, ss);
                asm volatile("" ::: "memory");
            }
    }
};
struct Epi3 {
    static constexpr bool PERM = true, AFTER_DRAIN = false;
    bf16_t* KB; bf16_t* VB; bf16_t* QB2; bf16_t* GZ2; const float* rowss; const float* gk; const float* gq; PG8_LAS float* xs;
    __device__ __forceinline__ void operator()(const f32x4 (&acc)[2][2][4][2], const Unit& u, int wr, int wc, int fr, int fq) const {
        const int type = u.pn >> 3, row0 = u.pm * BM + wr * 64 + fr;
        const int b = row0 >> 12;
        float rs[2][4];
#pragma unroll
        for (int ai = 0; ai < 2; ++ai)
#pragma unroll
            for (int m = 0; m < 4; ++m) rs[ai][m] = __builtin_amdgcn_rsqf(rowss[row0 + ai * HALF + m * 16] * (1.0f / DM) + EPS);
        const bool normed = (type == 0 || type == 2);
        if (normed) {
#pragma unroll
            for (int ai = 0; ai < 2; ++ai)
#pragma unroll
                for (int m = 0; m < 4; ++m)
#pragma unroll
                    for (int bj = 0; bj < 2; ++bj) {
                        const f32x4 v0 = acc[ai][bj][m][0] * rs[ai][m], v1 = acc[ai][bj][m][1] * rs[ai][m];
                        float ss = (v0[0] * v0[0] + v0[1] * v0[1]) + (v0[2] * v0[2] + v0[3] * v0[3]) + (v1[0] * v1[0] + v1[1] * v1[1]) + (v1[2] * v1[2] + v1[3] * v1[3]);
                        ss += __shfl_xor(ss, 16); ss += __shfl_xor(ss, 32);
                        if (fq == 0) xs[((ai * HALF + wr * 64 + m * 16 + fr) * 2 + bj) * 4 + wc] = ss;
                    }
            asm volatile("s_waitcnt lgkmcnt(0)" ::: "memory"); __builtin_amdgcn_s_barrier(); asm volatile("" ::: "memory");
        }
#pragma unroll
        for (int bj = 0; bj < 2; ++bj) {
            const int head = (u.pn & 7) * 2 + bj, bh = b * NH + head;
            f32x4 g0 = {1.f, 1.f, 1.f, 1.f}, g1 = g0;
            if (normed) { const float* gp = (type == 0 ? gk : gq) + head * HD + wc * 32 + 8 * fq; g0 = *(const f32x4*)gp; g1 = *(const f32x4*)(gp + 4); }
#pragma unroll
            for (int ai = 0; ai < 2; ++ai)
#pragma unroll
                for (int m = 0; m < 4; ++m) {
                    const int row = row0 + ai * HALF + m * 16, t = row & (SEQ - 1);
                    float sc = rs[ai][m];
                    if (normed) { const f32x4 p4 = *(const PG8_LAS f32x4*)(xs + ((ai * HALF + wr * 64 + m * 16 + fr) * 2 + bj) * 4);
                        sc *= __builtin_amdgcn_rsqf(((p4[0] + p4[1]) + (p4[2] + p4[3])) * (1.0f / HD) + EPS); }
                    f32x4 v0 = acc[ai][bj][m][0] * sc * g0, v1 = acc[ai][bj][m][1] * sc * g1;
                    bf16_t* dst;
                    if (type == 3) {
#pragma unroll
                        for (int j = 0; j < 4; ++j) { v0[j] = fsilu(v0[j]); v1[j] = fsilu(v1[j]); }
                        dst = GZ2 + (size_t)row * DM + (u.pn & 7) * BM + bj * HALF + wc * 32 + 8 * fq;
                    } else if (type == 2) dst = QB2 + ((size_t)bh * SEQ + t) * HD + wc * 32 + 8 * fq;
                    else dst = (type == 0 ? KB : VB) + ((size_t)bh * SKV + KPAD + t) * HD + wc * 32 + 8 * fq;
                    u32x4 w; w.x = pkbf(v0[0], v0[1]); w.y = pkbf(v0[2], v0[3]); w.z = pkbf(v1[0], v1[1]); w.w = pkbf(v1[2], v1[3]);
                    *(u32x4*)dst = w;
                }
        }
    }
};
struct Epi4 {
    static constexpr bool PERM = false, AFTER_DRAIN = false;
    const bf16_t* H1BF; float* OUT;
    __device__ __forceinline__ void operator()(const f32x4 (&acc)[2][2][4][2], const Unit& u, int wr, int wc, int fr, int fq) const {
        const int row0 = u.pm * BM + wr * 64 + fr, col0 = u.pn * BM + wc * 32 + 4 * fq;
#pragma unroll
        for (int ai = 0; ai < 2; ++ai)
#pragma unroll
            for (int m = 0; m < 4; ++m) {
                const size_t off = (size_t)(row0 + ai * HALF + m * 16) * DM + col0;
#pragma unroll
                for (int bj = 0; bj < 2; ++bj)
#pragma unroll
                    for (int n = 0; n < 2; ++n) {
                        const u32x2 w = *(const u32x2*)(H1BF + off + bj * HALF + n * 16);
                        const f32x4 h = {__uint_as_float(w.x << 16), __uint_as_float(w.x & 0xffff0000u), __uint_as_float(w.y << 16), __uint_as_float(w.y & 0xffff0000u)};
                        *(f32x4*)(OUT + off + bj * HALF + n * 16) = h + acc[ai][bj][m][n];
                    }
                asm volatile("" ::: "memory");
            }
    }
};
template <class Epi, class Sched, bool ALIGN_EPI = false, bool SP2 = false>
__device__ __forceinline__ void gemm_phase(PG8_LAS unsigned char* lds, const Gemm g, const Sched& S, const Epi& E) {
    const int tid = threadIdx.x, wid = __builtin_amdgcn_readfirstlane(tid >> 6), lane = tid & 63, wr = wid >> 2, wc = wid & 3, fr = lane & 15, fq = lane >> 4;
    const int K = g.K, nt = K / BK;
    unsigned voffA[2], voffB[2];
#pragma unroll
    for (int i = 0; i < 2; ++i) { int R, C; stage_rc(tid * 16 + i * 8192, R, C); const int Rb = Epi::PERM ? ((R & ~31) + perm32(R & 31)) : R;
        voffA[i] = (unsigned)(R * K + C) * 2u; voffB[i] = (unsigned)(Rb * K + C) * 2u; }
    const size_t kstep = (size_t)(BK * 2);
    const size_t hstep = (size_t)HALF * K * 2;
    const size_t tstep = 2 * hstep;
    const unsigned ldsw = (unsigned)wid * 1024u;
    const int aoff = lds_byte(wr * 64 + fr, fq * 8), boff = lds_byte(wc * 32 + fr, fq * 8);
#define PG8_SA(b, h) (((b) * 2 + (h)) * HTB)
#define PG8_SB(b, h) ((4 + (b) * 2 + (h)) * HTB)
#define PG8_STAGE(bufoff, gbase, voff) do { _Pragma("unroll") for (int _i = 0; _i < 2; ++_i) \
        __builtin_amdgcn_global_load_lds((const unsigned*)((const char*)(gbase) + (voff)[_i]), (PG8_LAS unsigned*)(lds + (bufoff) + ldsw + _i * 8192), 16, 0, 0); } while (0)
#define PG8_LDA(dst, b, h) do { _Pragma("unroll") for (int m = 0; m < 4; ++m) _Pragma("unroll") for (int k = 0; k < 2; ++k) dst[m][k] = *(const PG8_LAS bf16x8*)(lds + PG8_SA(b, h) + aoff + m * 2048 + k * 1024); } while (0)
#define PG8_LDB(dst, b, h) do { _Pragma("unroll") for (int n = 0; n < 2; ++n) _Pragma("unroll") for (int k = 0; k < 2; ++k) dst[n][k] = *(const PG8_LAS bf16x8*)(lds + PG8_SB(b, h) + boff + n * 2048 + k * 1024); } while (0)
#define PG8_MMA(ai, bj, At, Bt) do { __builtin_amdgcn_s_setprio(1); _Pragma("unroll") for (int m = 0; m < 4; ++m) _Pragma("unroll") for (int n = 0; n < 2; ++n) _Pragma("unroll") for (int k = 0; k < 2; ++k) \
        acc[ai][bj][m][n] = __builtin_amdgcn_mfma_f32_16x16x32_bf16(Bt[n][k], At[m][k], acc[ai][bj][m][n], 0, 0, 0); __builtin_amdgcn_s_setprio(0); } while (0)
#define PG8_WAIT_V(n) asm volatile("s_waitcnt vmcnt(" #n ")" ::: "memory")
#define PG8_WAIT_L(n) asm volatile("s_waitcnt lgkmcnt(" #n ")" ::: "memory")
#define PG8_BAR __builtin_amdgcn_s_barrier()
#define PG8_SCHED __builtin_amdgcn_sched_barrier(0)
    Unit cur, nxt; int ui = 0;
    if (!S.next(0, cur)) return;
    f32x4 acc[2][2][4][2];
#pragma unroll
    for (int a = 0; a < 2; ++a)
#pragma unroll
        for (int b = 0; b < 2; ++b)
#pragma unroll
            for (int m = 0; m < 4; ++m)
#pragma unroll
                for (int n = 0; n < 2; ++n) acc[a][b][m][n] = (f32x4){0.f, 0.f, 0.f, 0.f};
    bf16x8 At[4][2], B0[2][2], B1[2][2];
    const char* cA = (const char*)g.A + (size_t)cur.pm * tstep; const char* cB = (const char*)g.Bt + (size_t)cur.pn * tstep;
    S.a_ready(cur);
    if constexpr (SP2) {
        PG8_STAGE(PG8_SB(0, 0), cB, voffB); PG8_STAGE(PG8_SB(0, 1), cB + hstep, voffB); PG8_STAGE(PG8_SA(0, 0), cA, voffA); PG8_STAGE(PG8_SA(0, 1), cA + hstep, voffA);
        if (wr == 1) PG8_BAR;
        PG8_WAIT_V(2); PG8_BAR;
        PG8_STAGE(PG8_SB(1, 0), cB + kstep, voffB); PG8_STAGE(PG8_SA(1, 0), cA + kstep, voffA); PG8_STAGE(PG8_SB(1, 1), cB + hstep + kstep, voffB);
        PG8_WAIT_V(6); PG8_BAR;
    } else {
        PG8_STAGE(PG8_SB(0, 0), cB, voffB); PG8_STAGE(PG8_SA(0, 0), cA, voffA); PG8_STAGE(PG8_SB(0, 1), cB + hstep, voffB); PG8_STAGE(PG8_SA(0, 1), cA + hstep, voffA);
        if (wr == 1) PG8_BAR;
        PG8_WAIT_V(4); PG8_BAR;
        PG8_STAGE(PG8_SB(1, 0), cB + kstep, voffB); PG8_STAGE(PG8_SA(1, 0), cA + kstep, voffA); PG8_STAGE(PG8_SB(1, 1), cB + hstep + kstep, voffB);
        PG8_WAIT_V(6); PG8_BAR;
    }
    for (;;) {
        const bool has_next = S.next(ui + 1, nxt);
        const char* nA = has_next ? (const char*)g.A + (size_t)nxt.pm * tstep : cA; const char* nB = has_next ? (const char*)g.Bt + (size_t)nxt.pn * tstep : cB;
        for (int t = 0; t < nt; t += 2) {
            const bool last = (t == nt - 2);
            const char* a1 = cA + (size_t)(t + 1) * kstep;
            const char* a2 = last ? nA : cA + (size_t)(t + 2) * kstep; const char* b2 = last ? nB : cB + (size_t)(t + 2) * kstep;
            const char* a3 = a2 + kstep; const char* b3 = b2 + kstep;
            if (last && has_next) S.a_ready(nxt);
            if constexpr (SP2) {
            PG8_LDB(B0, 0, 0); PG8_LDB(B1, 0, 1); PG8_SCHED; PG8_LDA(At, 0, 0); PG8_STAGE(PG8_SA(1, 1), a1 + hstep, voffA);
            PG8_WAIT_V(8); PG8_WAIT_L(0); PG8_BAR; PG8_MMA(0, 0, At, B0); PG8_MMA(0, 1, At, B1); PG8_BAR; PG8_SCHED;
            PG8_LDA(At, 0, 1); PG8_STAGE(PG8_SB(0, 0), b2, voffB); PG8_STAGE(PG8_SB(0, 1), b2 + hstep, voffB); PG8_STAGE(PG8_SA(0, 0), a2, voffA);
            PG8_WAIT_V(8); PG8_WAIT_L(0); PG8_BAR; PG8_MMA(1, 0, At, B0); PG8_MMA(1, 1, At, B1); PG8_BAR; PG8_SCHED;
            PG8_LDB(B0, 1, 0); PG8_LDB(B1, 1, 1); PG8_SCHED; PG8_LDA(At, 1, 0); PG8_STAGE(PG8_SA(0, 1), a2 + hstep, voffA);
            PG8_WAIT_V(8); PG8_WAIT_L(0); PG8_BAR; PG8_MMA(0, 0, At, B0); PG8_MMA(0, 1, At, B1); PG8_BAR; PG8_SCHED;
            PG8_LDA(At, 1, 1); PG8_STAGE(PG8_SB(1, 0), b3, voffB); PG8_STAGE(PG8_SB(1, 1), b3 + hstep, voffB); PG8_STAGE(PG8_SA(1, 0), a3, voffA);
            PG8_WAIT_V(8); PG8_WAIT_L(0); PG8_BAR; PG8_MMA(1, 0, At, B0); PG8_MMA(1, 1, At, B1); PG8_BAR; PG8_SCHED;
            } else {
            PG8_LDB(B0, 0, 0); PG8_SCHED; PG8_LDA(At, 0, 0); PG8_STAGE(PG8_SA(1, 1), a1 + hstep, voffA);
            PG8_WAIT_L(8); PG8_BAR; PG8_WAIT_L(0); PG8_MMA(0, 0, At, B0); PG8_BAR; PG8_SCHED;
            PG8_LDB(B1, 0, 1); PG8_STAGE(PG8_SB(0, 0), b2, voffB);
            PG8_BAR; PG8_WAIT_L(0); PG8_MMA(0, 1, At, B1); PG8_BAR;
            PG8_LDA(At, 0, 1); PG8_STAGE(PG8_SA(0, 0), a2, voffA);
            PG8_BAR; PG8_WAIT_L(0); PG8_MMA(1, 0, At, B0); PG8_BAR; PG8_SCHED;
            PG8_STAGE(PG8_SB(0, 1), b2 + hstep, voffB);
            PG8_WAIT_V(6); PG8_BAR; PG8_MMA(1, 1, At, B1); PG8_BAR;
            PG8_LDB(B0, 1, 0); PG8_SCHED; PG8_LDA(At, 1, 0); PG8_STAGE(PG8_SA(0, 1), a2 + hstep, voffA);
            PG8_WAIT_L(8); PG8_BAR; PG8_WAIT_L(0); PG8_MMA(0, 0, At, B0); PG8_BAR; PG8_SCHED;
            PG8_LDB(B1, 1, 1); PG8_STAGE(PG8_SB(1, 0), b3, voffB);
            PG8_BAR; PG8_WAIT_L(0); PG8_MMA(0, 1, At, B1); PG8_BAR;
            PG8_LDA(At, 1, 1); PG8_STAGE(PG8_SA(1, 0), a3, voffA);
            PG8_BAR; PG8_WAIT_L(0); PG8_MMA(1, 0, At, B0); PG8_BAR; PG8_SCHED;
            PG8_STAGE(PG8_SB(1, 1), b3 + hstep, voffB);
            PG8_WAIT_V(6); PG8_BAR; PG8_MMA(1, 1, At, B1); PG8_BAR;
            }
        }
        if constexpr (ALIGN_EPI) { if (wr == 0) PG8_BAR; }
        if constexpr (!Epi::AFTER_DRAIN) { E(acc, cur, wr, wc, fr, fq); S.done(cur); }
        if (!has_next) break;
#pragma unroll
        for (int a = 0; a < 2; ++a)
#pragma unroll
            for (int b = 0; b < 2; ++b)
#pragma unroll
                for (int m = 0; m < 4; ++m)
#pragma unroll
                    for (int n = 0; n < 2; ++n) acc[a][b][m][n] = (f32x4){0.f, 0.f, 0.f, 0.f};
        cur = nxt; cA = nA; cB = nB; ++ui;
        if constexpr (ALIGN_EPI) { if (wr == 1) PG8_BAR; }
    }
    PG8_WAIT_V(0);
    if constexpr (!ALIGN_EPI) { if (wr == 0) PG8_BAR; }
    PG8_BAR;
    if constexpr (Epi::AFTER_DRAIN) { E.fused(acc, cur, wr, wc, fr, fq, lds, wid, lane); S.done(cur); }
#undef PG8_SA
#undef PG8_SB
#undef PG8_STAGE
#undef PG8_LDA
#undef PG8_LDB
#undef PG8_MMA
#undef PG8_WAIT_V
#undef PG8_WAIT_L
#undef PG8_BAR
#undef PG8_SCHED
}
}
#define XB_LAS __attribute__((address_space(3)))
#define XB_TMO      128
#define XB_XCNT(j)  (256  + 64 * (j))
#define XB_XSUB(j)  (1280 + 64 * (j))
#define XB_XGEN(j)  (2304 + 64 * (j))
#define XB_TOP      3328
#define XB_TOPGEN   3392
#define XCD_BAR_WORDS 3456
#define XB_SPIN_CAP (1u << 18)

__device__ __forceinline__ unsigned xb_ld(unsigned* p)              { return __hip_atomic_load(p, __ATOMIC_RELAXED, __HIP_MEMORY_SCOPE_AGENT); }
__device__ __forceinline__ unsigned xb_add(unsigned* p, unsigned v) { return __hip_atomic_fetch_add(p, v, __ATOMIC_RELAXED, __HIP_MEMORY_SCOPE_AGENT); }
__device__ __forceinline__ unsigned xb_xcc_id() { return (unsigned)__builtin_amdgcn_s_getreg((3 << 11) | 20) & 0xFu; }
#define XB_SPIN(cond, bar) do { unsigned _sp = 0; while (cond) { __builtin_amdgcn_s_sleep(1); \
    if ((++_sp & 255u) == 0u) { if (xb_ld(&(bar)[XB_TMO])) break; if (_sp > XB_SPIN_CAP) { atomicAdd(&(bar)[XB_TMO], 1u); break; } } } } while (0)

struct XcdBarrier {
    unsigned* bar; unsigned x;
    volatile XB_LAS unsigned* st;
};

__device__ __forceinline__ XcdBarrier xcd_barrier_post(unsigned* bar, volatile XB_LAS unsigned* st) {
    XcdBarrier b; b.bar = bar; b.x = xb_xcc_id(); b.st = st;
    if (threadIdx.x == 0) (void)xb_add(&bar[XB_XCNT(b.x)], 1u);
    return b;
}
__device__ __forceinline__ void xcd_barrier_complete(unsigned* bar, unsigned x, unsigned& nloc, unsigned& nx) {
    const unsigned G = gridDim.x * gridDim.y * gridDim.z;
    unsigned sum, cnt, mine, sp = 0u;
    for (;;) {
        sum = 0u; cnt = 0u; mine = 0u;
#pragma unroll
        for (unsigned j = 0; j < 16; ++j) { const unsigned c = xb_ld(&bar[XB_XCNT(j)]); sum += c; cnt += (c > 0u) ? 1u : 0u; mine = (j == x) ? c : mine; }
        if (sum == G) break;
        __builtin_amdgcn_s_sleep(1);
        if ((++sp & 255u) == 0u) { if (xb_ld(&bar[XB_TMO])) break; if (sp > XB_SPIN_CAP) { atomicAdd(&bar[XB_TMO], 1u); break; } }
    }
    nloc = mine > 0u ? mine : 1u; nx = cnt > 0u ? cnt : 1u;
}

__device__ __forceinline__ void xcd_barrier(const XcdBarrier& b) {
    asm volatile("s_waitcnt vmcnt(0)" ::: "memory");
    __syncthreads();
    if (threadIdx.x == 0) {
        unsigned* bar = b.bar;
        __builtin_amdgcn_s_waitcnt(0);
        unsigned nloc = b.st[0], nx = b.st[1];
        if (nloc == 0u) { xcd_barrier_complete(bar, b.x, nloc, nx); b.st[0] = nloc; b.st[1] = nx; }
        const unsigned old = xb_add(&bar[XB_XSUB(b.x)], 1u);
        const unsigned gen = old / nloc;
        if (old + 1u == (gen + 1u) * nloc) {
            __builtin_amdgcn_fence(__ATOMIC_RELEASE, "agent");
            asm volatile("s_waitcnt vmcnt(0)" ::: "memory");
            const unsigned og = xb_add(&bar[XB_TOP], 1u);
            const unsigned tg = og / nx;
            if (og + 1u == (tg + 1u) * nx) xb_add(&bar[XB_TOPGEN], 1u);
            else XB_SPIN(xb_ld(&bar[XB_TOPGEN]) == tg, bar);
            __builtin_amdgcn_fence(__ATOMIC_ACQUIRE, "agent");
            xb_add(&bar[XB_XGEN(b.x)], 1u);
            asm volatile("s_waitcnt vmcnt(0)" ::: "memory");
        } else {
            XB_SPIN(xb_ld(&bar[XB_XGEN(b.x)]) == gen, bar);
            __builtin_amdgcn_fence(__ATOMIC_ACQUIRE, "agent");
            asm volatile("s_waitcnt vmcnt(0)" ::: "memory");
        }
    }
    __syncthreads();
}
struct Ptrs {
    const float *x, *meta, *gamma_lb, *a_norm, *a_w_in, *a_out_norm, *a_w_out, *kv_norm, *kv_w, *fox_b_f, *fox_k_norm, *b_norm, *b_w_in, *b_q_norm, *b_w_out;
    float* out; float* sm;
    bf16_t *WT_AIN, *WT_AOUT, *WT_KVB, *WT_BOUT, *WT_F, *XN0, *QS, *VV, *GZ, *OG;
};

struct P0Item { const float* W; const float* g; bf16_t* WT; int ldw, row_off, k0, n0; };
constexpr int P0_I_AIN = 32 * 128, P0_I_AOUT = 32 * 32, P0_I_KV = 32 * 64, P0_I_BIN = 32 * 64, P0_I_BOUT = 32 * 32;
constexpr int P0_NITEMS = P0_I_AIN + P0_I_AOUT + P0_I_KV + P0_I_BIN + P0_I_BOUT;
__device__ __forceinline__ P0Item p0_decode(const Ptrs& P, int it) {
    P0Item I; int r = it, nblk;
    if (r < P0_I_AIN) { I.W = P.a_w_in; I.ldw = 8192; I.g = P.a_norm; I.WT = P.WT_AIN; I.row_off = 0; nblk = 128; }
    else if ((r -= P0_I_AIN) < P0_I_AOUT) { I.W = P.a_w_out; I.ldw = 2048; I.g = P.a_out_norm; I.WT = P.WT_AOUT; I.row_off = 0; nblk = 32; }
    else if ((r -= P0_I_AOUT) < P0_I_KV) { I.W = P.kv_w; I.ldw = 4112; I.g = P.kv_norm; I.WT = P.WT_KVB; I.row_off = 0; nblk = 64; }
    else if ((r -= P0_I_KV) < P0_I_BIN) { I.W = P.b_w_in; I.ldw = 4096; I.g = P.b_norm; I.WT = P.WT_KVB; I.row_off = 4096; nblk = 64; }
    else { r -= P0_I_BIN; I.W = P.b_w_out; I.ldw = 2048; I.g = nullptr; I.WT = P.WT_BOUT; I.row_off = 0; nblk = 32; }
    I.k0 = 64 * (r / nblk); I.n0 = 64 * (r % nblk);
    return I;
}
__device__ __forceinline__ void p0_item_load(const P0Item& I, int lane, f32x4 (&v)[16], float (&gg)[16]) {
    const int c4 = lane & 15, rr = lane >> 4;
#pragma unroll
    for (int i = 0; i < 16; ++i) { const int k = I.k0 + 4 * i + rr; v[i] = *(const f32x4*)(I.W + (size_t)k * I.ldw + I.n0 + 4 * c4); gg[i] = I.g ? I.g[k] : 1.0f; }
}
__device__ __forceinline__ void p0_item_store(const P0Item& I, LAS float* scr, int lane, const f32x4 (&v)[16], const float (&gg)[16]) {
    const int c4 = lane & 15, rr = lane >> 4;
#pragma unroll
    for (int i = 0; i < 16; ++i) { LAS float* p = scr + (4 * i + rr) * 65 + 4 * c4; p[0] = v[i][0] * gg[i]; p[1] = v[i][1] * gg[i]; p[2] = v[i][2] * gg[i]; p[3] = v[i][3] * gg[i]; }
    asm volatile("s_waitcnt lgkmcnt(0)" ::: "memory");
    const int c = lane & 7, nn = lane >> 3;
#pragma unroll
    for (int j = 0; j < 8; ++j) { const int n = nn + 8 * j; const LAS float* q = scr + (8 * c) * 65 + n;
        u32x4 o; o.x = pkbf(q[0 * 65], q[1 * 65]); o.y = pkbf(q[2 * 65], q[3 * 65]); o.z = pkbf(q[4 * 65], q[5 * 65]); o.w = pkbf(q[6 * 65], q[7 * 65]);
        *(u32x4*)(I.WT + (size_t)(I.row_off + I.n0 + n) * DM + I.k0 + 8 * c) = o; }
    asm volatile("s_waitcnt lgkmcnt(0)" ::: "memory");
}
__device__ __forceinline__ void rms_row_to_bf16(const float* xrow, bf16_t* orow, int lane) {
    const f32x4* xr = (const f32x4*)xrow + lane;
    f32x4 v[8]; float s = 0.f;
#pragma unroll
    for (int j = 0; j < 8; ++j) { v[j] = xr[64 * j]; s += (v[j].x * v[j].x + v[j].y * v[j].y) + (v[j].z * v[j].z + v[j].w * v[j].w); }
    const float rstd = __builtin_amdgcn_rsqf(wave_sum(s) * (1.f / DM) + EPS);
    u32x2* o8 = (u32x2*)orow + lane;
#pragma unroll
    for (int j = 0; j < 8; ++j) { u32x2 w; w.x = pkbf(v[j].x * rstd, v[j].y * rstd); w.y = pkbf(v[j].z * rstd, v[j].w * rstd); o8[64 * j] = w; }
}
__device__ __forceinline__ void p0_prologue(const Ptrs& P, LAS unsigned char* lds, int gw, int NGW, int wave, int lane) {
    LAS float* scr = (LAS float*)(lds + wave * 16640);
    {
        int it = gw; f32x4 va[16]; float ga[16];
        if (it < P0_NITEMS) p0_item_load(p0_decode(P, it), lane, va, ga);
        while (it < P0_NITEMS) {
            const int nx = it + NGW; f32x4 vb[16]; float gb[16];
            if (nx < P0_NITEMS) p0_item_load(p0_decode(P, nx), lane, vb, gb);
            p0_item_store(p0_decode(P, it), scr, lane, va, ga);
#pragma unroll
            for (int i = 0; i < 16; ++i) { va[i] = vb[i]; ga[i] = gb[i]; }
            it = nx;
        }
    }
    for (int idx = gw * 64 + lane; idx < 16 * DM; idx += NGW * 64) { const int k = idx >> 4, n = idx & 15;
        P.WT_F[(size_t)n * DM + k] = (bf16_t)(pkbf(P.kv_w[(size_t)k * 4112 + 4096 + n] * P.kv_norm[k], 0.f) & 0xffffu); }
    for (int m = gw; m < MT; m += NGW) rms_row_to_bf16(m < MR ? P.x + (size_t)m * DM : P.meta + (size_t)(m - MR) * DM, P.XN0 + (size_t)m * DM, lane);
    for (int idx = gw * 64 + lane; idx < DM; idx += NGW * 64) P.sm[SM_LBV + idx] = fsigmoid(P.gamma_lb[idx] - P.gamma_lb[DM + idx]);
    for (int idx = gw * 64 + lane; idx < MT; idx += NGW * 64) P.sm[SM_ROWSS + idx] = 0.f;
}

__device__ __forceinline__ f32x4 skinny_tile(const bf16_t* A, const bf16_t* Bt, int lane) {
    const int r = lane & 15, g = lane >> 4;
    const bf16x8* pa = (const bf16x8*)(A + (size_t)r * DM + 8 * g);
    const bf16x8* pb = (const bf16x8*)(Bt + (size_t)r * DM + 8 * g);
    f32x4 acc = {0.f, 0.f, 0.f, 0.f};
#pragma unroll 16
    for (int k = 0; k < DM / 32; ++k) acc = __builtin_amdgcn_mfma_f32_16x16x32_bf16(pa[4 * k], pb[4 * k], acc, 0, 0, 0);
    return acc;
}
__device__ __forceinline__ f32x4 skinny_tile4(const bf16_t* A, const bf16_t* Bt, int lane, int wave, LAS f32x4* xs) {
    const int r = lane & 15, g = lane >> 4, part = wave & 3;
    const bf16x8* pa = (const bf16x8*)(A + (size_t)r * DM + 8 * g + part * (DM / 4));
    const bf16x8* pb = (const bf16x8*)(Bt + (size_t)r * DM + 8 * g + part * (DM / 4));
    f32x4 acc = {0.f, 0.f, 0.f, 0.f};
#pragma unroll
    for (int k = 0; k < DM / 128; ++k) acc = __builtin_amdgcn_mfma_f32_16x16x32_bf16(pa[4 * k], pb[4 * k], acc, 0, 0, 0);
    xs[wave * 64 + lane] = acc;
    __syncthreads();
    const int w0 = wave & ~3;
    const f32x4 t = (xs[w0 * 64 + lane] + xs[(w0 + 1) * 64 + lane]) + (xs[(w0 + 2) * 64 + lane] + xs[(w0 + 3) * 64 + lane]);
    __syncthreads();
    return t;
}
constexpr int HG_LD128 = 136, HG_LD64 = 72, HG_LDO = 132;
constexpr int HG_QI = 0, HG_KI = HG_QI + 64 * HG_LD128 * 2, HG_QD = HG_KI + 64 * HG_LD128 * 2, HG_KDT = HG_QD + 64 * HG_LD128 * 2,
              HG_VT = HG_KDT + 128 * HG_LD64 * 2, HG_AL = HG_VT + 128 * HG_LD64 * 2, HG_ST = HG_AL + 64 * HG_LD64 * 2, HG_RT = HG_ST + 128 * HG_LD128 * 2,
              HG_DEC = HG_RT + 4 * 128 * 4, HG_END = HG_DEC + 128 * 4;
static_assert(HG_END <= 140000 && 64 * HG_LDO * 4 <= HG_QD, "hgrn LDS map (O tile overlays QI + KI)");

template <int MODE>
__device__ __forceinline__ void hgrn_item(LAS unsigned char* lds, const bf16_t* QS, const unsigned short* LOGF, const unsigned short* LOGFM, const bf16_t* VV, const bf16_t* GZ, bf16_t* OG,
                                          float* SEGS, float* DSEG, int b, int h, int seg) {
    const int tid = threadIdx.x, wid = __builtin_amdgcn_readfirstlane(tid >> 6), lane = tid & 63, r = lane & 15, g = lane >> 4;
    const int d = tid & 127, rq = tid >> 7, t0 = 16 * rq;
    LAS bf16_t* QI = (LAS bf16_t*)(lds + HG_QI); LAS bf16_t* KI = (LAS bf16_t*)(lds + HG_KI); LAS bf16_t* QD = (LAS bf16_t*)(lds + HG_QD);
    LAS bf16_t* KDT = (LAS bf16_t*)(lds + HG_KDT); LAS bf16_t* VT = (LAS bf16_t*)(lds + HG_VT); LAS bf16_t* AL = (LAS bf16_t*)(lds + HG_AL);
    LAS bf16_t* ST = (LAS bf16_t*)(lds + HG_ST); LAS float* RT = (LAS float*)(lds + HG_RT); LAS float* DEC = (LAS float*)(lds + HG_DEC);
    LAS float* OL = (LAS float*)(lds + HG_QI);
    const int item = (b * NH + h) * 8 + seg;
    const int c_begin = seg == 0 ? 0 : 8 * seg + 1, c_end = 8 * seg + 9;
    f32x4 Sacc[8];
#pragma unroll
    for (int dt = 0; dt < 8; ++dt) Sacc[dt] = (f32x4){0.f, 0.f, 0.f, 0.f};
    float dsum = 0.f;
    if (MODE == 1) {
#ifdef HG_NOFOLD
        for (int j = 0; j < 0; ++j) {
#else
        for (int j = 0; j < seg; ++j) {
#endif
            const int itj = (b * NH + h) * 8 + j;
            const float* sj = SEGS + (size_t)itj * 16384; const float* dj = DSEG + itj * 128;
#pragma unroll
            for (int dt = 0; dt < 8; ++dt) {
                const f32x4 l4 = *(const f32x4*)(dj + 16 * dt + 4 * g);
#pragma unroll
                for (int q = 0; q < 4; ++q) Sacc[dt][q] = fexp(l4[q]) * Sacc[dt][q] + sj[(16 * dt + 4 * g + q) * 128 + 16 * wid + r];
            }
        }
#pragma unroll
        for (int dt = 0; dt < 8; ++dt) { u32x2 w; w.x = pkbf(Sacc[dt][0], Sacc[dt][1]); w.y = pkbf(Sacc[dt][2], Sacc[dt][3]);
            *(LAS u32x2*)(ST + (16 * wid + r) * HG_LD128 + 16 * dt + 4 * g) = w; }
    }
    float lf[16]; unsigned q16[16], v16[16];
#define HG_LOAD(cc) do { const int c_ = (cc); const bool vld_ = c_ > 0 || rq == 3; const int rb_ = b * SEQ + (c_ - 1) * 64;                                   \
        const unsigned short* lp = c_ == 0 ? LOGFM + h * HD + d : LOGF + (size_t)(rb_ + t0) * DM + h * HD + d;                                                       \
        const size_t o16 = c_ == 0 ? (size_t)MR * DM + h * HD + d : (size_t)(rb_ + t0) * DM + h * HD + d;                                                   \
        _Pragma("unroll") for (int i = 0; i < 16; ++i) { const float x = h2f(lp[(size_t)i * DM]); const unsigned vv = VV[o16 + (size_t)i * DM];                   \
            lf[i] = vld_ ? x : 0.f; v16[i] = vld_ ? vv : 0u;                                                                                                \
            if (MODE == 1) { const unsigned qq = QS[o16 + (size_t)i * DM]; q16[i] = vld_ ? qq : 0u; } } } while (0)
    for (int c = c_begin; c < c_end; ++c) {
        HG_LOAD(c);
        const int rowbase = c == 0 ? (MR - 48) : b * SEQ + (c - 1) * 64;
        float cs[16];
        float run = 0.f;
#pragma unroll
        for (int i = 0; i < 16; ++i) { run += lf[i]; cs[i] = run; }
        RT[rq * 128 + d] = run;
        __syncthreads();
        const float r0 = RT[d], r1 = RT[128 + d], r2 = RT[256 + d], r3 = RT[384 + d];
        const float off = (rq > 0 ? r0 : 0.f) + (rq > 1 ? r1 : 0.f) + (rq > 2 ? r2 : 0.f);
        const float bmid = r0 + r1, blast = (r0 + r1) + (r2 + r3);
        if (rq == 0) { DEC[d] = fexp(blast); dsum += blast; }
        const float emid = fexp(bmid), elast = fexp(blast - bmid);
        {
            float kdv[16];
#pragma unroll
            for (int i = 0; i < 16; ++i) {
                const float bb = off + cs[i];
                const float kk = 1.0f - fexp(lf[i]);
                const float e1 = fexp(bb - bmid), e2 = fexp(bmid - bb);
                const float ki = kk * e2;
                kdv[i] = ki * elast;
                if (MODE == 1) {
                    const float qi = __uint_as_float(q16[i] << 16) * e1;
                    QI[(t0 + i) * HG_LD128 + d] = (bf16_t)(pkbf(qi, 0.f) & 0xffffu);
                    KI[(t0 + i) * HG_LD128 + d] = (bf16_t)(pkbf(ki, 0.f) & 0xffffu);
                    QD[(t0 + i) * HG_LD128 + d] = (bf16_t)(pkbf(qi * emid, 0.f) & 0xffffu);
                }
            }
            u32x4 w0, w1, x0, x1;
            w0.x = pkbf(kdv[0], kdv[1]); w0.y = pkbf(kdv[2], kdv[3]); w0.z = pkbf(kdv[4], kdv[5]); w0.w = pkbf(kdv[6], kdv[7]);
            w1.x = pkbf(kdv[8], kdv[9]); w1.y = pkbf(kdv[10], kdv[11]); w1.z = pkbf(kdv[12], kdv[13]); w1.w = pkbf(kdv[14], kdv[15]);
            x0.x = v16[0] | (v16[1] << 16); x0.y = v16[2] | (v16[3] << 16); x0.z = v16[4] | (v16[5] << 16); x0.w = v16[6] | (v16[7] << 16);
            x1.x = v16[8] | (v16[9] << 16); x1.y = v16[10] | (v16[11] << 16); x1.z = v16[12] | (v16[13] << 16); x1.w = v16[14] | (v16[15] << 16);
            *(LAS u32x4*)(KDT + d * HG_LD64 + t0) = w0; *(LAS u32x4*)(KDT + d * HG_LD64 + t0 + 8) = w1;
            *(LAS u32x4*)(VT + d * HG_LD64 + t0) = x0; *(LAS u32x4*)(VT + d * HG_LD64 + t0 + 8) = x1;
        }
        __syncthreads();
        const int tF = tid >> 3, e0F = 16 * (tid & 7);
        const bool wr_ok = c > 0 ? true : (tF >= 48 && b == 0);
        const size_t off2 = (size_t)(wr_ok ? rowbase + tF : MR) * DM + h * HD + e0F;
        u32x4 z0 = {0u, 0u, 0u, 0u}, z1 = z0;
        if (MODE == 1) { z0 = *(const u32x4*)(GZ + off2); z1 = *(const u32x4*)(GZ + off2 + 8); }
        if (MODE == 1) {
            const int ti = wid & 3, si0 = 2 * (wid >> 2);
#pragma unroll
            for (int sj = 0; sj < 2; ++sj) {
                const int si = si0 + sj;
                f32x4 a4 = {0.f, 0.f, 0.f, 0.f};
                if (si <= ti) {
#pragma unroll
                    for (int k4 = 0; k4 < 4; ++k4) {
                        const bf16x8 fa = *(const LAS bf16x8*)(KI + (16 * si + r) * HG_LD128 + 32 * k4 + 8 * g);
                        const bf16x8 fb = *(const LAS bf16x8*)(QI + (16 * ti + r) * HG_LD128 + 32 * k4 + 8 * g);
                        a4 = __builtin_amdgcn_mfma_f32_16x16x32_bf16(fa, fb, a4, 0, 0, 0);
                    }
                    if (si == ti) {
#pragma unroll
                        for (int q = 0; q < 4; ++q) if (4 * g + q > r) a4[q] = 0.f;
                    }
                }
                u32x2 w; w.x = pkbf(a4[0], a4[1]); w.y = pkbf(a4[2], a4[3]);
                *(LAS u32x2*)(AL + (16 * ti + r) * HG_LD64 + 16 * si + 4 * g) = w;
            }
            __syncthreads();
        }
        bf16x8 bv[2];
        bv[0] = *(const LAS bf16x8*)(VT + (16 * wid + r) * HG_LD64 + 8 * g);
        bv[1] = *(const LAS bf16x8*)(VT + (16 * wid + r) * HG_LD64 + 32 + 8 * g);
        if (MODE == 1) {
            bf16x8 sf[4];
#pragma unroll
            for (int k4 = 0; k4 < 4; ++k4) sf[k4] = *(const LAS bf16x8*)(ST + (16 * wid + r) * HG_LD128 + 32 * k4 + 8 * g);
#pragma unroll
            for (int ti = 0; ti < 4; ++ti) {
                f32x4 o4 = {0.f, 0.f, 0.f, 0.f};
#pragma unroll
                for (int k4 = 0; k4 < 4; ++k4) {
                    const bf16x8 fa = *(const LAS bf16x8*)(QD + (16 * ti + r) * HG_LD128 + 32 * k4 + 8 * g);
                    o4 = __builtin_amdgcn_mfma_f32_16x16x32_bf16(fa, sf[k4], o4, 0, 0, 0);
                }
#pragma unroll
                for (int ks = 0; ks < 2; ++ks) {
                    if (ks == 1 && ti < 2) continue;
                    const bf16x8 fa = *(const LAS bf16x8*)(AL + (16 * ti + r) * HG_LD64 + 32 * ks + 8 * g);
                    o4 = __builtin_amdgcn_mfma_f32_16x16x32_bf16(fa, bv[ks], o4, 0, 0, 0);
                }
#pragma unroll
                for (int q = 0; q < 4; ++q) OL[(16 * ti + 4 * g + q) * HG_LDO + 16 * wid + r] = o4[q];
            }
        }
#pragma unroll
        for (int dt = 0; dt < 8; ++dt) {
            const f32x4 dc = *(const LAS f32x4*)(DEC + 16 * dt + 4 * g);
            Sacc[dt] = Sacc[dt] * dc;
#pragma unroll
            for (int ks = 0; ks < 2; ++ks) {
                const bf16x8 fa = *(const LAS bf16x8*)(KDT + (16 * dt + r) * HG_LD64 + 32 * ks + 8 * g);
                Sacc[dt] = __builtin_amdgcn_mfma_f32_16x16x32_bf16(fa, bv[ks], Sacc[dt], 0, 0, 0);
            }
        }
        if (MODE == 1) {
#pragma unroll
            for (int dt = 0; dt < 8; ++dt) { u32x2 w; w.x = pkbf(Sacc[dt][0], Sacc[dt][1]); w.y = pkbf(Sacc[dt][2], Sacc[dt][3]);
                *(LAS u32x2*)(ST + (16 * wid + r) * HG_LD128 + 16 * dt + 4 * g) = w; }
            __syncthreads();
            const int t = tF, e0 = e0F;
            f32x4 o[4]; float ss = 0.f;
#pragma unroll
            for (int q = 0; q < 4; ++q) { o[q] = *(const LAS f32x4*)(OL + t * HG_LDO + e0 + 4 * q); ss += (o[q][0] * o[q][0] + o[q][1] * o[q][1]) + (o[q][2] * o[q][2] + o[q][3] * o[q][3]); }
            ss += __shfl_xor(ss, 1); ss += __shfl_xor(ss, 2); ss += __shfl_xor(ss, 4);
            const float rstd = __builtin_amdgcn_rsqf(ss * (1.0f / HD) + EPS);
            if (wr_ok) {
                u32x4 w0, w1;
#define HG_G(zw, a, b_) pkbf((a) * rstd * __uint_as_float((zw) << 16), (b_) * rstd * __uint_as_float((zw) & 0xffff0000u))
                w0.x = HG_G(z0.x, o[0][0], o[0][1]); w0.y = HG_G(z0.y, o[0][2], o[0][3]); w0.z = HG_G(z0.z, o[1][0], o[1][1]); w0.w = HG_G(z0.w, o[1][2], o[1][3]);
                w1.x = HG_G(z1.x, o[2][0], o[2][1]); w1.y = HG_G(z1.y, o[2][2], o[2][3]); w1.z = HG_G(z1.z, o[3][0], o[3][1]); w1.w = HG_G(z1.w, o[3][2], o[3][3]);
#undef HG_G
                *(u32x4*)(OG + off2) = w0; *(u32x4*)(OG + off2 + 8) = w1;
            }
        }
        __syncthreads();
    }
#undef HG_LOAD
    if (MODE == 0) {
        float* sj = SEGS + (size_t)item * 16384;
#pragma unroll
        for (int dt = 0; dt < 8; ++dt)
#pragma unroll
            for (int q = 0; q < 4; ++q) sj[(16 * dt + 4 * g + q) * 128 + 16 * wid + r] = Sacc[dt][q];
        if (rq == 0) DSEG[item * 128 + d] = dsum;
    }
}
__device__ __forceinline__ void p1_meta(const Ptrs& P, LAS unsigned char* lds, int gw, int NGW, int wave, int lane) {
    const int r = lane & 15, g = lane >> 4; LAS f32x4* xs = (LAS f32x4*)lds;
    for (int base = 0; base < 512; base += NGW / 4) {
        const int tl = base + (gw >> 2); const bool ok = tl < 512 && (wave & 3) == 0;
        const f32x4 acc = skinny_tile4(P.XN0 + (size_t)MR * DM, P.WT_AIN + (size_t)(tl < 512 ? tl : 0) * 16 * DM, lane, wave, xs);
        if (!ok) continue;
        const int col = tl * 16 + r, type = col >> 11, c = col & 2047;
#pragma unroll
        for (int q = 0; q < 4; ++q) {
            const int mr = 4 * g + q; const float v = acc[q];
            if (type == 0) P.QS[(size_t)(MR + mr) * DM + c] = (bf16_t)(pkbf(fsilu(v), 0.f) & 0xffffu);
            else if (type == 1) { const float lb = P.sm[SM_LBV + c]; ((unsigned short*)(P.sm + SM_LOGFM))[mr * DM + c] = (unsigned short)(pkh(flog(lb + (1.0f - lb) * fsigmoid(v)), 0.f) & 0xffffu); }
            else if (type == 2) P.VV[(size_t)(MR + mr) * DM + c] = (bf16_t)(pkbf(v, 0.f) & 0xffffu);
            else P.GZ[(size_t)(MR + mr) * DM + c] = (bf16_t)(pkbf(fsilu(v), 0.f) & 0xffffu);
        }
    }
}
__device__ __forceinline__ void p4_meta(const Ptrs& P, bf16_t* H1BF, LAS unsigned char* lds, int gw, int NGW, int wave, int lane) {
    const int r = lane & 15, g = lane >> 4; LAS f32x4* xs = (LAS f32x4*)lds;
    for (int base = 0; base < 128; base += NGW / 4) {
        const int tl = base + (gw >> 2); const bool ok = tl < 128 && (wave & 3) == 0;
        const f32x4 acc = skinny_tile4(P.OG + (size_t)MR * DM, P.WT_AOUT + (size_t)(tl < 128 ? tl : 0) * 16 * DM, lane, wave, xs);
        if (!ok) continue;
        const int col = tl * 16 + r;
#pragma unroll
        for (int q = 0; q < 4; ++q) {
            const int mr = 4 * g + q; const float hv = P.meta[mr * DM + col] + acc[q];
            H1BF[(size_t)(MR + mr) * DM + col] = (bf16_t)(pkbf(hv, 0.f) & 0xffffu);
            float ss = hv * hv; ss += __shfl_xor(ss, 1); ss += __shfl_xor(ss, 2); ss += __shfl_xor(ss, 4); ss += __shfl_xor(ss, 8);
            if (r == 0) atomicAdd(P.sm + SM_ROWSS + MR + mr, ss);
        }
    }
}
__device__ __forceinline__ void p5_side(const Ptrs& P, const bf16_t* H1BF, bf16_t* KB, bf16_t* VB, LAS unsigned char* lds, int gw, int NGW, int wave, int lane) {
    const int r = lane & 15, g = lane >> 4; LAS f32x4* xs = (LAS f32x4*)lds;
    for (int base = 0; base < 256 + 513; base += NGW / 4) {
        const int tl = base + (gw >> 2); const bool inr = tl < 256 + 513, ok = inr && (wave & 3) == 0;
        const bool meta = !inr || tl < 256; const int rt = meta ? 0 : tl - 256;
        const bf16_t* A = meta ? H1BF + (size_t)MR * DM : H1BF + (size_t)rt * 16 * DM;
        const bf16_t* Bt = meta ? P.WT_KVB + (size_t)(inr ? tl : 0) * 16 * DM : P.WT_F;
        const f32x4 acc = skinny_tile4(A, Bt, lane, wave, xs);
        if (!ok) continue;
        if (tl < 256) {
            const int col = tl * 16 + r, isv = col >> 11, c = col & 2047, head = c >> 7, dd = c & 127;
#pragma unroll
            for (int q = 0; q < 4; ++q) {
                const int mr = 4 * g + q;
                const float rs = __builtin_amdgcn_rsqf(P.sm[SM_ROWSS + MR + mr] * (1.0f / DM) + EPS);
                const bf16_t v = (bf16_t)(pkbf(acc[q] * rs, 0.f) & 0xffffu);
                bf16_t* bs = isv ? VB : KB;
                bs[((size_t)(0 * NH + head) * SKV + 48 + mr) * HD + dd] = v;
                bs[((size_t)(1 * NH + head) * SKV + 48 + mr) * HD + dd] = v;
            }
        } else {
            const float bf = P.fox_b_f[r];
#pragma unroll
            for (int q = 0; q < 4; ++q) {
                const int row = rt * 16 + 4 * g + q;
                const float rs = __builtin_amdgcn_rsqf(P.sm[SM_ROWSS + row] * (1.0f / DM) + EPS);
                const float xl = acc[q] * rs + bf;
                P.sm[SM_LOGF2 + row * 16 + r] = fminf(xl, 0.f) - flog(1.0f + fexp(-fabsf(xl)));
            }
        }
    }
    for (int idx = gw * 64 + lane; idx < 32 * 48 * 16; idx += NGW * 64) {
        const int bh = idx / (48 * 16), rem = idx % (48 * 16);
        const u32x4 z = {0u, 0u, 0u, 0u};
        *(u32x4*)(KB + (size_t)bh * SKV * HD + rem * 8) = z; *(u32x4*)(VB + (size_t)bh * SKV * HD + rem * 8) = z;
    }
}
__device__ __forceinline__ void p6_norm_scan(const Ptrs& P, bf16_t* KB, bf16_t* QB2, int gw, int NGW, int lane) {
    const int sub = lane >> 4, l16 = lane & 15;
    constexpr int NKR = 32 * SKV, NQR = 32 * SEQ;
    (void)NKR; (void)NQR; (void)QB2;
    for (int r4 = gw; r4 < 32 * 16 / 4; r4 += NGW) {
        const int rr = r4 * 4 + sub, bh = rr >> 4, mr = rr & 15;
        bf16_t* p = KB + ((size_t)bh * SKV + 48 + mr) * HD; const float* gn = P.fox_k_norm + (bh & 15) * HD;
        const u32x4 w = *(const u32x4*)(p + 8 * l16);
        float v[8];
        v[0] = __uint_as_float(w.x << 16); v[1] = __uint_as_float(w.x & 0xffff0000u); v[2] = __uint_as_float(w.y << 16); v[3] = __uint_as_float(w.y & 0xffff0000u);
        v[4] = __uint_as_float(w.z << 16); v[5] = __uint_as_float(w.z & 0xffff0000u); v[6] = __uint_as_float(w.w << 16); v[7] = __uint_as_float(w.w & 0xffff0000u);
        float ss = 0.f;
#pragma unroll
        for (int j = 0; j < 8; ++j) ss += v[j] * v[j];
        ss += __shfl_xor(ss, 1); ss += __shfl_xor(ss, 2); ss += __shfl_xor(ss, 4); ss += __shfl_xor(ss, 8);
        const float rs = __builtin_amdgcn_rsqf(ss * (1.0f / HD) + EPS);
        const f32x4 g0 = *(const f32x4*)(gn + 8 * l16), g1 = *(const f32x4*)(gn + 8 * l16 + 4);
        u32x4 o; o.x = pkbf(v[0] * rs * g0[0], v[1] * rs * g0[1]); o.y = pkbf(v[2] * rs * g0[2], v[3] * rs * g0[3]);
        o.z = pkbf(v[4] * rs * g1[0], v[5] * rs * g1[1]); o.w = pkbf(v[6] * rs * g1[2], v[7] * rs * g1[3]);
        *(u32x4*)(p + 8 * l16) = o;
    }
    if ((gw & 7) == 0) for (int sidx = gw >> 3; sidx < 32; sidx += NGW >> 3) {
        const int b = sidx >> 4, h = sidx & 15; float* bias = P.sm + SM_BIAS + sidx * SKV;
        if (lane < 48) bias[lane] = -1e30f;
        constexpr int NPOS = NMETA + SEQ, PER = 65;
        float v[PER];
#pragma unroll
        for (int k = 0; k < PER; ++k) {
            const int pos = lane * PER + k, pc = pos < NPOS ? pos : NPOS - 1;
            const int row = pc < NMETA ? MR + pc : b * SEQ + pc - NMETA;
            const float x = P.sm[SM_LOGF2 + row * 16 + h];
            v[k] = pos < NPOS ? x : 0.f;
        }
        float run = 0.f;
#pragma unroll
        for (int k = 0; k < PER; ++k) { run += v[k]; v[k] = run; }
        float tot = run;
#pragma unroll
        for (int o = 1; o < 64; o <<= 1) { const float n = __shfl_up(tot, o); if (lane >= o) tot += n; }
        const float base = tot - run;
#pragma unroll
        for (int k = 0; k < PER; ++k) { const int pos = lane * PER + k; if (pos < NPOS) bias[48 + pos] = -(base + v[k]) * 11.313708498984761f; }
    }
}
namespace attn {
constexpr float SCALE = 0.08838834764831845f;
constexpr float THR = 20.f;
constexpr int NW = 8, QBLK = 32, KVBLK = 64, QB = NW * QBLK, D = 128, OST = 2048;
constexpr int SHM_V = KVBLK * D * 2, SHM_K = KVBLK * D * 2;
constexpr int OFF_WS = 2 * SHM_V + 2 * SHM_K, OFF_BIAS = OFF_WS + NW * 64 * 4, LDS_BYTES = OFF_BIAS + SKV * 4;
constexpr unsigned WBIG = 1u << 30;

#define KSWZ(row, colB) ((row) * 256 + ((colB) ^ (((row) & 7) << 4)))
#define SBAR() __builtin_amdgcn_sched_barrier(0)
__device__ __forceinline__ int v_st(int k, int c) { const int kk = (k & ~0xC) | ((k & 4) << 1) | ((k & 8) >> 1); return ((kk >> 3) * 4 + (c >> 5)) * 512 + ((kk & 7) * 32 + (c & 31)) * 2; }
__device__ __forceinline__ int v_rd_base(int lane) { return ((lane & 3) << 3) | (((lane >> 2) & 3) << 6) | (((lane >> 4) & 1) << 5) | (((lane >> 5) & 1) << 8); }
constexpr int v_rd_off(int d0, int ks, int half) { return d0 * 512 + ks * 4096 + half * 2048; }
__device__ __forceinline__ int crow(int r, int hi) { return (r & 3) + 8 * (r >> 2) + 4 * hi; }
__device__ __forceinline__ void mask_tile(f32x16& p0, f32x16& p1, int dq, unsigned W) {
    const float NEG = -__builtin_inff();
#pragma unroll
    for (int r = 0; r < 16; ++r) {
        const int c = (r & 3) + 8 * (r >> 2);
        if ((unsigned)(dq - c) >= W) p0[r] = NEG;
        if ((unsigned)(dq - c - 32) >= W) p1[r] = NEG;
    }
}
__device__ __forceinline__ void partialSM(f32x16& p0, f32x16& p1, float& m_reg, float& mn, float& alpha) {
    float pmax = p0[0]; for (int r = 1; r < 16; ++r) pmax = fmaxf(pmax, p0[r]); for (int r = 0; r < 16; ++r) pmax = fmaxf(pmax, p1[r]);
    { auto rr = __builtin_amdgcn_permlane32_swap(__float_as_uint(pmax), __float_as_uint(pmax), false, false);
      pmax = fmaxf(__uint_as_float(rr[0]), __uint_as_float(rr[1])); }
    constexpr float C2 = 1.4426950408889634f * SCALE;
    if (__builtin_expect(__all((pmax - m_reg) * SCALE <= THR), 1)) { mn = m_reg; alpha = 1.f; }
    else { mn = fmaxf(m_reg, pmax); alpha = __builtin_amdgcn_exp2f((m_reg - mn) * C2); m_reg = mn; }
    const float mnL = -mn * C2;
    for (int r = 0; r < 16; ++r) p0[r] = fmaf(p0[r], C2, mnL); for (int r = 0; r < 16; ++r) p1[r] = fmaf(p1[r], C2, mnL);
    for (int r = 0; r < 16; ++r) p0[r] = __builtin_amdgcn_exp2f(p0[r]);
}
__device__ __forceinline__ void finishSM(f32x16& p0, f32x16& p1, float alpha, float& l_reg, bf16x8& pa0, bf16x8& pa1, bf16x8& pa2, bf16x8& pa3) {
    for (int r = 0; r < 16; ++r) p1[r] = __builtin_amdgcn_exp2f(p1[r]);
    float ps = 0; for (int r = 0; r < 16; ++r) ps += p0[r]; for (int r = 0; r < 16; ++r) ps += p1[r];
    { auto rr = __builtin_amdgcn_permlane32_swap(__float_as_uint(ps), __float_as_uint(ps), false, false);
      ps = __uint_as_float(rr[0]) + __uint_as_float(rr[1]); }
    l_reg = l_reg * alpha + ps;
#define PK4(P, B_, OUT) do { unsigned a0 = pkbf(P[B_+0], P[B_+1]), a1 = pkbf(P[B_+2], P[B_+3]);                          \
        unsigned b0 = pkbf(P[B_+4], P[B_+5]), b1 = pkbf(P[B_+6], P[B_+7]);                                             \
        auto r0 = __builtin_amdgcn_permlane32_swap(a0, b0, false, false); auto r1 = __builtin_amdgcn_permlane32_swap(a1, b1, false, false); \
        u32x4 w = {r0[0], r1[0], r0[1], r1[1]}; OUT = *reinterpret_cast<bf16x8*>(&w); } while (0)
    PK4(p0, 0, pa0); PK4(p0, 8, pa1); PK4(p1, 0, pa2); PK4(p1, 8, pa3);
#undef PK4
}
template <int KB>
__device__ __forceinline__ void qkt(f32x16& p0, f32x16& p1, const char* K_lds, const float* bl, int r32, int hi, const bf16x8* qr) {
    {
        const f32x4 a0 = *(const f32x4*)(bl), a1 = *(const f32x4*)(bl + 8), a2 = *(const f32x4*)(bl + 16), a3 = *(const f32x4*)(bl + 24);
        const f32x4 c0 = *(const f32x4*)(bl + 32), c1 = *(const f32x4*)(bl + 40), c2 = *(const f32x4*)(bl + 48), c3 = *(const f32x4*)(bl + 56);
        p0 = (f32x16){a0[0], a0[1], a0[2], a0[3], a1[0], a1[1], a1[2], a1[3], a2[0], a2[1], a2[2], a2[3], a3[0], a3[1], a3[2], a3[3]};
        p1 = (f32x16){c0[0], c0[1], c0[2], c0[3], c1[0], c1[1], c1[2], c1[3], c2[0], c2[1], c2[2], c2[3], c3[0], c3[1], c3[2], c3[3]};
    }
    const char* kb[4];
#pragma unroll
    for (int dd = 0; dd < 4; ++dd) kb[dd] = K_lds + KB * SHM_K + KSWZ(r32, (dd * 16 + hi * 8) * 2);
#pragma unroll
    for (int d0 = 0; d0 < 8; ++d0) { const char* a = kb[d0 & 3] + (d0 >> 2) * 128;
        bf16x8 b0 = *reinterpret_cast<const bf16x8*>(a);
        bf16x8 b1 = *reinterpret_cast<const bf16x8*>(a + 32 * 256);
        p0 = __builtin_amdgcn_mfma_f32_32x32x16_bf16(b0, qr[d0], p0, 0, 0, 0);
        p1 = __builtin_amdgcn_mfma_f32_32x32x16_bf16(b1, qr[d0], p1, 0, 0, 0); }
}
template <int VB>
__device__ __forceinline__ void pv_tile(f32x16* o, int vb0, bf16x8 pa0, bf16x8 pa1, bf16x8 pa2, bf16x8 pa3) {
#define TRRD(dst, off) asm volatile("ds_read_b64_tr_b16 %0, %1 offset:%2" : "=&v"(dst) : "v"(vb0), "i"(off) : "memory")
#define PV_D0(d0) do { s16x4 l0, l1, l2, l3, h0, h1, h2, h3; constexpr int b_ = VB * SHM_V + v_rd_off(d0, 0, 0); \
        TRRD(l0, b_); TRRD(h0, b_ + 2048); TRRD(l1, b_ + 4096); TRRD(h1, b_ + 6144); TRRD(l2, b_ + 8192); TRRD(h2, b_ + 10240); TRRD(l3, b_ + 12288); TRRD(h3, b_ + 14336); \
        asm volatile("s_waitcnt lgkmcnt(0)" ::: "memory"); SBAR();   \
        o[d0] = __builtin_amdgcn_mfma_f32_32x32x16_bf16(pa0, (bf16x8){l0[0], l0[1], l0[2], l0[3], h0[0], h0[1], h0[2], h0[3]}, o[d0], 0, 0, 0);   \
        o[d0] = __builtin_amdgcn_mfma_f32_32x32x16_bf16(pa1, (bf16x8){l1[0], l1[1], l1[2], l1[3], h1[0], h1[1], h1[2], h1[3]}, o[d0], 0, 0, 0);   \
        o[d0] = __builtin_amdgcn_mfma_f32_32x32x16_bf16(pa2, (bf16x8){l2[0], l2[1], l2[2], l2[3], h2[0], h2[1], h2[2], h2[3]}, o[d0], 0, 0, 0);   \
        o[d0] = __builtin_amdgcn_mfma_f32_32x32x16_bf16(pa3, (bf16x8){l3[0], l3[1], l3[2], l3[3], h3[0], h3[1], h3[2], h3[3]}, o[d0], 0, 0, 0); } while (0)
    PV_D0(0); PV_D0(1); PV_D0(2); PV_D0(3);
#undef PV_D0
#undef TRRD
}

struct BlockRef { const bf16_t* Q; const bf16_t* K; const bf16_t* V; bf16_t* O; const bf16_t* GZ; const float* BIAS; int P0; };
struct Seam { bf16x8 qr[8]; bf16x8 st_v0, st_v1, st_k0, st_k1; };
#define ROW(p, k0, rr) ((p) + (size_t)((k0) + (rr)) * D + sc)
#define VMW() asm volatile("s_waitcnt vmcnt(0)" ::: "memory")
#define VMWN(n) asm volatile("s_waitcnt vmcnt(%0)" :: "i"(n) : "memory")
#define LD8(p) (*reinterpret_cast<const bf16x8*>(p))
#define SLOAD_H(Kp, Vp, k0) do { S.st_v0 = LD8(ROW(Vp, k0, sr)); S.st_v1 = LD8(ROW(Vp, k0, 32 + sr));              \
                         S.st_k0 = LD8(ROW(Kp, k0, sr)); S.st_k1 = LD8(ROW(Kp, k0, 32 + sr)); } while (0)
#define SWRITE_HK(bf) do { *(bf16x8*)(K_lds + (bf) * SHM_K + kws) = S.st_k0; *(bf16x8*)(K_lds + (bf) * SHM_K + kws + 32 * 256) = S.st_k1; } while (0)
#define SWRITE_HV(bf) do { *(bf16x8*)(V_lds + (bf) * SHM_V + vst0) = S.st_v0; *(bf16x8*)(V_lds + (bf) * SHM_V + vst1) = S.st_v1; } while (0)
#define SWRITE_H(bf) do { SWRITE_HV(bf); SWRITE_HK(bf); } while (0)
__device__ __forceinline__ void causal_prime(const BlockRef& cur, char* lds, Seam& S) {
    const int tid = threadIdx.x, wid = __builtin_amdgcn_readfirstlane(tid >> 6), lane = tid & 63, r32 = lane & 31, hi = lane >> 5;
    const int sr = tid >> 4, sc = (tid & 15) * 8, kws = KSWZ(sr, sc * 2); char* K_lds = lds + 2 * SHM_V;
    for (int d0 = 0; d0 < 8; ++d0) S.qr[d0] = LD8(cur.Q + (size_t)(wid * QBLK + r32) * D + d0 * 16 + hi * 8);
    SLOAD_H(cur.K, cur.V, 0); VMW(); SWRITE_HK(0);
    __syncthreads();
}
__device__ __forceinline__ void causal_block(const BlockRef& cur, char* lds, Seam& S) {
    const int tid = threadIdx.x, wid = __builtin_amdgcn_readfirstlane(tid >> 6), lane = tid & 63, r32 = lane & 31, hi = lane >> 5;
    const int NT = (cur.P0 + QB - 1) / KVBLK + 1;
    const int qlo = cur.P0 + wid * QBLK, qm = qlo + r32 - 4 * hi;
    char* V_lds = lds; char* K_lds = lds + 2 * SHM_V;
    float* ws = (float*)(lds + OFF_WS) + wid * 64; float* li_l = ws, * al_l = ws + 32;
    float* bias_l = (float*)(lds + OFF_BIAS);
    for (int i = tid * 4; i < cur.P0 + QB; i += NW * 64 * 4) *(f32x4*)(bias_l + i) = *(const f32x4*)(cur.BIAS + i);
    __syncthreads();
    float m_reg = -1e30f, l_reg = 0; f32x16 o[4] = {};
    const int sr = tid >> 4, sc = (tid & 15) * 8, vst0 = v_st(sr, sc), vst1 = v_st(32 + sr, sc), kws = KSWZ(sr, sc * 2);
    const int vb0 = (int)(uintptr_t)V_lds + v_rd_base(lane);
    const bf16_t* Kh = cur.K; const bf16_t* Vh = cur.V;
#define RESC(a) do { if (__any((a) < 1.f)) { if (hi == 0) al_l[r32] = (a); asm volatile("s_waitcnt lgkmcnt(0)" ::: "memory");              \
                     for (int d_ = 0; d_ < 4; ++d_) for (int r = 0; r < 16; ++r) o[d_][r] *= al_l[crow(r, hi)]; } } while (0)
#define KBASE(t) ((t) * KVBLK)
#define MASKT(P0_, P1_, t) do { const int kb_ = KBASE(t); if (kb_ + KVBLK - 1 > qlo) mask_tile(P0_, P1_, qm - kb_, WBIG); } while (0)
    constexpr int NQL = 8;
#define SEAM_K0() do { VMWN(NQL); SWRITE_HK(0); SBAR(); } while (0)
    f32x16 pA0, pA1, pB0, pB1; float mnA, mnB, alA, alB; bf16x8 pa0, pa1, pa2, pa3;
    SWRITE_HV(0); SBAR();
    if (NT > 1) { SLOAD_H(Kh, Vh, KBASE(1)); }
    SBAR(); qkt<0>(pA0, pA1, K_lds, bias_l + 4 * hi + KBASE(0), r32, hi, S.qr);
    MASKT(pA0, pA1, 0); partialSM(pA0, pA1, m_reg, mnA, alA);
    if (NT > 1) { VMW(); SWRITE_H(1); }
    __syncthreads();
#define HALF_STEP(PX0, PX1, mnX, alX, PY0, PY1, alY, t, KB, VB, SB) do {                                                      \
        SBAR(); qkt<KB>(PX0, PX1, K_lds, bias_l + 4 * hi + KBASE(t), r32, hi, S.qr);                                             \
        finishSM(PY0, PY1, alY, l_reg, pa0, pa1, pa2, pa3); SBAR();                                                           \
        if ((t) + 1 < NT) { SLOAD_H(Kh, Vh, KBASE((t) + 1)); SBAR(); }                                               \
        pv_tile<VB>(o, vb0, pa0, pa1, pa2, pa3); MASKT(PX0, PX1, (t)); partialSM(PX0, PX1, m_reg, mnX, alX);                                        \
        __syncthreads();                                                                                                      \
        if ((t) + 1 < NT) { VMW(); SWRITE_H(SB); }                                                                          \
        RESC(alX); __syncthreads(); } while (0)
    for (int t = 1; t + 1 < NT; t += 2) {
        HALF_STEP(pB0, pB1, mnB, alB, pA0, pA1, alA, t, 1, 0, 0);
        HALF_STEP(pA0, pA1, mnA, alA, pB0, pB1, alB, t + 1, 0, 1, 1);
    }
    const bool even = (NT & 1) == 0;
    if (even) { SBAR(); qkt<1>(pB0, pB1, K_lds, bias_l + 4 * hi + KBASE(NT - 1), r32, hi, S.qr); SBAR(); }
    SBAR();
    finishSM(pA0, pA1, alA, l_reg, pa0, pa1, pa2, pa3); SBAR();
    pv_tile<0>(o, vb0, pa0, pa1, pa2, pa3);
    if (even) { MASKT(pB0, pB1, NT - 1); partialSM(pB0, pB1, m_reg, mnB, alB); __syncthreads(); RESC(alB);
        finishSM(pB0, pB1, alB, l_reg, pa0, pa1, pa2, pa3); SBAR(); pv_tile<1>(o, vb0, pa0, pa1, pa2, pa3); }
    SBAR();
    if (hi == 0) li_l[r32] = l_reg; asm volatile("s_waitcnt lgkmcnt(0)" ::: "memory");
    float rli[16];
#pragma unroll
    for (int r = 0; r < 16; ++r) rli[r] = __builtin_amdgcn_rcpf(li_l[crow(r, hi)]);
    int eoff = 4 * hi * OST + r32;
    asm volatile("" : "+v"(eoff));
    bf16_t* Ow = cur.O + (size_t)(wid * QBLK) * OST + eoff; const bf16_t* Gw = cur.GZ + (size_t)(wid * QBLK) * OST + eoff;
    unsigned gzv[16][4];
#pragma unroll
    for (int r = 0; r < 16; ++r) { const int ro = ((r & 3) + 8 * (r >> 2)) * OST;
#pragma unroll
        for (int d0 = 0; d0 < 4; ++d0) gzv[r][d0] = Gw[ro + d0 * 32]; }
#pragma unroll
    for (int r = 0; r < 16; ++r) { const int ro = ((r & 3) + 8 * (r >> 2)) * OST;
#pragma unroll
        for (int d0 = 0; d0 < 4; ++d0) { const float v = o[d0][r] * rli[r] * __uint_as_float(gzv[r][d0] << 16);
            const float vn = __shfl_xor(v, 1);
            if ((r32 & 1) == 0) *(unsigned*)(Ow + ro + d0 * 32) = pkbf(v, vn); } }
    __syncthreads();
#undef RESC
#undef KBASE
#undef MASKT
#undef SEAM_K0
#undef HALF_STEP
}
#undef ROW
#undef VMW
#undef VMWN
#undef LD8
#undef SLOAD_H
#undef SWRITE_HK
#undef SWRITE_HV
#undef SWRITE_H

struct Tensors { const bf16_t* Q; const bf16_t* K; const bf16_t* V; bf16_t* O; const bf16_t* GZ; const float* BIAS; };
__device__ __forceinline__ BlockRef make_ref(const Tensors& T, int L, int pass) {
    const int xcd = L & 7, k = L >> 3, bh = xcd * 4 + (k >> 3), x = k & 7, qb = pass ? 15 - x : x, b = bh >> 4, h = bh & 15;
    BlockRef r;
    r.Q = T.Q + ((size_t)bh * SEQ + (size_t)qb * QB) * D; r.K = T.K + (size_t)bh * SKV * D; r.V = T.V + (size_t)bh * SKV * D;
    r.O = T.O + ((size_t)(b * SEQ + qb * QB)) * OST + h * D; r.GZ = T.GZ + ((size_t)(b * SEQ + qb * QB)) * OST + h * D;
    r.BIAS = T.BIAS + bh * SKV; r.P0 = KPAD + qb * QB;
    return r;
}
__device__ __forceinline__ void attn_phase(char* lds, const Tensors& T) {
    const int total = 256, stride = gridDim.x;
    int L = blockIdx.x; if (L >= total) return;
    Seam S;
    for (; L < total; L += stride)
        for (int pass = 0; pass < 2; ++pass) {
            const BlockRef cur = make_ref(T, L, pass);
            causal_prime(cur, lds, S);
            causal_block(cur, lds, S);
        }
}
#undef KSWZ
#undef SBAR
}
constexpr int NWAVES = 8, LDS_BYTES = 147456;
static_assert(pg8::STAGE_BYTES + 8192 <= LDS_BYTES - 256 && pg8::STAGE_BYTES <= LDS_BYTES && HG_END <= LDS_BYTES && attn::LDS_BYTES <= LDS_BYTES, "LDS budget");
constexpr int N_PHASES = 9;
constexpr size_t WS_BAR = 1376256;
constexpr int LDS_MISC = LDS_BYTES - 256;
static_assert(WS_BAR >= (size_t)SM_END * 4 && WS_BAR % 256 == 0 && WS_BAR + 3 * XCD_BAR_WORDS * 4 <= 2 * MiB && HG_END <= LDS_MISC, "barrier words");
struct Args { const float* in[15]; float* out; unsigned char* ws; int ph_lo, ph_hi, li, pad; };

__global__ void __launch_bounds__(NWAVES * 64, 2) yoco_fwd(Args args) {
    extern __shared__ __attribute__((aligned(16))) unsigned char lds_raw[];
    LAS unsigned char* lds = (LAS unsigned char*)lds_raw;
    const int tid = threadIdx.x, lane = tid & 63, wave = __builtin_amdgcn_readfirstlane(tid >> 6);
    const int G = gridDim.x, gw = blockIdx.x * NWAVES + wave, NGW = G * NWAVES;
    unsigned char* ws = args.ws;
    Ptrs P;
    P.x = args.in[0]; P.meta = args.in[1]; P.gamma_lb = args.in[2]; P.a_norm = args.in[3]; P.a_w_in = args.in[4]; P.a_out_norm = args.in[5]; P.a_w_out = args.in[6];
    P.kv_norm = args.in[7]; P.kv_w = args.in[8]; P.fox_b_f = args.in[9]; P.fox_k_norm = args.in[10]; P.b_norm = args.in[11]; P.b_w_in = args.in[12]; P.b_q_norm = args.in[13]; P.b_w_out = args.in[14];
    P.out = args.out; P.sm = (float*)(ws + WS_SMALL);
    P.WT_AIN = (bf16_t*)(ws + WS_WT_AIN); P.WT_AOUT = (bf16_t*)(ws + WS_WT_AOUT); P.WT_KVB = (bf16_t*)(ws + WS_WT_KVB); P.WT_BOUT = (bf16_t*)(ws + WS_WT_BOUT); P.WT_F = (bf16_t*)(ws + WS_WT_F);
    P.XN0 = (bf16_t*)(ws + WS_XN0); P.QS = (bf16_t*)(ws + WS_QS); P.VV = (bf16_t*)(ws + WS_VV); P.GZ = (bf16_t*)(ws + WS_GZ); P.OG = (bf16_t*)(ws + WS_OG);
    bf16_t* H1BF = (bf16_t*)(ws + WS_XN0); bf16_t* KB = (bf16_t*)(ws + WS_QS); bf16_t* VB = (bf16_t*)(ws + WS_VV); bf16_t* QB2 = (bf16_t*)(ws + WS_GZ); bf16_t* GZ2 = (bf16_t*)(ws + WS_OG);
    float* SEGS = (float*)(ws + WS_WT_AIN); bf16_t* OG2 = (bf16_t*)(ws + WS_WT_AIN);
    unsigned short* LOGF = (unsigned short*)args.out;
    const int lo = args.ph_lo, hi = args.ph_hi;
    volatile LAS unsigned* MISC = (volatile LAS unsigned*)(lds + LDS_MISC);
    if (tid < 2) MISC[tid] = 0u;
    __syncthreads();
    const XcdBarrier bar = xcd_barrier_post((unsigned*)(ws + WS_BAR) + args.li * XCD_BAR_WORDS, MISC);
#ifndef PH_MASK
#ifdef DBG_STOP
#define PH_MASK ((2 << DBG_STOP) - 1)
#else
#define PH_MASK 0x1ff
#endif
#endif
#define IN(k) (((PH_MASK >> (k)) & 1) && lo <= (k) && (k) < hi)
#define SEAM(k) do { if (IN(k) && IN((k) + 1)) xcd_barrier(bar); } while (0)

#ifndef PH_DUP
#define PH_DUP -1
#endif
#define GSYNC() xcd_barrier(bar)
#if PH_DUP < 0
#define REP(k)
#define REP_END
#else
#define REP(k) for (int rep_ = 0; rep_ < (PH_DUP == (k) ? 2 : 1); ++rep_) { if (PH_DUP == (k) && rep_ == 1) GSYNC();
#define REP_END }
#endif
#ifdef EXTRA_SYNCS
    for (int es = 0; es < EXTRA_SYNCS; ++es) GSYNC();
#endif
    REP(0)
    if (IN(0)) { p0_prologue(P, lds, gw, NGW, wave, lane); }
    REP_END
    SEAM(0);
    REP(1)
    if (IN(1)) {
        pg8::Gemm g{P.XN0, P.WT_AIN, MR, 8192, DM}; pg8::StaticOrder S; S.init(MR, 8192, G, (int)blockIdx.x);
        pg8::Epi1 E{P.QS, LOGF, P.VV, P.GZ, P.sm + SM_LBV};
        pg8::gemm_phase<pg8::Epi1, pg8::StaticOrder, true, true>(lds, g, S, E);
        p1_meta(P, lds, gw, NGW, wave, lane);
    }
    REP_END
    SEAM(1);
    REP(2)
    if (IN(2)) {
        for (int it = blockIdx.x; it < 32 * 7; it += G) { const int bh = it / 7, seg = it % 7;
            hgrn_item<0>(lds, P.QS, LOGF, (const unsigned short*)(P.sm + SM_LOGFM), P.VV, P.GZ, P.OG, SEGS, P.sm + SM_DSEG, bh >> 4, bh & 15, seg); }
    }
    REP_END
    SEAM(2);
    REP(3)
    if (IN(3)) {
        for (int it = blockIdx.x; it < 256; it += G) { const int bh = it >> 3, seg = it & 7;
            hgrn_item<1>(lds, P.QS, LOGF, (const unsigned short*)(P.sm + SM_LOGFM), P.VV, P.GZ, P.OG, SEGS, P.sm + SM_DSEG, bh >> 4, bh & 15, seg); }
    }
    REP_END
    SEAM(3);
    if (IN(4)) {
        pg8::Gemm g{P.OG, P.WT_AOUT, MR, DM, DM}; pg8::StaticOrder S; S.init(MR, DM, G, (int)blockIdx.x);
        pg8::Epi2 E{P.x, P.out, H1BF, P.sm + SM_ROWSS};
        pg8::gemm_phase<pg8::Epi2, pg8::StaticOrder, true, true>(lds, g, S, E);
        p4_meta(P, H1BF, lds, gw, NGW, wave, lane);
    }
    SEAM(4);
    REP(5)
    if (IN(5)) {
        pg8::Gemm g{H1BF, P.WT_KVB, MR, 8192, DM}; pg8::StaticOrder S; S.init(MR, 8192, G, (int)blockIdx.x);
        pg8::Epi3 E{KB, VB, QB2, GZ2, P.sm + SM_ROWSS, P.fox_k_norm, P.b_q_norm, (LAS float*)(lds + pg8::STAGE_BYTES)};
        pg8::gemm_phase<pg8::Epi3, pg8::StaticOrder, true, true>(lds, g, S, E);
        p5_side(P, H1BF, KB, VB, lds, gw, NGW, wave, lane);
    }
    REP_END
    SEAM(5);
    if (IN(6)) { p6_norm_scan(P, KB, QB2, gw, NGW, lane); }
    SEAM(6);
    REP(7)
    if (IN(7)) {
        const attn::Tensors T{QB2, KB, VB, OG2, GZ2, P.sm + SM_BIAS};
        attn::attn_phase((char*)lds_raw, T);
    }
    REP_END
    SEAM(7);
    if (IN(8)) {
        pg8::Gemm g{OG2, P.WT_BOUT, MR, DM, DM}; pg8::StaticOrder S; S.init(MR, DM, G, (int)blockIdx.x);
        pg8::Epi4 E{H1BF, P.out};
        pg8::gemm_phase<pg8::Epi4, pg8::StaticOrder, true, true>(lds, g, S, E);
    }
#ifdef DBG_STOP
    { xcd_barrier(bar);
      const size_t n = (size_t)MR * DM;
      for (size_t i = (size_t)blockIdx.x * 512 + tid; i < n; i += (size_t)G * 512) {
          float v = 0.f;
          if (DBG_STOP == 1) v = bf2f(P.QS[i]) + bf2f(P.VV[i]) + bf2f(P.GZ[i]);
          if (DBG_STOP == 2) v = (i < (size_t)224 * 16384 ? SEGS[(i / (7 * 16384)) * (8 * 16384) + (i % (7 * 16384))] : 0.f) + (i < 32768 ? P.sm[SM_LOGFM + i] : 0.f) + (i < 16 * DM ? bf2f(P.QS[(size_t)MR * DM + i]) + bf2f(P.VV[(size_t)MR * DM + i]) + bf2f(P.GZ[(size_t)MR * DM + i]) : 0.f);
          if (DBG_STOP == 3) v = bf2f(P.OG[i]);
          if (DBG_STOP == 4) v = args.out[i] + bf2f(H1BF[i]);
          if (DBG_STOP == 5 || DBG_STOP == 6) v = bf2f(KB[i]) + bf2f(VB[i]) + bf2f(QB2[i]) + bf2f(GZ2[i]) + (i < 32 * SKV ? P.sm[SM_BIAS + i] * 1e-3f : 0.f);
          if (DBG_STOP == 7) v = bf2f(OG2[i]);
          args.out[i] = v;
      } }
#endif
#undef IN
#undef SEAM
}

#ifndef MK_PER_PHASE
#define MK_PER_PHASE 0
#endif
extern "C" void kernel_launch(void* const* d_in, const int* in_sizes, int n_in, void* d_out, int out_size, void* d_ws, size_t ws_size, hipStream_t stream) {
    static int grid = 0;
    if (grid == 0) {
        if (n_in != 15 || out_size != MR * DM || ws_size < WS_END) { fprintf(stderr, "kernel_launch: unexpected shapes (n_in %d, out %d, ws %zu)\n", n_in, out_size, ws_size); grid = -1; return; }
        int dev = 0, cus = 0, per_cu = 0;
        (void)hipGetDevice(&dev); (void)hipDeviceGetAttribute(&cus, hipDeviceAttributeMultiprocessorCount, dev);
        if (hipFuncSetAttribute((const void*)yoco_fwd, hipFuncAttributeMaxDynamicSharedMemorySize, LDS_BYTES) != hipSuccess) { fprintf(stderr, "kernel_launch: hipFuncSetAttribute failed\n"); grid = -1; return; }
        if (hipOccupancyMaxActiveBlocksPerMultiprocessor(&per_cu, (const void*)yoco_fwd, NWAVES * 64, LDS_BYTES) != hipSuccess || per_cu < 1) { fprintf(stderr, "kernel_launch: occupancy query says %d blocks per CU\n", per_cu); per_cu = 1; }
        (void)hipGetLastError();
        grid = cus > 0 ? cus : 256;
    }
    if (grid < 0) return;
    if (hipMemsetAsync((char*)d_ws + WS_BAR, 0, 3 * XCD_BAR_WORDS * 4, stream) != hipSuccess) { fprintf(stderr, "kernel_launch: hipMemsetAsync failed\n"); return; }
    Args a{};
    for (int i = 0; i < 15; ++i) a.in[i] = (const float*)d_in[i];
    a.out = (float*)d_out; a.ws = (unsigned char*)d_ws;
#if defined(DUP_PHASE)
    {
        const int cuts[4][2] = {{0, DUP_PHASE + 1}, {DUP_PHASE, DUP_PHASE + 1}, {DUP_PHASE + 1, N_PHASES}, {0, 0}};
        for (int li = 0; li < 3; ++li) { if (cuts[li][0] >= cuts[li][1]) continue; a.ph_lo = cuts[li][0]; a.ph_hi = cuts[li][1]; a.li = li; void* kargs[] = {&a};
            hipError_t e = hipLaunchCooperativeKernel((const void*)yoco_fwd, dim3(grid), dim3(NWAVES * 64), kargs, LDS_BYTES, stream);
            if (e != hipSuccess) { fprintf(stderr, "kernel_launch: launch %d failed: %s\n", li, hipGetErrorString(e)); break; } }
    }
#elif MK_PER_PHASE
    for (int p = 0; p < N_PHASES; ++p) { a.ph_lo = p; a.ph_hi = p + 1; void* kargs[] = {&a};
        hipError_t e = hipLaunchCooperativeKernel((const void*)yoco_fwd, dim3(grid), dim3(NWAVES * 64), kargs, LDS_BYTES, stream);
        if (e != hipSuccess) { fprintf(stderr, "kernel_launch: launch of phase %d failed: %s\n", p, hipGetErrorString(e)); break; } }
#else
    a.ph_lo = 0; a.ph_hi = N_PHASES; void* kargs[] = {&a};
    hipError_t e = hipLaunchCooperativeKernel((const void*)yoco_fwd, dim3(grid), dim3(NWAVES * 64), kargs, LDS_BYTES, stream);
    if (e != hipSuccess) fprintf(stderr, "kernel_launch: cooperative launch failed: %s (grid %d)\n", hipGetErrorString(e), grid);
#endif
}
```
